# Optimizing an MI355X kernel written in HIP

```python
import math
import jax, jax.numpy as jnp
from jax import lax
import numpy as np

D_MODEL = 1024
BATCH = 4
SEQ = 8192
DEPTH = 1

N_MEM = 256
EPS = 1e-6
NEG = -1e30

A_HEADS = 16
A_HEAD_DIM = 64
A_WIDTH = A_HEADS * A_HEAD_DIM
MOBA_BLOCK = 256
MOBA_TOPK = 3
MOBA_Q_CHUNK = 32
ROPE_THETA = 10000.0

B_HEADS = 8
B_KEY_DIM = 128
B_VAL_DIM = D_MODEL // B_HEADS
B_KEY_WIDTH = B_HEADS * B_KEY_DIM
B_VAL_WIDTH = B_HEADS * B_VAL_DIM
HGRN_CHUNK = 64

X_HEADS = 4
X_HEAD_DIM = D_MODEL // X_HEADS

FFN_HIDDEN = ((8 * D_MODEL + 3 * 256 - 1) // (3 * 256)) * 256

IN_WIDTHS = (A_WIDTH, A_WIDTH, A_WIDTH, B_KEY_WIDTH, B_KEY_WIDTH, B_VAL_WIDTH, B_VAL_WIDTH, D_MODEL, D_MODEL)
IN_WIDTH = A_WIDTH * 3 + B_KEY_WIDTH * 2 + B_VAL_WIDTH * 2 + D_MODEL * 2

kernel_name = "hybrid_moba_hgrn2_griffin_merge"


def rmsnorm(x, g):
    xf = x.astype(jnp.float32)
    y = xf * lax.rsqrt(jnp.mean(xf * xf, axis=-1, keepdims=True) + EPS)
    return (y * g.astype(jnp.float32)).astype(x.dtype)


def rope(t, pos):
    hd = t.shape[-1]
    inv_freq = jnp.power(ROPE_THETA, -jnp.arange(0, hd, 2, dtype=jnp.float32) / hd)
    ang = pos.astype(jnp.float32)[:, None, :, None] * inv_freq
    cos, sin = jnp.cos(ang), jnp.sin(ang)
    tf = t.astype(jnp.float32)
    t1, t2 = tf[..., : hd // 2], tf[..., hd // 2:]
    return jnp.concatenate([t1 * cos - t2 * sin, t2 * cos + t1 * sin], axis=-1).astype(t.dtype)


def split_cols(z):
    outs, off = [], 0
    for w in IN_WIDTHS:
        outs.append(z[..., off:off + w])
        off += w
    return outs


def moba_attention(q, k, v, pos):
    B, S, _ = q.shape
    H, hd, BLK, QC = A_HEADS, A_HEAD_DIM, MOBA_BLOCK, MOBA_Q_CHUNK
    scale = hd ** -0.5

    def heads(t):
        return t.reshape(B, S, H, hd).transpose(0, 2, 1, 3)

    q = rope(heads(q), pos)
    k = rope(heads(k), pos)
    v = heads(v)
    nb = -(-S // BLK)
    s_pad = nb * BLK
    padw = [(0, 0), (0, 0), (0, s_pad - S), (0, 0)]
    q, k, v = jnp.pad(q, padw), jnp.pad(k, padw), jnp.pad(v, padw)
    kb = k.reshape(B, H, nb, BLK, hd)
    vb = v.reshape(B, H, nb, BLK, hd)

    k_mean = jnp.mean(kb.astype(jnp.float32), axis=3)
    gate = jnp.einsum('bhsd,bhnd->bhsn', q.astype(jnp.float32), k_mean)
    q_blk = jnp.arange(s_pad) // BLK
    past = jnp.arange(nb)[None, :] < q_blk[:, None]
    gate = jnp.where(past, gate, NEG)
    n_sel = min(MOBA_TOPK, nb)
    _, idx = lax.top_k(gate, n_sel)
    valid = idx < q_blk[:, None]

    n_chunks = s_pad // QC

    def to_chunks(t):
        return jnp.moveaxis(t.reshape(B, H, n_chunks, QC, t.shape[-1]), 2, 0)

    starts = jnp.arange(n_chunks, dtype=jnp.int32) * QC
    bi = jnp.arange(B)[:, None, None, None]
    hi = jnp.arange(H)[None, :, None, None]

    def attend(args):
        qc, ic, vmask, start = args
        blk = start // BLK
        k_own = lax.dynamic_index_in_dim(kb, blk, axis=2, keepdims=False)
        v_own = lax.dynamic_index_in_dim(vb, blk, axis=2, keepdims=False)
        q_pos = start + jnp.arange(QC)
        k_pos = blk * BLK + jnp.arange(BLK)
        s_own = jnp.einsum('bhqd,bhkd->bhqk', qc, k_own).astype(jnp.float32) * scale
        s_own = jnp.where(k_pos[None, :] <= q_pos[:, None], s_own, NEG)
        k_sel = kb[bi, hi, ic]
        v_sel = vb[bi, hi, ic]
        s_sel = jnp.einsum('bhqd,bhqjkd->bhqjk', qc, k_sel).astype(jnp.float32) * scale
        s_sel = jnp.where(vmask[..., None], s_sel, NEG).reshape(B, H, QC, n_sel * BLK)
        p = jax.nn.softmax(jnp.concatenate([s_sel, s_own], axis=-1), axis=-1).astype(v.dtype)
        p_sel = p[..., : n_sel * BLK].reshape(B, H, QC, n_sel, BLK)
        p_own = p[..., n_sel * BLK:]
        return (jnp.einsum('bhqjk,bhqjkd->bhqd', p_sel, v_sel)
                + jnp.einsum('bhqk,bhkd->bhqd', p_own, v_own))

    o = lax.map(attend, (to_chunks(q), to_chunks(idx), to_chunks(valid), starts))
    o = jnp.moveaxis(o, 0, 2).reshape(B, H, s_pad, hd)[:, :, :S]
    return o.transpose(0, 2, 1, 3).reshape(B, S, H * hd)


def hgrn2(q, f, i, og, lb, norm_g):
    B, S, _ = q.shape
    H, dk, dv, C = B_HEADS, B_KEY_DIM, B_VAL_DIM, HGRN_CHUNK
    nc = S // C

    def heads(t, d):
        return t.reshape(B, S, H, d).transpose(0, 2, 1, 3).astype(jnp.float32)

    qh = jax.nn.silu(heads(q, dk)) * (dk ** -0.5)
    lbh = lb.astype(jnp.float32).reshape(1, H, 1, dk)
    fg = lbh + (1.0 - lbh) * jax.nn.sigmoid(heads(f, dk))
    logf = jnp.log(fg)
    kh = 1.0 - fg
    vh = heads(i, dv)

    def to_chunks(t):
        return jnp.moveaxis(t.reshape(B, H, nc, C, t.shape[-1]), 2, 0)

    causal = jnp.tril(jnp.ones((C, C), dtype=bool))[:, :, None]

    def step(state, xs):
        qc, kc, vc, gc = xs
        b = jnp.cumsum(gc, axis=2)
        o_inter = jnp.einsum('bhtd,bhdv->bhtv', qc * jnp.exp(b), state)
        diff = b[:, :, :, None, :] - b[:, :, None, :, :]
        decay = jnp.where(causal, jnp.exp(jnp.where(causal, diff, 0.0)), 0.0)
        a = jnp.einsum('bhtd,bhsd,bhtsd->bhts', qc, kc, decay)
        o = o_inter + jnp.einsum('bhts,bhsv->bhtv', a, vc)
        b_last = b[:, :, -1:, :]
        new_state = (jnp.exp(b_last[:, :, 0, :])[..., None] * state
                     + jnp.einsum('bhsd,bhsv->bhdv', kc * jnp.exp(b_last - b), vc))
        return new_state, o

    s0 = jnp.zeros((B, H, dk, dv), jnp.float32)
    _, o = lax.scan(step, s0, (to_chunks(qh), to_chunks(kh), to_chunks(vh), to_chunks(logf)))
    o = jnp.moveaxis(o, 0, 2).reshape(B, H, S, dv).transpose(0, 2, 1, 3)
    o = o * lax.rsqrt(jnp.mean(o * o, axis=-1, keepdims=True) + EPS)
    o = o.reshape(B, S, H * dv) * norm_g.astype(jnp.float32)
    o = o * jax.nn.silu(og.astype(jnp.float32))
    return o.astype(q.dtype)


def memory_cross_attention(h, mem, wq, wkv, wo):
    B, S, _ = h.shape
    M = mem.shape[1]
    q = (h @ wq).reshape(B, S, X_HEADS, X_HEAD_DIM)
    kv = mem @ wkv
    k = kv[..., :D_MODEL].reshape(B, M, X_HEADS, X_HEAD_DIM)
    v = kv[..., D_MODEL:].reshape(B, M, X_HEADS, X_HEAD_DIM)
    s = jnp.einsum('bshd,bmhd->bhsm', q, k).astype(jnp.float32) * (X_HEAD_DIM ** -0.5)
    p = jax.nn.softmax(s, axis=-1).astype(v.dtype)
    o = jnp.einsum('bhsm,bmhd->bshd', p, v).reshape(B, S, D_MODEL)
    return o @ wo


def setup_inputs(seed: int = 0) -> dict:
    key = jax.random.key(seed)
    ks = jax.random.split(key, 24)
    f32 = jnp.float32

    def w(k, shape, fan_in):
        return jax.random.normal(k, shape, f32) * (fan_in ** -0.5)

    def gain(k, shape):
        return 1.0 + 0.02 * jax.random.normal(k, shape, f32)

    x = jax.random.normal(ks[0], (BATCH, SEQ, D_MODEL), f32)
    mem = jax.random.normal(ks[1], (BATCH, N_MEM, D_MODEL), f32)
    offs = jax.random.randint(ks[2], (BATCH, 1), 0, 1024, dtype=jnp.int32)
    positions = offs + jnp.arange(SEQ, dtype=jnp.int32)[None, :]
    return {
        "x": x,
        "mem": mem,
        "positions": positions,
        "norm_mix_g": gain(ks[3], (DEPTH, D_MODEL)),
        "w_in": w(ks[4], (DEPTH, D_MODEL, IN_WIDTH), D_MODEL),
        "hgrn_lb_logits": 0.5 * jax.random.normal(ks[5], (DEPTH + 1, B_KEY_WIDTH), f32),
        "hgrn_norm_g": gain(ks[6], (DEPTH, B_VAL_WIDTH)),
        "w_br_attn": w(ks[7], (DEPTH, A_WIDTH, D_MODEL), A_WIDTH),
        "w_br_hgrn": w(ks[8], (DEPTH, B_VAL_WIDTH, D_MODEL), B_VAL_WIDTH),
        "w_out": w(ks[9], (DEPTH, D_MODEL, D_MODEL), D_MODEL),
        "norm_x_g": gain(ks[10], (DEPTH, D_MODEL)),
        "norm_mem_g": gain(ks[11], (DEPTH, D_MODEL)),
        "wq_x": w(ks[12], (DEPTH, D_MODEL, D_MODEL), D_MODEL),
        "wkv_x": w(ks[13], (DEPTH, D_MODEL, 2 * D_MODEL), D_MODEL),
        "wo_x": w(ks[14], (DEPTH, D_MODEL, D_MODEL), D_MODEL),
        "norm_ffn_g": gain(ks[15], (DEPTH, D_MODEL)),
        "w_ffn_in": w(ks[16], (DEPTH, D_MODEL, 2 * FFN_HIDDEN), D_MODEL),
        "w_ffn_out": w(ks[17], (DEPTH, FFN_HIDDEN, D_MODEL), FFN_HIDDEN),
        "final_norm_g": gain(ks[18], (D_MODEL,)),
    }


def reference(x, mem, positions, norm_mix_g, w_in, hgrn_lb_logits, hgrn_norm_g, w_br_attn,
              w_br_hgrn, w_out, norm_x_g, norm_mem_g, wq_x, wkv_x, wo_x, norm_ffn_g,
              w_ffn_in, w_ffn_out, final_norm_g):
    lb_all = jnp.cumsum(jax.nn.softmax(hgrn_lb_logits.astype(jnp.float32), axis=0), axis=0)
    h = x
    for l in range(DEPTH):
        xn = rmsnorm(h, norm_mix_g[l])
        q_a, k_a, v_a, q_b, f_b, i_b, og_b, g_a, g_b = split_cols(xn @ w_in[l])
        y_a = moba_attention(q_a, k_a, v_a, positions) @ w_br_attn[l]
        y_b = hgrn2(q_b, f_b, i_b, og_b, lb_all[l], hgrn_norm_g[l]) @ w_br_hgrn[l]
        merged = jax.nn.sigmoid(g_a) * y_a + jax.nn.sigmoid(g_b) * y_b
        h = h + merged @ w_out[l]
        h = h + memory_cross_attention(rmsnorm(h, norm_x_g[l]), rmsnorm(mem, norm_mem_g[l]),
                                       wq_x[l], wkv_x[l], wo_x[l])
        hn = rmsnorm(h, norm_ffn_g[l])
        gu = hn @ w_ffn_in[l]
        h = h + (jax.nn.silu(gu[..., :FFN_HIDDEN]) * gu[..., FFN_HIDDEN:]) @ w_ffn_out[l]
    return rmsnorm(h, final_norm_g)
```

```cpp
#include <hip/hip_runtime.h>
#include <hip/hip_cooperative_groups.h>
#include <cstdio>
#include <cstdint>
namespace cg = cooperative_groups;

#ifndef MK_N_LAUNCHES
#define MK_N_LAUNCHES 1
#endif

#ifndef STAGE_HGRN
#define STAGE_HGRN 1
#endif
#ifndef STAGE_MOBA
#define STAGE_MOBA 1
#endif
#ifndef STAGE_XATTN
#define STAGE_XATTN 1
#endif
#define LAS __attribute__((address_space(3)))
typedef unsigned short bf16_t;
typedef short bf16x8 __attribute__((ext_vector_type(8)));
typedef float f32x4 __attribute__((ext_vector_type(4)));
typedef float f32x2 __attribute__((ext_vector_type(2)));
typedef unsigned u32x4 __attribute__((ext_vector_type(4)));
typedef unsigned u32x2 __attribute__((ext_vector_type(2)));

constexpr int NB = 4, SEQ = 8192, T = NB * SEQ, D = 1024;
constexpr int AH = 16, AHD = 64, NBLK = 32;
constexpr int BH = 8, BDK = 128, BDV = 128, NCH = SEQ / 64;
constexpr int XH = 4, XHD = 256, NMEM = 256;
constexpr int FFN = 2816;
constexpr int ZN = 7168;
constexpr float EPS = 1e-6f;
constexpr float LOG2E = 1.4426950408889634f;
constexpr float QSCALE = 0.125f * LOG2E;
constexpr float XSCALE = 0.0625f * LOG2E;
constexpr float DKS = 0.08838834764831845f;

constexpr size_t MiB = 1u << 20;
constexpr size_t WS_CTL = 0, CTL_ZERO_BYTES = 2 * MiB;
constexpr size_t CTL_KMEAN = 64 * 1024;
constexpr size_t CTL_KAMAX = CTL_KMEAN + 512 * 1024;
constexpr size_t CTL_SSQ1 = 1 * MiB, CTL_SSQ2 = CTL_SSQ1 + 128 * 1024, CTL_SSQ3 = CTL_SSQ2 + 128 * 1024;
constexpr size_t WS_WZ = 4 * MiB, WS_WG = 18 * MiB, WS_WBR = 22 * MiB, WS_WOUT = 26 * MiB, WS_WQ = 28 * MiB, WS_WKV = 30 * MiB, WS_WO = 34 * MiB, WS_WFI = 36 * MiB, WS_WFO = 47 * MiB;
constexpr size_t WS_RC = 53 * MiB, WS_RS = 57 * MiB, WS_MEMN = 61 * MiB, WS_KX = 63 * MiB, WS_VX = 65 * MiB, WS_E1 = 67 * MiB, WS_E2 = 69 * MiB;
constexpr size_t WS_XN = 72 * MiB;
constexpr size_t WS_Q = 136 * MiB;
constexpr size_t WS_QI = 200 * MiB;
constexpr size_t WS_KI = 264 * MiB;
constexpr size_t WS_VB = 328 * MiB;
constexpr size_t WS_OG = 392 * MiB;
constexpr size_t WS_ACT = 264 * MiB;
constexpr size_t WS_END = 512 * MiB;

typedef __bf16 bf16x2_t __attribute__((ext_vector_type(2)));
__device__ __forceinline__ unsigned cvt_pk_bf16(float lo, float hi) { const f32x2 v = {lo, hi}; const bf16x2_t b = __builtin_convertvector(v, bf16x2_t); return __builtin_bit_cast(unsigned, b); }
__device__ __forceinline__ float bf2f(bf16_t h) { return __uint_as_float(((unsigned)h) << 16); }
__device__ __forceinline__ float bflo(unsigned w) { return __uint_as_float(w << 16); }
__device__ __forceinline__ float bfhi(unsigned w) { return __uint_as_float(w & 0xffff0000u); }
__device__ __forceinline__ bf16_t f2bf(float f) { return (bf16_t)(cvt_pk_bf16(f, 0.f) & 0xffffu); }
__device__ __forceinline__ float sigmoidf_(float x) { return __builtin_amdgcn_rcpf(1.0f + __expf(-x)); }
__device__ __forceinline__ float wave_sum(float v) {
#pragma unroll
    for (int o = 1; o < 64; o <<= 1) v += __shfl_xor(v, o);
    return v;
}
__device__ __forceinline__ float wave_max(float v) {
#pragma unroll
    for (int o = 1; o < 64; o <<= 1) v = fmaxf(v, __shfl_xor(v, o));
    return v;
}
__device__ __forceinline__ u32x4 pack8(const f32x4& a, const f32x4& b) { u32x4 w; w.x = cvt_pk_bf16(a[0], a[1]); w.y = cvt_pk_bf16(a[2], a[3]); w.z = cvt_pk_bf16(b[0], b[1]); w.w = cvt_pk_bf16(b[2], b[3]); return w; }
__device__ __forceinline__ void unpack8(const u32x4& w, f32x4& a, f32x4& b) { a = (f32x4){bflo(w.x), bfhi(w.x), bflo(w.y), bfhi(w.y)}; b = (f32x4){bflo(w.z), bfhi(w.z), bflo(w.w), bfhi(w.w)}; }

namespace pg8 {
constexpr int BM = 256, BK = 64, HALF = 128, HTB = HALF * BK * 2, STAGE_BYTES = 8 * HTB, NXCD = 8, WGM = 8;
__host__ __device__ __forceinline__ int lds_byte(int r, int c) { const int st = (r >> 4) * 2 + (c >> 5), rr = r & 15, cc = c & 31, ob = rr * 64 + cc * 2; return st * 1024 + (ob ^ (((ob >> 9) & 1) << 5)); }
__host__ __device__ __forceinline__ void stage_rc(int b, int& R, int& C) { const int st = b / 1024, sb = b % 1024, swz = sb ^ (((sb >> 9) & 1) << 5); R = (st >> 1) * 16 + swz / 64; C = (st & 1) * 32 + (swz % 64) / 2; }
struct Unit { int pm, pn; };
struct AView {
    const char* b0; const char* b1; int tsplit; long bstride, tstride, kstride; int lda;
    __device__ __forceinline__ const char* ptr(int pm, int t) const { return (t < tsplit ? b0 : b1) + (long)(pm >> 5) * bstride + (long)(pm & 31) * tstride + (long)t * kstride; }
};
__device__ __forceinline__ AView a_rowmajor(const void* A, int lda) { AView v; v.b0 = (const char*)A; v.b1 = (const char*)A; v.tsplit = 1 << 30; v.tstride = (long)256 * lda * 2; v.bstride = 32 * v.tstride; v.kstride = 128; v.lda = lda; return v; }
struct Gemm { AView A; const bf16_t* Bt; int M, N, K; };
struct StaticOrder {
    int nM, nN, nwg, G, c;
    __device__ void init(int M, int N, int G_, int c_) { nM = M / BM; nN = N / BM; nwg = nM * nN; G = G_; c = c_; }
    __device__ bool next(int i, Unit& u) const {
        const long L = (long)i * G + c; if (L >= nwg) return false;
        int wgid = (int)L; { const int q = nwg / NXCD, r = nwg % NXCD, xcd = wgid % NXCD, off = wgid / NXCD; wgid = (xcd < r ? xcd * (q + 1) : r * (q + 1) + (xcd - r) * q) + off; }
        const int nig = WGM * nN, gid = wgid / nig, fm = gid * WGM, gsz = (nM - fm) < WGM ? (nM - fm) : WGM;
        u.pm = fm + ((wgid % nig) % gsz); u.pn = (wgid % nig) / gsz; return true;
    }
};
struct PairOrder { StaticOrder base;
    __device__ bool next(int i, Unit& u) const { Unit v; if (!base.next(i >> 1, v)) return false; u.pm = v.pm; u.pn = 2 * v.pn + (i & 1); return true; } };
template <class Epi, bool ALIGN_EPI, class Sched = StaticOrder>
__device__ __forceinline__ void gemm_phase(LAS unsigned char* lds, const Gemm g, const Sched& S, const Epi& E) {
    const int tid = threadIdx.x, wid = __builtin_amdgcn_readfirstlane(tid >> 6), lane = tid & 63, wr = wid >> 2, wc = wid & 3, fr = lane & 15, fq = lane >> 4;
    const int K = g.K, nt = K / BK;
    unsigned voffA[2], voffB[2];
#pragma unroll
    for (int i = 0; i < 2; ++i) { int R, C; stage_rc(tid * 16 + i * 8192, R, C); voffA[i] = (unsigned)(R * g.A.lda + C) * 2u; voffB[i] = (unsigned)(R * K + C) * 2u; }
    const size_t hstepA = (size_t)HALF * g.A.lda * 2, hstepB = (size_t)HALF * K * 2, tstepB = 2 * hstepB, kstep = 128;
    const unsigned ldsw = (unsigned)wid * 1024u;
    const int aoff = lds_byte(wr * 64 + fr, fq * 8), boff = lds_byte(wc * 32 + fr, fq * 8);
#define PG8_SA(b, h) (((b) * 2 + (h)) * HTB)
#define PG8_SB(b, h) ((4 + (b) * 2 + (h)) * HTB)
#define PG8_STAGE(bufoff, gbase, voff) do { _Pragma("unroll") for (int _i = 0; _i < 2; ++_i) \
        __builtin_amdgcn_global_load_lds((const unsigned*)((const char*)(gbase) + (voff)[_i]), (LAS unsigned*)(lds + (bufoff) + ldsw + _i * 8192), 16, 0, 0); } while (0)
#define PG8_LDA(dst, b, h) do { _Pragma("unroll") for (int m = 0; m < 4; ++m) _Pragma("unroll") for (int k = 0; k < 2; ++k) dst[m][k] = *(const LAS bf16x8*)(lds + PG8_SA(b, h) + aoff + m * 2048 + k * 1024); } while (0)
#define PG8_LDB(dst, b, h) do { _Pragma("unroll") for (int n = 0; n < 2; ++n) _Pragma("unroll") for (int k = 0; k < 2; ++k) dst[n][k] = *(const LAS bf16x8*)(lds + PG8_SB(b, h) + boff + n * 2048 + k * 1024); } while (0)
#define PG8_MMA(ai, bj, At, Bt) do { __builtin_amdgcn_s_setprio(1); _Pragma("unroll") for (int m = 0; m < 4; ++m) _Pragma("unroll") for (int n = 0; n < 2; ++n) _Pragma("unroll") for (int k = 0; k < 2; ++k) \
        acc[ai][bj][m][n] = __builtin_amdgcn_mfma_f32_16x16x32_bf16(Bt[n][k], At[m][k], acc[ai][bj][m][n], 0, 0, 0); __builtin_amdgcn_s_setprio(0); } while (0)
#define PG8_WAIT_V(n) asm volatile("s_waitcnt vmcnt(" #n ")" ::: "memory")
#define PG8_WAIT_L(n) asm volatile("s_waitcnt lgkmcnt(" #n ")" ::: "memory")
#define PG8_BAR __builtin_amdgcn_s_barrier()
#define PG8_SCHED __builtin_amdgcn_sched_barrier(0)
    Unit cur, nxt; int ui = 0;
    if (!S.next(0, cur)) return;
    f32x4 acc[2][2][4][2];
#pragma unroll
    for (int a = 0; a < 2; ++a)
#pragma unroll
        for (int b = 0; b < 2; ++b)
#pragma unroll
            for (int m = 0; m < 4; ++m)
#pragma unroll
                for (int n = 0; n < 2; ++n) acc[a][b][m][n] = (f32x4){0.f, 0.f, 0.f, 0.f};
    bf16x8 At[4][2], B0[2][2], B1[2][2];
    const char* cB = (const char*)g.Bt + (size_t)cur.pn * tstepB;
    {
        const char* cA = g.A.ptr(cur.pm, 0); const char* cA1 = g.A.ptr(cur.pm, 1);
        PG8_STAGE(PG8_SB(0, 0), cB, voffB); PG8_STAGE(PG8_SB(0, 1), cB + hstepB, voffB); PG8_STAGE(PG8_SA(0, 0), cA, voffA); PG8_STAGE(PG8_SA(0, 1), cA + hstepA, voffA);
        if (wr == 1) PG8_BAR;
        PG8_WAIT_V(2); PG8_BAR;
        PG8_STAGE(PG8_SB(1, 0), cB + kstep, voffB); PG8_STAGE(PG8_SA(1, 0), cA1, voffA); PG8_STAGE(PG8_SB(1, 1), cB + hstepB + kstep, voffB);
        PG8_WAIT_V(6); PG8_BAR;
    }
    for (;;) {
        const bool has_next = S.next(ui + 1, nxt);
        const int npm = has_next ? nxt.pm : cur.pm;
        const char* nB = has_next ? (const char*)g.Bt + (size_t)nxt.pn * tstepB : cB;
        for (int t = 0; t < nt; t += 2) {
            const bool last = (t == nt - 2);
            if constexpr (Epi::MID) { if (t == (nt >> 1)) E.mid(acc, cur, wr, wc, fr, fq); }
            const char* a1 = g.A.ptr(cur.pm, t + 1);
            const char* a2 = last ? g.A.ptr(npm, 0) : g.A.ptr(cur.pm, t + 2);
            const char* a3 = last ? g.A.ptr(npm, 1) : g.A.ptr(cur.pm, t + 3);
            const char* b2 = last ? nB : cB + (size_t)(t + 2) * kstep;
            const char* b3 = b2 + kstep;
            PG8_LDB(B0, 0, 0); PG8_LDB(B1, 0, 1); PG8_SCHED; PG8_LDA(At, 0, 0); PG8_STAGE(PG8_SA(1, 1), a1 + hstepA, voffA);
            PG8_WAIT_V(8); PG8_WAIT_L(0); PG8_BAR; PG8_MMA(0, 0, At, B0); PG8_MMA(0, 1, At, B1); PG8_BAR; PG8_SCHED;
            PG8_LDA(At, 0, 1); PG8_STAGE(PG8_SB(0, 0), b2, voffB); PG8_STAGE(PG8_SB(0, 1), b2 + hstepB, voffB); PG8_STAGE(PG8_SA(0, 0), a2, voffA);
            PG8_WAIT_V(8); PG8_WAIT_L(0); PG8_BAR; PG8_MMA(1, 0, At, B0); PG8_MMA(1, 1, At, B1); PG8_BAR; PG8_SCHED;
            PG8_LDB(B0, 1, 0); PG8_LDB(B1, 1, 1); PG8_SCHED; PG8_LDA(At, 1, 0); PG8_STAGE(PG8_SA(0, 1), a2 + hstepA, voffA);
            PG8_WAIT_V(8); PG8_WAIT_L(0); PG8_BAR; PG8_MMA(0, 0, At, B0); PG8_MMA(0, 1, At, B1); PG8_BAR; PG8_SCHED;
            PG8_LDA(At, 1, 1); PG8_STAGE(PG8_SB(1, 0), b3, voffB); PG8_STAGE(PG8_SB(1, 1), b3 + hstepB, voffB); PG8_STAGE(PG8_SA(1, 0), a3, voffA);
            PG8_WAIT_V(8); PG8_WAIT_L(0); PG8_BAR; PG8_MMA(1, 0, At, B0); PG8_MMA(1, 1, At, B1); PG8_BAR; PG8_SCHED;
        }
        if constexpr (ALIGN_EPI) { if (wr == 0) PG8_BAR; }
        E(acc, cur, wr, wc, fr, fq);
        if (!has_next) break;
#pragma unroll
        for (int a = 0; a < 2; ++a)
#pragma unroll
            for (int b = 0; b < 2; ++b)
#pragma unroll
                for (int m = 0; m < 4; ++m)
#pragma unroll
                    for (int n = 0; n < 2; ++n) acc[a][b][m][n] = (f32x4){0.f, 0.f, 0.f, 0.f};
        cur = nxt; cB = nB; ++ui;
        if constexpr (ALIGN_EPI) { if (wr == 1) PG8_BAR; }
    }
    PG8_WAIT_V(0);
    if constexpr (!ALIGN_EPI) { if (wr == 0) PG8_BAR; }
    PG8_BAR;
#undef PG8_SA
#undef PG8_SB
#undef PG8_STAGE
#undef PG8_LDA
#undef PG8_LDB
#undef PG8_MMA
#undef PG8_WAIT_V
#undef PG8_WAIT_L
#undef PG8_BAR
#undef PG8_SCHED
}
}
typedef f32x4 Acc[2][2][4][2];

__host__ __device__ __forceinline__ int perm8(int p) { return (p & ~31) | (((p >> 2) & 3) << 3) | (((p >> 4) & 1) << 2) | (p & 3); }

struct EpiZ {
    static constexpr bool MID = false;
    bf16_t *Q, *Kp, *Vp, *QI, *KI, *VB, *OG; float *E1, *E2; const float *rc, *rs; float* kmean; unsigned* kamax; const float* lbl;
    __device__ __forceinline__ void mid(Acc&, const pg8::Unit&, int, int, int, int) const {}
    template <bool ISK> __device__ __forceinline__ void rope_sec(bf16_t* dst, const Acc& acc, const pg8::Unit& u, int wr, int wc, int fr, int fq) const {
        const int pn = u.pn, b = u.pm >> 5, s0 = (u.pm & 31) * 256;
        const int dlo = 16 * (wc & 1) + 4 * fq;
#pragma unroll
        for (int bj = 0; bj < 2; ++bj) {
            const int plane = b * 16 + 4 * (pn & 3) + 2 * bj + (wc >> 1);
            f32x4 slo = {0.f, 0.f, 0.f, 0.f}, shi = {0.f, 0.f, 0.f, 0.f}; float amax = 0.f;
#pragma unroll
            for (int ai = 0; ai < 2; ++ai)
#pragma unroll
                for (int m = 0; m < 4; ++m) {
                    const int s = s0 + 128 * ai + 64 * wr + 16 * m + fr; const size_t tok = (size_t)b * SEQ + s;
                    const f32x4 c4 = *(const f32x4*)(rc + tok * 32 + dlo), s4 = *(const f32x4*)(rs + tok * 32 + dlo);
                    const f32x4 lo = acc[ai][bj][m][0], hi = acc[ai][bj][m][1];
                    f32x4 olo = lo * c4 - hi * s4, ohi = hi * c4 + lo * s4;
                    if (!ISK) { olo = olo * QSCALE; ohi = ohi * QSCALE; }
                    else { slo += olo; shi += ohi;
#pragma unroll
                        for (int j = 0; j < 4; ++j) amax = fmaxf(amax, fmaxf(fabsf(olo[j]), fabsf(ohi[j]))); }
                    bf16_t* p = dst + ((size_t)plane * SEQ + s) * 64 + dlo;
                    u32x2 w0, w1; w0.x = cvt_pk_bf16(olo[0], olo[1]); w0.y = cvt_pk_bf16(olo[2], olo[3]); w1.x = cvt_pk_bf16(ohi[0], ohi[1]); w1.y = cvt_pk_bf16(ohi[2], ohi[3]);
                    *(u32x2*)p = w0; *(u32x2*)(p + 32) = w1;
                }
            if (ISK) {
#pragma unroll
                for (int j = 0; j < 4; ++j) {
#pragma unroll
                    for (int o = 1; o < 16; o <<= 1) { slo[j] += __shfl_xor(slo[j], o); shi[j] += __shfl_xor(shi[j], o); } }
                amax = wave_max(amax);
                if (fr == 0) { float* km = kmean + ((size_t)plane * NBLK + (u.pm & 31)) * 64 + dlo;
#pragma unroll
                    for (int j = 0; j < 4; ++j) { atomicAdd(km + j, slo[j]); atomicAdd(km + 32 + j, shi[j]); } }
                if ((threadIdx.x & 63) == 0) atomicMax(kamax + plane, __float_as_uint(amax));
            }
        }
    }
    template <bool ACT> __device__ __forceinline__ void plane_sec(bf16_t* dst, int pbase, const Acc& acc, const pg8::Unit& u, int wr, int wc, int fr, int fq) const {
        const int b = u.pm >> 5, s0 = (u.pm & 31) * 256, dc0 = 32 * (wc & 1) + 8 * fq;
#pragma unroll
        for (int bj = 0; bj < 2; ++bj) {
            const int plane = b * 16 + pbase + 2 * bj + (wc >> 1);
#pragma unroll
            for (int ai = 0; ai < 2; ++ai)
#pragma unroll
                for (int m = 0; m < 4; ++m) {
                    const int s = s0 + 128 * ai + 64 * wr + 16 * m + fr;
                    f32x4 v0 = acc[ai][bj][m][0], v1 = acc[ai][bj][m][1];
                    if (ACT) {
#pragma unroll
                        for (int j = 0; j < 4; ++j) { v0[j] = v0[j] * sigmoidf_(v0[j]); v1[j] = v1[j] * sigmoidf_(v1[j]); } }
                    *(u32x4*)(dst + ((size_t)plane * SEQ + s) * 64 + dc0) = pack8(v0, v1);
                }
        }
    }
    __device__ __forceinline__ void qf_sec(const Acc& acc, const pg8::Unit& u, int wr, int wc, int fr, int fq) const {
        const int b = u.pm >> 5, s0 = (u.pm & 31) * 256;
        {
            const int h = u.pn, hp = b * 16 + 2 * h + (wc >> 1);
#pragma unroll
            for (int nn = 0; nn < 2; ++nn) {
                const int dc0 = 32 * (wc & 1) + 8 * fq + 4 * nn, lcol = h * 128 + 32 * wc + 8 * fq + 4 * nn;
                float lb[4];
#pragma unroll
                for (int i = 0; i < 4; ++i) { const float l0 = lbl[lcol + i], l1 = lbl[1024 + lcol + i]; lb[i] = 1.0f / (1.0f + __expf(l1 - l0)); }
#pragma unroll
                for (int ai = 0; ai < 2; ++ai) {
                    float bcs[4][4], kk[4][4];
#pragma unroll
                    for (int m = 0; m < 4; ++m)
#pragma unroll
                        for (int i = 0; i < 4; ++i) {
                            const float zf = acc[ai][1][m][nn][i];
                            const float e = __expf(-zf), sg = __builtin_amdgcn_rcpf(1.0f + e);
                            kk[m][i] = (1.0f - lb[i]) * (e * sg);
                            float v = __logf(lb[i] + (1.0f - lb[i]) * sg);
#pragma unroll
                            for (int o = 1; o < 16; o <<= 1) { const float t = __shfl_up(v, o, 16); if (fr >= o) v += t; }
                            bcs[m][i] = v;
                        }
                    float bmid[4], blast[4];
#pragma unroll
                    for (int i = 0; i < 4; ++i) {
                        float base = 0.f;
#pragma unroll
                        for (int m = 0; m < 4; ++m) { const float tot = __shfl(bcs[m][i], 15, 16); bcs[m][i] += base; base += tot; }
                        bmid[i] = __shfl(bcs[1][i], 15, 16); blast[i] = __shfl(bcs[3][i], 15, 16);
                    }
#pragma unroll
                    for (int m = 0; m < 4; ++m) {
                        const int s = s0 + 128 * ai + 64 * wr + 16 * m + fr;
                        f32x4 qv, kv;
#pragma unroll
                        for (int i = 0; i < 4; ++i) {
                            const float zq = acc[ai][0][m][nn][i];
                            const float ex = __expf(bcs[m][i] - bmid[i]);
                            qv[i] = zq * sigmoidf_(zq) * DKS * ex;
                            kv[i] = kk[m][i] * __builtin_amdgcn_rcpf(ex);
                        }
                        const size_t off = ((size_t)hp * SEQ + s) * 64 + dc0;
                        u32x2 wq_, wk_; wq_.x = cvt_pk_bf16(qv[0], qv[1]); wq_.y = cvt_pk_bf16(qv[2], qv[3]); wk_.x = cvt_pk_bf16(kv[0], kv[1]); wk_.y = cvt_pk_bf16(kv[2], kv[3]);
                        *(u32x2*)(QI + off) = wq_; *(u32x2*)(KI + off) = wk_;
                    }
                    if (fr == 15) {
                        const int chunk = (s0 + 128 * ai + 64 * wr) >> 6;
                        const size_t eo = (((size_t)(b * BH + h)) * NCH + chunk) * 128 + 32 * wc + 8 * fq + 4 * nn;
                        f32x4 a0, c0;
#pragma unroll
                        for (int i = 0; i < 4; ++i) { a0[i] = __expf(bmid[i]); c0[i] = __expf(blast[i] - bmid[i]); }
                        *(f32x4*)(E1 + eo) = a0; *(f32x4*)(E2 + eo) = c0;
                    }
                }
            }
        }
    }
};
template <bool ISK> struct EpiRope { static constexpr bool MID = false; EpiZ z;
    __device__ __forceinline__ void mid(Acc&, const pg8::Unit&, int, int, int, int) const {}
    __device__ __forceinline__ void operator()(const Acc& acc, const pg8::Unit& u, int wr, int wc, int fr, int fq) const { z.template rope_sec<ISK>(ISK ? z.Kp : z.Q, acc, u, wr, wc, fr, fq); } };
template <bool ACT> struct EpiPlane { static constexpr bool MID = false; EpiZ z; bf16_t* dst;
    __device__ __forceinline__ void mid(Acc&, const pg8::Unit&, int, int, int, int) const {}
    __device__ __forceinline__ void operator()(const Acc& acc, const pg8::Unit& u, int wr, int wc, int fr, int fq) const { z.template plane_sec<ACT>(dst, 4 * u.pn, acc, u, wr, wc, fr, fq); } };
struct EpiQF { static constexpr bool MID = false; EpiZ z;
    __device__ __forceinline__ void mid(Acc&, const pg8::Unit&, int, int, int, int) const {}
    __device__ __forceinline__ void operator()(const Acc& acc, const pg8::Unit& u, int wr, int wc, int fr, int fq) const { z.qf_sec(acc, u, wr, wc, fr, fq); } };
struct EpiKV {
    static constexpr bool MID = false;
    bf16_t *KX, *VX;
    __device__ __forceinline__ void mid(Acc&, const pg8::Unit&, int, int, int, int) const {}
    __device__ __forceinline__ void operator()(const Acc& acc, const pg8::Unit& u, int wr, int wc, int fr, int fq) const {
        bf16_t* dst = (u.pn < 4 ? KX : VX) + (size_t)(u.pm * 4 + (u.pn & 3)) * 256 * 256;
#pragma unroll
        for (int ai = 0; ai < 2; ++ai)
#pragma unroll
            for (int m = 0; m < 4; ++m) { const int r = 128 * ai + 64 * wr + 16 * m + fr;
#pragma unroll
                for (int bj = 0; bj < 2; ++bj) *(u32x4*)(dst + (size_t)r * 256 + 128 * bj + 32 * wc + 8 * fq) = pack8(acc[ai][bj][m][0], acc[ai][bj][m][1]); }
    }
};
struct EpiGate {
    static constexpr bool MID = false;
    bf16_t *RAT, *SGB;
    __device__ __forceinline__ void mid(Acc&, const pg8::Unit&, int, int, int, int) const {}
    __device__ __forceinline__ void operator()(const Acc& acc, const pg8::Unit& u, int wr, int wc, int fr, int fq) const {
        const int c0 = 128 * u.pn + 32 * wc + 8 * fq;
#pragma unroll
        for (int ai = 0; ai < 2; ++ai)
#pragma unroll
            for (int m = 0; m < 4; ++m) { const size_t r = (size_t)u.pm * 256 + 128 * ai + 64 * wr + 16 * m + fr;
                f32x4 ra[2], sb[2];
#pragma unroll
                for (int n = 0; n < 2; ++n)
#pragma unroll
                    for (int j = 0; j < 4; ++j) { const float ea = __expf(-acc[ai][0][m][n][j]), eb = __expf(-acc[ai][1][m][n][j]); sb[n][j] = __builtin_amdgcn_rcpf(1.0f + eb); ra[n][j] = (1.0f + eb) * __builtin_amdgcn_rcpf(1.0f + ea); }
                *(u32x4*)(RAT + r * D + c0) = pack8(ra[0], ra[1]); *(u32x4*)(SGB + r * D + c0) = pack8(sb[0], sb[1]); }
    }
};
struct EpiMerged {
    static constexpr bool MID = true;
    const bf16_t *RAT, *SGB; bf16_t* MG;
    __device__ __forceinline__ void mid(Acc& acc, const pg8::Unit& u, int wr, int wc, int fr, int fq) const {
        const int c0 = 256 * u.pn + 32 * wc + 8 * fq;
#pragma unroll
        for (int ai = 0; ai < 2; ++ai)
#pragma unroll
            for (int m = 0; m < 4; ++m) { const size_t r = (size_t)u.pm * 256 + 128 * ai + 64 * wr + 16 * m + fr;
#pragma unroll
                for (int bj = 0; bj < 2; ++bj) { const u32x4 wa = *(const u32x4*)(RAT + r * D + c0 + 128 * bj);
                    f32x4 a0, a1; unpack8(wa, a0, a1); acc[ai][bj][m][0] *= a0; acc[ai][bj][m][1] *= a1; }
                asm volatile("" ::: "memory"); }
    }
    __device__ __forceinline__ void operator()(const Acc& acc, const pg8::Unit& u, int wr, int wc, int fr, int fq) const {
        const int c0 = 256 * u.pn + 32 * wc + 8 * fq;
#pragma unroll
        for (int ai = 0; ai < 2; ++ai)
#pragma unroll
            for (int m = 0; m < 4; ++m) { const size_t r = (size_t)u.pm * 256 + 128 * ai + 64 * wr + 16 * m + fr;
#pragma unroll
                for (int bj = 0; bj < 2; ++bj) { const u32x4 wb = *(const u32x4*)(SGB + r * D + c0 + 128 * bj); f32x4 b0, b1; unpack8(wb, b0, b1);
                    *(u32x4*)(MG + r * D + c0 + 128 * bj) = pack8(acc[ai][bj][m][0] * b0, acc[ai][bj][m][1] * b1); } }
    }
};
template <bool RBF> struct EpiRes {
    static constexpr bool MID = false;
    const void* R; bf16_t* Hb; float* ssq;
    __device__ __forceinline__ void mid(Acc&, const pg8::Unit&, int, int, int, int) const {}
    __device__ __forceinline__ void operator()(const Acc& acc, const pg8::Unit& u, int wr, int wc, int fr, int fq) const {
        const int c0 = 256 * u.pn + 32 * wc + 4 * fq;
#pragma unroll
        for (int ai = 0; ai < 2; ++ai)
#pragma unroll
            for (int m = 0; m < 4; ++m) { const size_t r = (size_t)u.pm * 256 + 128 * ai + 64 * wr + 16 * m + fr; float ss = 0.f;
#pragma unroll
                for (int bj = 0; bj < 2; ++bj)
#pragma unroll
                    for (int n = 0; n < 2; ++n) { const size_t off = r * D + c0 + 128 * bj + 16 * n; f32x4 h = acc[ai][bj][m][n];
                        if (RBF) { const u32x2 w = *(const u32x2*)((const bf16_t*)R + off); h[0] += bflo(w.x); h[1] += bfhi(w.x); h[2] += bflo(w.y); h[3] += bfhi(w.y); }
                        else h += *(const f32x4*)((const float*)R + off);
                        ss += (h[0] * h[0] + h[1] * h[1]) + (h[2] * h[2] + h[3] * h[3]);
                        u32x2 w; w.x = cvt_pk_bf16(h[0], h[1]); w.y = cvt_pk_bf16(h[2], h[3]); *(u32x2*)(Hb + off) = w; }
                ss += __shfl_xor(ss, 16); ss += __shfl_xor(ss, 32);
                if (fq == 0) atomicAdd(ssq + r, ss); }
    }
};
struct EpiScaleRow {
    static constexpr bool MID = false;
    const float* ssq; bf16_t* O; float scale;
    __device__ __forceinline__ void mid(Acc&, const pg8::Unit&, int, int, int, int) const {}
    __device__ __forceinline__ void operator()(const Acc& acc, const pg8::Unit& u, int wr, int wc, int fr, int fq) const {
        const int c0 = 256 * u.pn + 32 * wc + 8 * fq;
#pragma unroll
        for (int ai = 0; ai < 2; ++ai)
#pragma unroll
            for (int m = 0; m < 4; ++m) { const size_t r = (size_t)u.pm * 256 + 128 * ai + 64 * wr + 16 * m + fr; const float rs = rsqrtf(ssq[r] * (1.0f / D) + EPS) * scale;
#pragma unroll
                for (int bj = 0; bj < 2; ++bj) *(u32x4*)(O + r * D + c0 + 128 * bj) = pack8(acc[ai][bj][m][0] * rs, acc[ai][bj][m][1] * rs); }
    }
};
struct EpiSwiglu {
    static constexpr bool MID = false;
    const float* ssq; bf16_t* ACT;
    __device__ __forceinline__ void mid(Acc&, const pg8::Unit&, int, int, int, int) const {}
    __device__ __forceinline__ void operator()(const Acc& acc, const pg8::Unit& u, int wr, int wc, int fr, int fq) const {
        const int c0 = 128 * u.pn + 32 * wc + 8 * fq;
#pragma unroll
        for (int ai = 0; ai < 2; ++ai)
#pragma unroll
            for (int m = 0; m < 4; ++m) { const size_t r = (size_t)u.pm * 256 + 128 * ai + 64 * wr + 16 * m + fr; const float rs = rsqrtf(ssq[r] * (1.0f / D) + EPS);
                f32x4 o[2];
#pragma unroll
                for (int n = 0; n < 2; ++n)
#pragma unroll
                    for (int j = 0; j < 4; ++j) { const float gv = acc[ai][0][m][n][j] * rs, uv = acc[ai][1][m][n][j] * rs; o[n][j] = gv * sigmoidf_(gv) * uv; }
                *(u32x4*)(ACT + r * FFN + c0) = pack8(o[0], o[1]); }
    }
};

typedef short s16x4 __attribute__((ext_vector_type(4)));
typedef short v4i16_t __attribute__((ext_vector_type(4)));
__device__ __forceinline__ s16x4 tr_read(const LAS unsigned char* p) { return __builtin_bit_cast(s16x4, __builtin_amdgcn_ds_read_tr16_b64_v4i16((LAS v4i16_t*)p)); }
__device__ __forceinline__ bf16x8 mk8(s16x4 lo, s16x4 hi) { return (bf16x8){lo[0], lo[1], lo[2], lo[3], hi[0], hi[1], hi[2], hi[3]}; }
__device__ __forceinline__ bf16x8 tr_frag(const LAS unsigned char* base, int pitch, int r0, int c0, int lane) {
    const int g = lane >> 4, i = lane & 15; const LAS unsigned char* p = base + (r0 + 8 * g + (i >> 2)) * pitch + (c0 + 4 * (i & 3)) * 2;
    return mk8(tr_read(p), tr_read(p + 4 * pitch));
}
__device__ __forceinline__ bf16x8 tr_frag_split(const LAS unsigned char* base, int pitch, int r0, int c0, int lane) {
    const int g = lane >> 4, i = lane & 15; const LAS unsigned char* p = base + (r0 + 4 * g + (i >> 2)) * pitch + (c0 + 4 * (i & 3)) * 2;
    return mk8(tr_read(p), tr_read(p + 16 * pitch));
}
__device__ __forceinline__ bf16x8 ld_frag(const LAS unsigned char* base, int pitch, int row, int col) { return *(const LAS bf16x8*)(base + row * pitch + col * 2); }
#define MFMA16(A, B, C) __builtin_amdgcn_mfma_f32_16x16x32_bf16((A), (B), (C), 0, 0, 0)
#define LDS_FADD(p, v) ((void)__hip_atomic_fetch_add((LAS float*)(p), (v), __ATOMIC_RELAXED, __HIP_MEMORY_SCOPE_WORKGROUP))

namespace hg {
constexpr int PITCH = 272;
constexpr int TILE = 64 * PITCH, HBUF = 3 * TILE;
constexpr int OFF_SP = 2 * HBUF, OFF_AM = OFF_SP + 128 * PITCH, AMP = 144, OFF_RSS = OFF_AM + 64 * AMP, OFF_E = OFF_RSS + 512, END = OFF_E + 2 * 1024;
static_assert(END <= 160 * 1024, "hgrn lds");
}
__device__ __forceinline__ void hgrn_item(LAS unsigned char* lds, int b, int h, const bf16_t* QIp, bf16_t* OUTp, size_t omask, const bf16_t* KIp, const bf16_t* VBp, const bf16_t* OGp, const float* E1p, const float* E2p, const float* gh) {
    using namespace hg;
    const int tid = threadIdx.x, lane = tid & 63, w = __builtin_amdgcn_readfirstlane(tid >> 6), c = lane & 15, g = lane >> 4;
    const size_t pl0 = ((size_t)(b * 16 + 2 * h)) * SEQ * 64, pl1 = pl0 + (size_t)SEQ * 64;
    const size_t eb = ((size_t)(b * BH + h)) * NCH * 128;
    const int tt = w >> 1, dvh = w & 1;
    f32x4 S[8];
#pragma unroll
    for (int j = 0; j < 8; ++j) S[j] = (f32x4){0.f, 0.f, 0.f, 0.f};
    f32x4 ghv[4];
#pragma unroll
    for (int jj = 0; jj < 4; ++jj) ghv[jj] = *(const f32x4*)(gh + h * 128 + 64 * dvh + 16 * jj + 4 * g);
    const size_t oplane = (dvh ? pl1 : pl0) + (size_t)(16 * tt + c) * 64 + 4 * g;
    u32x4 pq[2], pk[2], pv[2]; float pe = 0.f;
    auto issue = [&](int ch) {
#pragma unroll
        for (int k = 0; k < 2; ++k) { const int i = tid + 512 * k, row = i >> 4, pc = i & 15; const size_t src = (pc < 8 ? pl0 : pl1) + ((size_t)(64 * ch + row)) * 64 + (pc & 7) * 8;
            pq[k] = *(const u32x4*)(QIp + src); pk[k] = *(const u32x4*)(KIp + src); pv[k] = *(const u32x4*)(VBp + src); }
        if (tid < 256) pe = (tid < 128 ? E1p : E2p)[eb + (size_t)ch * 128 + (tid & 127)];
    };
    auto commit = [&](int p) {
        LAS unsigned char* bufp = lds + p * HBUF;
#pragma unroll
        for (int k = 0; k < 2; ++k) { const int i = tid + 512 * k, row = i >> 4, pc = i & 15; const int o = row * PITCH + pc * 16;
            *(LAS u32x4*)(bufp + o) = pq[k]; *(LAS u32x4*)(bufp + TILE + o) = pk[k]; *(LAS u32x4*)(bufp + 2 * TILE + o) = pv[k]; }
        if (tid < 256) ((LAS float*)(lds + OFF_E + p * 1024))[tid] = pe;
    };
    __syncthreads();
    issue(0); commit(0);
    __syncthreads();
    for (int ch = 0; ch < NCH; ++ch) {
        const int p = ch & 1;
        const LAS unsigned char* qb_ = lds + p * HBUF; const LAS unsigned char* kb_ = qb_ + TILE; const LAS unsigned char* vb_ = qb_ + 2 * TILE;
        const LAS float* e1s = (const LAS float*)(lds + OFF_E + p * 1024); const LAS float* e2s = e1s + 128;
        u32x2 ogv[4];
#pragma unroll
        for (int jj = 0; jj < 4; ++jj) ogv[jj] = *(const u32x2*)(OGp + oplane + (size_t)ch * 4096 + 16 * jj);
        issue(ch + 1 < NCH ? ch + 1 : ch);
#pragma unroll
        for (int s2 = 0; s2 < 2; ++s2) {
            const int si = 2 * (w & 1) + s2; f32x4 acc = {0.f, 0.f, 0.f, 0.f};
#pragma unroll
            for (int ks = 0; ks < 4; ++ks) acc = MFMA16(ld_frag(kb_, PITCH, 16 * si + c, 32 * ks + 8 * g), ld_frag(qb_, PITCH, 16 * tt + c, 32 * ks + 8 * g), acc);
#pragma unroll
            for (int r = 0; r < 4; ++r) acc[r] = (16 * si + 4 * g + r > 16 * tt + c) ? 0.f : acc[r];
            u32x2 w_; w_.x = cvt_pk_bf16(acc[0], acc[1]); w_.y = cvt_pk_bf16(acc[2], acc[3]);
            *(LAS u32x2*)(lds + OFF_AM + (16 * tt + c) * AMP + (16 * si + 4 * g) * 2) = w_;
        }
        {
            const f32x4 e1v = *(const LAS f32x4*)(e1s + 16 * w + 4 * g);
#pragma unroll
            for (int j = 0; j < 8; ++j) { S[j] = S[j] * e1v; u32x2 w_; w_.x = cvt_pk_bf16(S[j][0], S[j][1]); w_.y = cvt_pk_bf16(S[j][2], S[j][3]);
                *(LAS u32x2*)(lds + OFF_SP + (16 * j + c) * PITCH + (16 * w + 4 * g) * 2) = w_; }
        }
        __syncthreads();
        f32x4 o[4];
        {
            bf16x8 aq[4], aa[2];
#pragma unroll
            for (int ks = 0; ks < 4; ++ks) aq[ks] = ld_frag(qb_, PITCH, 16 * tt + c, 32 * ks + 8 * g);
#pragma unroll
            for (int j2 = 0; j2 < 2; ++j2) aa[j2] = ld_frag(lds + OFF_AM, AMP, 16 * tt + c, 32 * j2 + 8 * g);
            float ss = 0.f;
#pragma unroll
            for (int jj = 0; jj < 4; ++jj) {
                const int j = 4 * dvh + jj; f32x4 acc = {0.f, 0.f, 0.f, 0.f};
#pragma unroll
                for (int ks = 0; ks < 4; ++ks) acc = MFMA16(ld_frag(lds + OFF_SP, PITCH, 16 * j + c, 32 * ks + 8 * g), aq[ks], acc);
#pragma unroll
                for (int j2 = 0; j2 < 2; ++j2) acc = MFMA16(tr_frag(vb_, PITCH, 32 * j2, 16 * j, lane), aa[j2], acc);
                o[jj] = acc; ss += (acc[0] * acc[0] + acc[1] * acc[1]) + (acc[2] * acc[2] + acc[3] * acc[3]);
            }
            ss += __shfl_xor(ss, 16); ss += __shfl_xor(ss, 32);
            if (g == 0) ((LAS float*)(lds + OFF_RSS))[(16 * tt + c) * 2 + dvh] = ss;
        }
        __syncthreads();
        {
            const LAS float* rp = (const LAS float*)(lds + OFF_RSS) + (16 * tt + c) * 2; const float rs = rsqrtf((rp[0] + rp[1]) * (1.0f / 128.0f) + EPS);
#pragma unroll
            for (int jj = 0; jj < 4; ++jj) { const f32x4 v = o[jj] * rs * ghv[jj]; u32x2 w_;
                w_.x = cvt_pk_bf16(v[0] * bflo(ogv[jj].x), v[1] * bfhi(ogv[jj].x)); w_.y = cvt_pk_bf16(v[2] * bflo(ogv[jj].y), v[3] * bfhi(ogv[jj].y));
                *(u32x2*)(OUTp + ((oplane + (size_t)ch * 4096 + 16 * jj) & omask)) = w_; }
            bf16x8 ak[2];
#pragma unroll
            for (int k2 = 0; k2 < 2; ++k2) ak[k2] = tr_frag(kb_, PITCH, 32 * k2, 16 * w, lane);
            const f32x4 e2v = *(const LAS f32x4*)(e2s + 16 * w + 4 * g);
#pragma unroll
            for (int j = 0; j < 8; ++j) {
#pragma unroll
                for (int k2 = 0; k2 < 2; ++k2) S[j] = MFMA16(ak[k2], tr_frag(vb_, PITCH, 32 * k2, 16 * j, lane), S[j]);
                S[j] = S[j] * e2v;
            }
            commit(p ^ 1);
        }
        __syncthreads();
    }
}

namespace mb {
constexpr int KP_ = 144;
constexpr int OFF_K = 0, OFF_V = 256 * KP_, OFF_KM = 2 * 256 * KP_, OFF_CNT = OFF_KM + 8192, OFF_BASE = OFF_CNT + 128, END = OFF_BASE + 128;
static_assert(END <= 160 * 1024, "moba lds");
constexpr size_t WS_PO = 456 * MiB, WS_PL = WS_PO + 48 * MiB, WS_LIST = WS_PL + 1536 * 1024;
constexpr int LIST_PER_BH = 256 * 496;
static_assert(WS_LIST + (size_t)16 * LIST_PER_BH * 2 <= 512 * MiB, "moba ws");
__device__ __forceinline__ int list_off(int n) { return 256 * (31 * n - (n * (n - 1)) / 2); }
}
__device__ __forceinline__ void mb_stage(LAS unsigned char* dst, const bf16_t* g, int tid) {
    u32x4 r[4];
#pragma unroll
    for (int k = 0; k < 4; ++k) { const int i = tid + 512 * k; r[k] = *(const u32x4*)(g + (size_t)(i >> 3) * 64 + (i & 7) * 8); }
#pragma unroll
    for (int k = 0; k < 4; ++k) { const int i = tid + 512 * k; *(LAS u32x4*)(dst + (i >> 3) * mb::KP_ + (i & 7) * 16) = r[k]; }
}
struct MbStage { u32x4 rk[4], rv[4]; };
__device__ __forceinline__ void mb_stage_issue(MbStage& st, const bf16_t* gk, const bf16_t* gv, int tid) {
#pragma unroll
    for (int k = 0; k < 4; ++k) { const int i = tid + 512 * k; const size_t o = (size_t)(i >> 3) * 64 + (i & 7) * 8; st.rk[k] = *(const u32x4*)(gk + o); st.rv[k] = *(const u32x4*)(gv + o); }
}
__device__ __forceinline__ void mb_stage_commit(const MbStage& st, LAS unsigned char* lds, int tid) {
#pragma unroll
    for (int k = 0; k < 4; ++k) { const int i = tid + 512 * k; const int o = (i >> 3) * mb::KP_ + (i & 7) * 16; *(LAS u32x4*)(lds + mb::OFF_K + o) = st.rk[k]; *(LAS u32x4*)(lds + mb::OFF_V + o) = st.rv[k]; }
}
__device__ __forceinline__ void mb_granule(const LAS unsigned char* lds, int lane, bf16x8 q0, bf16x8 q1, float mref, int qpos, int nstep, f32x4 (&o)[4], float& l) {
    using namespace mb;
    const int c = lane & 15, g = lane >> 4;
    float ls = 0.f;
#pragma unroll
    for (int dt = 0; dt < 4; ++dt) o[dt] = (f32x4){0.f, 0.f, 0.f, 0.f};
#pragma unroll
    for (int j = 0; j < 8; ++j) {
        if (j < nstep) {
            f32x4 s0 = {0.f, 0.f, 0.f, 0.f}, s1 = {0.f, 0.f, 0.f, 0.f};
            s0 = MFMA16(ld_frag(lds + OFF_K, KP_, 32 * j + c, 8 * g), q0, s0); s0 = MFMA16(ld_frag(lds + OFF_K, KP_, 32 * j + c, 32 + 8 * g), q1, s0);
            s1 = MFMA16(ld_frag(lds + OFF_K, KP_, 32 * j + 16 + c, 8 * g), q0, s1); s1 = MFMA16(ld_frag(lds + OFF_K, KP_, 32 * j + 16 + c, 32 + 8 * g), q1, s1);
#pragma unroll
            for (int r = 0; r < 4; ++r) { float p0 = __builtin_amdgcn_exp2f(s0[r] - mref), p1 = __builtin_amdgcn_exp2f(s1[r] - mref);
                p0 = (32 * j + 4 * g + r > qpos) ? 0.f : p0; p1 = (32 * j + 16 + 4 * g + r > qpos) ? 0.f : p1; s0[r] = p0; s1[r] = p1; ls += p0 + p1; }
            u32x4 w_; w_.x = cvt_pk_bf16(s0[0], s0[1]); w_.y = cvt_pk_bf16(s0[2], s0[3]); w_.z = cvt_pk_bf16(s1[0], s1[1]); w_.w = cvt_pk_bf16(s1[2], s1[3]);
            const bf16x8 pf = __builtin_bit_cast(bf16x8, w_);
#pragma unroll
            for (int dt = 0; dt < 4; ++dt) o[dt] = MFMA16(tr_frag_split(lds + OFF_V, KP_, 32 * j, 16 * dt, lane), pf, o[dt]);
        }
    }
    asm volatile("s_nop 15" : "+v"(o[0]), "+v"(o[1]), "+v"(o[2]), "+v"(o[3]));
    ls += __shfl_xor(ls, 16); ls += __shfl_xor(ls, 32); l = ls;
}
__device__ __forceinline__ float mb_mref(bf16x8 q0, bf16x8 q1, float kam) {
    float s = 0.f;
#pragma unroll
    for (int i = 0; i < 8; ++i) s += fabsf(bf2f((bf16_t)q0[i])) + fabsf(bf2f((bf16_t)q1[i]));
    s += __shfl_xor(s, 16); s += __shfl_xor(s, 32); return s * kam;
}
__device__ __forceinline__ void moba_gate_item(LAS unsigned char* lds, int bh, int bhl, int qb, const bf16_t* Qg, const float* kmeang, unsigned* gcnt, unsigned short* glist) {
    using namespace mb;
    int tid_ = threadIdx.x; asm volatile("" : "+v"(tid_)); const int tid = tid_;
    const size_t pbase = (size_t)bh * SEQ * 64;
    u32x4 rq[4]; float rkm[4];
#pragma unroll
    for (int k = 0; k < 4; ++k) { const int i = tid + 512 * k; rq[k] = *(const u32x4*)(Qg + pbase + (size_t)256 * qb * 64 + (size_t)(i >> 3) * 64 + (i & 7) * 8); rkm[k] = (i < qb * 64) ? kmeang[(size_t)bh * NBLK * 64 + i] : 0.f; }
    __syncthreads();
    LAS float* kms = (LAS float*)(lds + OFF_KM);
#pragma unroll
    for (int k = 0; k < 4; ++k) { const int i = tid + 512 * k; *(LAS u32x4*)(lds + OFF_K + (i >> 3) * KP_ + (i & 7) * 16) = rq[k]; kms[i] = rkm[k]; }
    if (tid < 32) ((LAS int*)(lds + OFF_CNT))[tid] = 0;
    __syncthreads();
    const int q = tid >> 1, hf = tid & 1; float qv[32];
#pragma unroll
    for (int k = 0; k < 4; ++k) { const u32x4 w_ = *(const LAS u32x4*)(lds + OFF_K + q * KP_ + hf * 64 + k * 16); f32x4 x0, x1; unpack8(w_, x0, x1);
#pragma unroll
        for (int e = 0; e < 4; ++e) { qv[8 * k + e] = x0[e]; qv[8 * k + 4 + e] = x1[e]; } }
    float v0 = -INFINITY, v1 = -INFINITY, v2 = -INFINITY; int i0 = -1, i1 = -1, i2 = -1;
    for (int n = 0; n < qb; ++n) { float gsum = 0.f; const LAS float* km = kms + n * 64 + hf * 32;
#pragma unroll
        for (int d = 0; d < 32; ++d) gsum += qv[d] * km[d];
        gsum += __shfl_xor(gsum, 1);
        if (gsum > v0) { v2 = v1; i2 = i1; v1 = v0; i1 = i0; v0 = gsum; i0 = n; } else if (gsum > v1) { v2 = v1; i2 = i1; v1 = gsum; i1 = n; } else if (gsum > v2) { v2 = gsum; i2 = n; } }
    int p0 = 0, p1 = 0, p2 = 0; LAS int* cnt = (LAS int*)(lds + OFF_CNT);
    if (hf == 0) {
        if (i0 >= 0) p0 = __hip_atomic_fetch_add(cnt + i0, 1, __ATOMIC_RELAXED, __HIP_MEMORY_SCOPE_WORKGROUP);
        if (i1 >= 0) p1 = __hip_atomic_fetch_add(cnt + i1, 1, __ATOMIC_RELAXED, __HIP_MEMORY_SCOPE_WORKGROUP);
        if (i2 >= 0) p2 = __hip_atomic_fetch_add(cnt + i2, 1, __ATOMIC_RELAXED, __HIP_MEMORY_SCOPE_WORKGROUP);
    }
    __syncthreads();
    if (tid < 32) { const int cn = cnt[tid]; ((LAS int*)(lds + OFF_BASE))[tid] = cn > 0 ? (int)atomicAdd(gcnt + bhl * 32 + tid, (unsigned)cn) : 0; }
    __syncthreads();
    if (hf == 0) {
        const LAS int* base = (const LAS int*)(lds + OFF_BASE); unsigned short* gl = glist + (size_t)bhl * LIST_PER_BH; const unsigned qg = (unsigned)(256 * qb + q);
        if (i0 >= 0) gl[list_off(i0) + base[i0] + p0] = (unsigned short)(qg);
        if (i1 >= 0) gl[list_off(i1) + base[i1] + p1] = (unsigned short)(qg | (1u << 13));
        if (i2 >= 0) gl[list_off(i2) + base[i2] + p2] = (unsigned short)(qg | (2u << 13));
    }
}
__device__ __forceinline__ void moba_part_item(LAS unsigned char* lds, int bh, int bhl, int n, int chunk, const bf16_t* Qg, const bf16_t* Kg, const bf16_t* Vg, const unsigned* kamaxg, const unsigned* gcnt, const unsigned short* glist, bf16_t* PO, float* PL) {
    using namespace mb;
    int tid_ = threadIdx.x; asm volatile("" : "+v"(tid_)); const int tid = tid_, lane = tid & 63, w = __builtin_amdgcn_readfirstlane(tid >> 6), c = lane & 15, g = lane >> 4;
    const int cnt = (int)gcnt[bhl * 32 + n], e0 = 512 * chunk;
    if (e0 >= cnt) return;
    const size_t pbase = (size_t)bh * SEQ * 64;
    MbStage st; mb_stage_issue(st, Kg + pbase + (size_t)256 * n * 64, Vg + pbase + (size_t)256 * n * 64, tid);
    const float kam = __uint_as_float(kamaxg[bh]); const unsigned short* gl = glist + (size_t)bhl * LIST_PER_BH + list_off(n);
    unsigned ent[4]; bool valid[4]; bf16x8 q0[4], q1[4];
#pragma unroll
    for (int k = 0; k < 4; ++k) { const int e = e0 + 16 * (w + 8 * k) + c; valid[k] = e < cnt; ent[k] = gl[valid[k] ? e : e0]; }
#pragma unroll
    for (int k = 0; k < 4; ++k) { const bf16_t* qr = Qg + pbase + (size_t)(ent[k] & 8191) * 64; q0[k] = *(const bf16x8*)(qr + 8 * g); q1[k] = *(const bf16x8*)(qr + 32 + 8 * g); }
    __syncthreads();
    mb_stage_commit(st, lds, tid);
    __syncthreads();
    if (e0 + 16 * w >= cnt) return;
    float mref[4], ls[4]; f32x4 o[4][4];
#pragma unroll
    for (int k = 0; k < 4; ++k) { mref[k] = valid[k] ? mb_mref(q0[k], q1[k], kam) : INFINITY; ls[k] = 0.f;
#pragma unroll
        for (int dt = 0; dt < 4; ++dt) o[k][dt] = (f32x4){0.f, 0.f, 0.f, 0.f}; }
#pragma unroll 1
    for (int j = 0; j < 8; ++j) {
        const bf16x8 ka0 = ld_frag(lds + OFF_K, KP_, 32 * j + c, 8 * g), ka1 = ld_frag(lds + OFF_K, KP_, 32 * j + c, 32 + 8 * g);
        const bf16x8 kb0 = ld_frag(lds + OFF_K, KP_, 32 * j + 16 + c, 8 * g), kb1 = ld_frag(lds + OFF_K, KP_, 32 * j + 16 + c, 32 + 8 * g);
        bf16x8 pf[4];
#pragma unroll
        for (int k = 0; k < 4; ++k) {
            f32x4 s0 = {0.f, 0.f, 0.f, 0.f}, s1 = {0.f, 0.f, 0.f, 0.f};
            s0 = MFMA16(ka0, q0[k], s0); s0 = MFMA16(ka1, q1[k], s0); s1 = MFMA16(kb0, q0[k], s1); s1 = MFMA16(kb1, q1[k], s1);
#pragma unroll
            for (int r = 0; r < 4; ++r) { s0[r] = __builtin_amdgcn_exp2f(s0[r] - mref[k]); s1[r] = __builtin_amdgcn_exp2f(s1[r] - mref[k]); ls[k] += s0[r] + s1[r]; }
            u32x4 w_; w_.x = cvt_pk_bf16(s0[0], s0[1]); w_.y = cvt_pk_bf16(s0[2], s0[3]); w_.z = cvt_pk_bf16(s1[0], s1[1]); w_.w = cvt_pk_bf16(s1[2], s1[3]);
            pf[k] = __builtin_bit_cast(bf16x8, w_); __builtin_amdgcn_sched_barrier(0);
        }
#pragma unroll
        for (int dt = 0; dt < 4; ++dt) { const bf16x8 vf = tr_frag_split(lds + OFF_V, KP_, 32 * j, 16 * dt, lane);
#pragma unroll
            for (int k = 0; k < 4; ++k) o[k][dt] = MFMA16(vf, pf[k], o[k][dt]); }
    }
#pragma unroll
    for (int k = 0; k < 4; ++k) {
        float l = ls[k]; l += __shfl_xor(l, 16); l += __shfl_xor(l, 32);
        if (valid[k]) { const int q = ent[k] & 8191, j = ent[k] >> 13; const size_t slot = ((size_t)bhl * SEQ + q) * 3 + j; bf16_t* po = PO + slot * 64 + 4 * g;
#pragma unroll
            for (int dt = 0; dt < 4; ++dt) { u32x2 w_; w_.x = cvt_pk_bf16(o[k][dt][0], o[k][dt][1]); w_.y = cvt_pk_bf16(o[k][dt][2], o[k][dt][3]); *(u32x2*)(po + 16 * dt) = w_; }
            if (g == 0) PL[slot] = l; }
    }
}
__device__ __forceinline__ void moba_comb_item(LAS unsigned char* lds, int bh, int bhl, int qb, bf16_t* Qg, const bf16_t* Kg, const bf16_t* Vg, const unsigned* kamaxg, const bf16_t* PO, const float* PL) {
    using namespace mb;
    int tid_ = threadIdx.x; asm volatile("" : "+v"(tid_)); const int tid = tid_, lane = tid & 63, w = __builtin_amdgcn_readfirstlane(tid >> 6), c = lane & 15, g = lane >> 4;
    const size_t pbase = (size_t)bh * SEQ * 64;
    MbStage st; mb_stage_issue(st, Kg + pbase + (size_t)256 * qb * 64, Vg + pbase + (size_t)256 * qb * 64, tid);
    const float kam = __uint_as_float(kamaxg[bh]); const int nsel = qb < 3 ? qb : 3;
    bf16x8 q0[2], q1[2];
#pragma unroll
    for (int k = 0; k < 2; ++k) { const int gq = k ? 15 - w : w; const bf16_t* qr = Qg + pbase + (size_t)(256 * qb + 16 * gq + c) * 64; q0[k] = *(const bf16x8*)(qr + 8 * g); q1[k] = *(const bf16x8*)(qr + 32 + 8 * g); }
    __syncthreads();
    mb_stage_commit(st, lds, tid);
    __syncthreads();
#pragma unroll 1
    for (int k = 0; k < 2; ++k) {
        const int gq = k ? 15 - w : w, ql = 16 * gq + c, q = 256 * qb + ql;
        const bf16x8 qa = k ? q0[1] : q0[0], qb_ = k ? q1[1] : q1[0];
        const size_t slot = ((size_t)bhl * SEQ + q) * 3;
        u32x2 pp[3][4]; float pl[3];
#pragma unroll
        for (int j = 0; j < 3; ++j) { const bool on = j < nsel; pl[j] = on ? PL[slot + j] : 0.f; const bf16_t* po = PO + (slot + (on ? j : 0)) * 64 + 4 * g;
#pragma unroll
            for (int dt = 0; dt < 4; ++dt) pp[j][dt] = on ? *(const u32x2*)(po + 16 * dt) : (u32x2){0u, 0u}; }
        const float mref = mb_mref(qa, qb_, kam);
        f32x4 o[4]; float l; mb_granule(lds, lane, qa, qb_, mref, ql, (gq >> 1) + 1, o, l);
#pragma unroll
        for (int j = 0; j < 3; ++j) { l += pl[j];
#pragma unroll
            for (int dt = 0; dt < 4; ++dt) { o[dt][0] += bflo(pp[j][dt].x); o[dt][1] += bfhi(pp[j][dt].x); o[dt][2] += bflo(pp[j][dt].y); o[dt][3] += bfhi(pp[j][dt].y); } }
        const float rl = 1.0f / l; bf16_t* qr = Qg + pbase + (size_t)q * 64;
#pragma unroll
        for (int dt = 0; dt < 4; ++dt) { u32x2 w_; w_.x = cvt_pk_bf16(o[dt][0] * rl, o[dt][1] * rl); w_.y = cvt_pk_bf16(o[dt][2] * rl, o[dt][3] * rl); *(u32x2*)(qr + 16 * dt + 4 * g) = w_; }
    }
}

namespace xa {
constexpr int P = 528;
constexpr int OFF_K = 0, OFF_V = 128 * P, END = 2 * 128 * P;
static_assert(END <= 160 * 1024, "xattn lds");
}
__device__ __forceinline__ void xattn_item(LAS unsigned char* lds, int b, int hx, int tile, const bf16_t* QXg, const bf16_t* KXg, const bf16_t* VXg, bf16_t* OXg) {
    using namespace xa;
    const int tid = threadIdx.x, lane = tid & 63, w = __builtin_amdgcn_readfirstlane(tid >> 6), c = lane & 15, g = lane >> 4;
    const size_t tok = (size_t)b * SEQ + 128 * tile + 16 * w + c;
    bf16x8 qf[8];
#pragma unroll
    for (int ks = 0; ks < 8; ++ks) qf[ks] = *(const bf16x8*)(QXg + tok * D + hx * 256 + 32 * ks + 8 * g);
    f32x4 o[16];
#pragma unroll
    for (int dt = 0; dt < 16; ++dt) o[dt] = (f32x4){0.f, 0.f, 0.f, 0.f};
    float m = -INFINITY, l = 0.f;
    const bf16_t* kb = KXg + (size_t)(b * 4 + hx) * 256 * 256; const bf16_t* vb = VXg + (size_t)(b * 4 + hx) * 256 * 256;
    for (int hb = 0; hb < 2; ++hb) {
        __syncthreads();
#pragma unroll
        for (int k = 0; k < 8; ++k) { const int i = tid + 512 * k, row = i >> 5, pc = i & 31;
            *(LAS u32x4*)(lds + OFF_K + row * P + pc * 16) = *(const u32x4*)(kb + (size_t)(128 * hb + row) * 256 + pc * 8);
            *(LAS u32x4*)(lds + OFF_V + row * P + pc * 16) = *(const u32x4*)(vb + (size_t)(128 * hb + row) * 256 + pc * 8); }
        __syncthreads();
        f32x4 s[8]; float mx = -INFINITY;
#pragma unroll
        for (int t = 0; t < 8; ++t) { f32x4 acc = {0.f, 0.f, 0.f, 0.f};
#pragma unroll
            for (int ks = 0; ks < 8; ++ks) acc = MFMA16(ld_frag(lds + OFF_K, P, 16 * t + c, 32 * ks + 8 * g), qf[ks], acc);
            s[t] = acc; mx = fmaxf(mx, fmaxf(fmaxf(acc[0], acc[1]), fmaxf(acc[2], acc[3]))); }
        mx = fmaxf(mx, __shfl_xor(mx, 16)); mx = fmaxf(mx, __shfl_xor(mx, 32));
        const float mn = fmaxf(m, mx), alpha = __builtin_amdgcn_exp2f(m - mn); m = mn;
        float ls = 0.f;
#pragma unroll
        for (int t = 0; t < 8; ++t)
#pragma unroll
            for (int r = 0; r < 4; ++r) { const float p = __builtin_amdgcn_exp2f(s[t][r] - mn); s[t][r] = p; ls += p; }
        ls += __shfl_xor(ls, 16); ls += __shfl_xor(ls, 32);
        l = l * alpha + ls;
#pragma unroll
        for (int dt = 0; dt < 16; ++dt) o[dt] = o[dt] * alpha;
#pragma unroll
        for (int j = 0; j < 4; ++j) {
            u32x4 w_; w_.x = cvt_pk_bf16(s[2 * j][0], s[2 * j][1]); w_.y = cvt_pk_bf16(s[2 * j][2], s[2 * j][3]); w_.z = cvt_pk_bf16(s[2 * j + 1][0], s[2 * j + 1][1]); w_.w = cvt_pk_bf16(s[2 * j + 1][2], s[2 * j + 1][3]);
            const bf16x8 pf = __builtin_bit_cast(bf16x8, w_);
#pragma unroll
            for (int dt = 0; dt < 16; ++dt) o[dt] = MFMA16(tr_frag_split(lds + OFF_V, P, 32 * j, 16 * dt, lane), pf, o[dt]);
        }
    }
    const float rl = 1.0f / l;
#pragma unroll
    for (int dt = 0; dt < 16; ++dt) { u32x2 w_; w_.x = cvt_pk_bf16(o[dt][0] * rl, o[dt][1] * rl); w_.y = cvt_pk_bf16(o[dt][2] * rl, o[dt][3] * rl); *(u32x2*)(OXg + tok * D + hx * 256 + 16 * dt + 4 * g) = w_; }
}

struct Args {
    const float* x; const float* mem; const int* pos; const float* g_mix; const float* w_in; const float* lbl; const float* g_hgrn; const float* w_bra; const float* w_brh; const float* w_out;
    const float* g_x; const float* g_mem; const float* wq; const float* wkv; const float* wo; const float* g_ffn; const float* w_ffi; const float* w_ffo; const float* g_fin;
    float* out; unsigned char* ws; int ph_lo, ph_hi;
};

template <class MapFn>
__device__ __forceinline__ void wt_item(const float* W, int ldw, const float* gain, bf16_t* WT, int ldwt, int koff, int nblk, int item, LAS float* scr, int lane, MapFn colmap) {
    const int kb = item / nblk, nb = item % nblk, k0 = 64 * kb, n0 = 32 * nb;
    const int col = colmap(n0 + (lane & 31));
    float wv[32];
#pragma unroll
    for (int i = 0; i < 32; ++i) wv[i] = W[(size_t)(k0 + 2 * i + (lane >> 5)) * ldw + col];
    if (gain) {
#pragma unroll
        for (int i = 0; i < 32; ++i) wv[i] *= gain[k0 + 2 * i + (lane >> 5)]; }
#pragma unroll
    for (int i = 0; i < 32; ++i) scr[(2 * i + (lane >> 5)) * 33 + (lane & 31)] = wv[i];
    asm volatile("s_waitcnt lgkmcnt(0)" ::: "memory");
    const int c = lane & 7;
#pragma unroll
    for (int j = 0; j < 4; ++j) { const int n = (lane >> 3) + 8 * j; const LAS float* s = scr + (8 * c) * 33 + n;
        u32x4 o; o.x = cvt_pk_bf16(s[0 * 33], s[1 * 33]); o.y = cvt_pk_bf16(s[2 * 33], s[3 * 33]); o.z = cvt_pk_bf16(s[4 * 33], s[5 * 33]); o.w = cvt_pk_bf16(s[6 * 33], s[7 * 33]);
        *(u32x4*)(WT + (size_t)(n0 + n) * ldwt + koff + k0 + 8 * c) = o; }
    asm volatile("s_waitcnt lgkmcnt(0)" ::: "memory");
}
__device__ __forceinline__ int zmap(int n) {
    const int tile = n >> 8, p = n & 255, bj = p >> 7, wc = (p >> 5) & 3, nn = (p >> 4) & 1, fq = (p >> 2) & 3, j = p & 3;
    if (tile < 8) return 256 * tile + 64 * (2 * bj + (wc >> 1)) + 32 * nn + 16 * (wc & 1) + 4 * fq + j;
    if (tile < 12) return 2048 + 256 * (tile - 8) + perm8(p);
    if (tile < 20) return (bj ? 4096 : 3072) + 128 * (tile - 12) + (perm8(p) & 127);
    if (tile < 24) return 5120 + 256 * (tile - 20) + perm8(p);
    return 6144 + 256 * (tile - 24) + perm8(p);
}
__device__ __forceinline__ void norm_row_bf16(const float* xrow, const float* g, bf16_t* orow, int lane) {
    f32x4 v[4]; float s = 0.f;
#pragma unroll
    for (int j = 0; j < 4; ++j) { v[j] = ((const f32x4*)xrow)[lane + 64 * j]; s += (v[j][0] * v[j][0] + v[j][1] * v[j][1]) + (v[j][2] * v[j][2] + v[j][3] * v[j][3]); }
    const float rstd = rsqrtf(wave_sum(s) * (1.0f / D) + EPS);
#pragma unroll
    for (int j = 0; j < 4; ++j) { const f32x4 gg = ((const f32x4*)g)[lane + 64 * j]; u32x2 w; w.x = cvt_pk_bf16(v[j][0] * rstd * gg[0], v[j][1] * rstd * gg[1]); w.y = cvt_pk_bf16(v[j][2] * rstd * gg[2], v[j][3] * rstd * gg[3]);
        ((u32x2*)orow)[lane + 64 * j] = w; }
}
__device__ __forceinline__ void sincos_acc(float ang, float& sn, float& cs) {
    const double a = (double)ang; const double q = __builtin_rint(a * 0.6366197723675814);
    const double t = __builtin_fma(-q, 1.5707963267948966, a) - q * 6.123233995736766e-17;
    const double t2 = t * t;
    double sp = -2.5052108385441720e-08; sp = sp * t2 + 2.7557319223985893e-06; sp = sp * t2 - 1.9841269841269841e-04; sp = sp * t2 + 8.3333333333333332e-03; sp = sp * t2 - 1.6666666666666666e-01; sp = sp * t2 * t + t;
    double cp = 2.0876756987868099e-09; cp = cp * t2 - 2.7557319223985888e-07; cp = cp * t2 + 2.4801587301587302e-05; cp = cp * t2 - 1.3888888888888889e-03; cp = cp * t2 + 4.1666666666666664e-02; cp = cp * t2 - 0.5; cp = cp * t2 + 1.0;
    const int qi = ((int)q) & 3;
    const double s_ = (qi & 1) ? cp : sp, c_ = (qi & 1) ? sp : cp;
    sn = (float)((qi & 2) ? -s_ : s_); cs = (float)(((qi == 1) || (qi == 2)) ? -c_ : c_);
}

constexpr int LDS_BYTES = 160 * 1024;
__global__ void __launch_bounds__(512, 2) mega_fwd(Args a) {
    extern __shared__ __attribute__((aligned(16))) unsigned char lds_raw[];
    LAS unsigned char* lds = (LAS unsigned char*)lds_raw;
    const int tid = threadIdx.x, lane = tid & 63, wave = __builtin_amdgcn_readfirstlane(tid >> 6);
    const int G = gridDim.x, bx = blockIdx.x;
    const int vcu = (G % 8 == 0) ? (bx % 8) * (G / 8) + bx / 8 : bx;
    const int gw = vcu * 8 + wave, NGW = G * 8;
#define kmean ((float*)(a.ws + CTL_KMEAN))
#define kamax ((unsigned*)(a.ws + CTL_KAMAX))
#define ssq1 ((float*)(a.ws + CTL_SSQ1))
#define ssq2 ((float*)(a.ws + CTL_SSQ2))
#define ssq3 ((float*)(a.ws + CTL_SSQ3))
#define WZ ((bf16_t*)(a.ws + WS_WZ))
#define WG ((bf16_t*)(a.ws + WS_WG))
#define WBR ((bf16_t*)(a.ws + WS_WBR))
#define WOUT ((bf16_t*)(a.ws + WS_WOUT))
#define WQ ((bf16_t*)(a.ws + WS_WQ))
#define WKV ((bf16_t*)(a.ws + WS_WKV))
#define WO ((bf16_t*)(a.ws + WS_WO))
#define WFI ((bf16_t*)(a.ws + WS_WFI))
#define WFO ((bf16_t*)(a.ws + WS_WFO))
#define RC ((float*)(a.ws + WS_RC))
#define RS ((float*)(a.ws + WS_RS))
#define MEMN ((bf16_t*)(a.ws + WS_MEMN))
#define KX ((bf16_t*)(a.ws + WS_KX))
#define VX ((bf16_t*)(a.ws + WS_VX))
#define E1 ((float*)(a.ws + WS_E1))
#define E2 ((float*)(a.ws + WS_E2))
#define XN ((bf16_t*)(a.ws + WS_XN))
#define HB XN
#define QP ((bf16_t*)(a.ws + WS_Q))
#define QX QP
#define QI ((bf16_t*)(a.ws + WS_QI))
#define OX QI
#define KI ((bf16_t*)(a.ws + WS_KI))
#define RAT KI
#define VB ((bf16_t*)(a.ws + WS_VB))
#define SGB VB
#define OG ((bf16_t*)(a.ws + WS_OG))
#define MG OG
#define ACT ((bf16_t*)(a.ws + WS_ACT))
#define KP ((bf16_t*)a.out)
#define VP ((bf16_t*)((unsigned char*)a.out + 64 * MiB))
#define H (a.out)
    cg::grid_group grid = cg::this_grid();
    const int lo = a.ph_lo, hi = a.ph_hi;
#ifndef PH_MASK
#define PH_MASK 0xfff
#endif
#define IN(k) (((PH_MASK >> (k)) & 1) && lo <= (k) && (k) < hi)
#define XBAR(word, count) do { asm volatile("s_waitcnt vmcnt(0)" ::: "memory"); __syncthreads(); \
        if (tid == 0) { unsigned* bw_ = (unsigned*)(a.ws + WS_CTL) + 64 * (word); __builtin_amdgcn_fence(__ATOMIC_RELEASE, "agent"); asm volatile("s_waitcnt vmcnt(0)" ::: "memory"); \
            __hip_atomic_fetch_add(bw_, 1u, __ATOMIC_RELAXED, __HIP_MEMORY_SCOPE_AGENT); \
            while (__hip_atomic_load(bw_, __ATOMIC_RELAXED, __HIP_MEMORY_SCOPE_AGENT) < (unsigned)(count)) __builtin_amdgcn_s_sleep(2); \
            __builtin_amdgcn_fence(__ATOMIC_ACQUIRE, "agent"); asm volatile("s_waitcnt vmcnt(0)" ::: "memory"); } \
        __syncthreads(); } while (0)
#define SEAM(k) do { if (IN(k) && IN((k) + 1)) { if (a.ph_lo < 0) grid.sync(); else XBAR(100 + (k), G); } } while (0)
#ifndef DUP_MASK
#define DUP_MASK 0
#endif
#define REPS(k) for (int rep_ = 0; rep_ < (((DUP_MASK >> (k)) & 1) ? 2 : 1); ++rep_)

    if (IN(0)) {
        LAS float* scr = (LAS float*)(lds + wave * 16384);
        constexpr int I_Z = 16 * (ZN / 32), I_G = 16 * 64, I_BR = 16 * 32, I_SQ = 16 * 32, I_KV = 16 * 64, I_FI = 16 * 176, I_FO = 44 * 32;
        constexpr int NITEMS = I_Z + I_G + 2 * I_BR + 3 * I_SQ + I_KV + I_FI + I_FO;
        for (int it = gw; it < NITEMS; it += NGW) {
            int r = it;
            if (r < I_Z) { wt_item(a.w_in, 9216, nullptr, WZ, 1024, 0, ZN / 32, r, scr, lane, [](int n) { return zmap(n); }); continue; } r -= I_Z;
            if (r < I_G) { wt_item(a.w_in, 9216, nullptr, WG, 1024, 0, 64, r, scr, lane, [](int n) { const int p = n & 255; return ((p >> 7) ? 8192 : 7168) + 128 * (n >> 8) + (perm8(p) & 127); }); continue; } r -= I_G;
            if (r < I_BR) { wt_item(a.w_bra, 1024, nullptr, WBR, 2048, 0, 32, r, scr, lane, [](int n) { return (n & ~255) + perm8(n & 255); }); continue; } r -= I_BR;
            if (r < I_BR) { wt_item(a.w_brh, 1024, nullptr, WBR, 2048, 1024, 32, r, scr, lane, [](int n) { return (n & ~255) + perm8(n & 255); }); continue; } r -= I_BR;
            if (r < I_SQ) { wt_item(a.w_out, 1024, nullptr, WOUT, 1024, 0, 32, r, scr, lane, [](int n) { return n; }); continue; } r -= I_SQ;
            if (r < I_SQ) { wt_item(a.wq, 1024, a.g_x, WQ, 1024, 0, 32, r, scr, lane, [](int n) { return (n & ~255) + perm8(n & 255); }); continue; } r -= I_SQ;
            if (r < I_SQ) { wt_item(a.wo, 1024, nullptr, WO, 1024, 0, 32, r, scr, lane, [](int n) { return n; }); continue; } r -= I_SQ;
            if (r < I_KV) { wt_item(a.wkv, 2048, nullptr, WKV, 1024, 0, 64, r, scr, lane, [](int n) { return (n & ~255) + perm8(n & 255); }); continue; } r -= I_KV;
            if (r < I_FI) { wt_item(a.w_ffi, 2 * FFN, a.g_ffn, WFI, 1024, 0, 176, r, scr, lane, [](int n) { const int p = n & 255; return ((p >> 7) ? FFN : 0) + 128 * (n >> 8) + (perm8(p) & 127); }); continue; } r -= I_FI;
            wt_item(a.w_ffo, 1024, nullptr, WFO, FFN, 0, 32, r, scr, lane, [](int n) { return n; });
        }
        for (int m = gw; m < T; m += 2 * NGW) {
            const int m2 = m + NGW; f32x4 v0[4], v1[4]; float s0 = 0.f, s1 = 0.f;
#pragma unroll
            for (int j = 0; j < 4; ++j) { v0[j] = ((const f32x4*)(a.x + (size_t)m * D))[lane + 64 * j]; v1[j] = ((const f32x4*)(a.x + (size_t)m2 * D))[lane + 64 * j]; }
#pragma unroll
            for (int j = 0; j < 4; ++j) { s0 += (v0[j][0] * v0[j][0] + v0[j][1] * v0[j][1]) + (v0[j][2] * v0[j][2] + v0[j][3] * v0[j][3]); s1 += (v1[j][0] * v1[j][0] + v1[j][1] * v1[j][1]) + (v1[j][2] * v1[j][2] + v1[j][3] * v1[j][3]); }
            const float r0 = rsqrtf(wave_sum(s0) * (1.0f / D) + EPS), r1 = rsqrtf(wave_sum(s1) * (1.0f / D) + EPS);
#pragma unroll
            for (int j = 0; j < 4; ++j) { const f32x4 gg = ((const f32x4*)a.g_mix)[lane + 64 * j]; const f32x4 a0 = v0[j] * r0 * gg, a1 = v1[j] * r1 * gg; u32x2 w0, w1;
                w0.x = cvt_pk_bf16(a0[0], a0[1]); w0.y = cvt_pk_bf16(a0[2], a0[3]); w1.x = cvt_pk_bf16(a1[0], a1[1]); w1.y = cvt_pk_bf16(a1[2], a1[3]);
                ((u32x2*)(XN + (size_t)m * D))[lane + 64 * j] = w0; ((u32x2*)(XN + (size_t)m2 * D))[lane + 64 * j] = w1; }
        }
        for (int m = gw; m < NB * NMEM; m += NGW) norm_row_bf16(a.mem + (size_t)m * D, a.g_mem, MEMN + (size_t)m * D, lane);
        for (int i = bx * 512 + tid; i < T * 32; i += G * 512) {
            const int tok = i >> 5, f = i & 31;
            const float inv = powf(10000.0f, -(float)(2 * f) * (1.0f / 64.0f));
            const float ang = (float)a.pos[tok] * inv;
            float sn, cs; sincos_acc(ang, sn, cs); RC[i] = cs; RS[i] = sn;
        }
    }
    SEAM(0);
    if (IN(1)) {

        const EpiZ Z{QP, KP, VP, QI, KI, VB, OG, E1, E2, RC, RS, kmean, kamax, a.lbl};
#define ZSEC(EPI, einit, tile0, ntile) { pg8::Gemm g{pg8::a_rowmajor(XN, D), WZ + (size_t)(tile0) * 256 * D, T, (ntile) * 256, D}; pg8::StaticOrder S; S.init(T, (ntile) * 256, G, bx); \
            const EPI E einit; pg8::gemm_phase<EPI, true>(lds, g, S, E); }
        ZSEC(EpiRope<false>, {Z}, 0, 4)
        ZSEC(EpiRope<true>, {Z}, 4, 4)
        ZSEC(EpiPlane<false>, ({Z, VP}), 8, 4)
        ZSEC(EpiQF, {Z}, 12, 8)
        ZSEC(EpiPlane<false>, ({Z, VB}), 20, 4)
        ZSEC(EpiPlane<true>, ({Z, OG}), 24, 4)
        { pg8::Gemm g{pg8::a_rowmajor(MEMN, D), WKV, NB * NMEM, 2 * D, D}; pg8::StaticOrder S; S.init(NB * NMEM, 2 * D, G, (bx + 128) % G);
          EpiKV E{KX, VX};
          pg8::gemm_phase<EpiKV, true>(lds, g, S, E); }
    #if (DUP_MASK >> 1) & 1
        ZSEC(EpiRope<false>, {Z}, 0, 4)
        ZSEC(EpiRope<true>, {Z}, 4, 4)
        ZSEC(EpiPlane<false>, ({Z, VP}), 8, 4)
        ZSEC(EpiQF, {Z}, 12, 8)
        ZSEC(EpiPlane<false>, ({Z, VB}), 20, 4)
        ZSEC(EpiPlane<true>, ({Z, OG}), 24, 4)
        { pg8::Gemm g{pg8::a_rowmajor(MEMN, D), WKV, NB * NMEM, 2 * D, D}; pg8::StaticOrder S; S.init(NB * NMEM, 2 * D, G, (bx + 128) % G);
          EpiKV E{KX, VX};
          pg8::gemm_phase<EpiKV, true>(lds, g, S, E); }
    #endif
#undef ZSEC
    }
    SEAM(1);
    if (IN(2)) {
#if STAGE_HGRN
#ifndef PROBE_P2
#define PROBE_P2 0
#endif
#ifndef PROBE_MB
#define PROBE_MB 0
#endif
        bf16_t* const DUMMY = (bf16_t*)(a.ws + 456 * MiB);
#if PROBE_P2 == 1
        if (bx < NB * BH) hgrn_item(lds, bx / BH, bx % BH, QI, (bf16_t*)(a.ws + 510 * MiB), (size_t)((1u << 20) - 1), KI, VB, OG, E1, E2, a.g_hgrn);
#endif
        if (bx < NB * BH) hgrn_item(lds, bx / BH, bx % BH, QI, QI, ~(size_t)0, KI, VB, OG, E1, E2, a.g_hgrn);
#else
        if (bx < NB * BH) {
            const int b = bx / BH, h = bx % BH;
            LAS float* Sst = (LAS float*)lds;
            LAS bf16_t* qs = (LAS bf16_t*)(lds + 65536);
            LAS bf16_t* ks = qs + 64 * 128; LAS bf16_t* vs = ks + 64 * 128;
            LAS float* Am = (LAS float*)(lds + 65536 + 49152);
            LAS float* e1s = Am + 64 * 65; LAS float* e2s = e1s + 128; LAS float* rss = e2s + 128;
            for (int i = tid; i < 128 * 128; i += 512) Sst[i] = 0.f;
            const size_t pl0 = ((size_t)(b * 16 + 2 * h)) * SEQ * 64, pl1 = pl0 + (size_t)SEQ * 64;
            for (int c = 0; c < NCH; ++c) {
                __syncthreads();
                for (int i = tid; i < 64 * 16; i += 512) {
                    const int t = i >> 4, pc = i & 15; const size_t src = (pc < 8 ? pl0 : pl1) + ((size_t)(64 * c + t)) * 64 + (pc & 7) * 8;
                    *(LAS u32x4*)(qs + t * 128 + pc * 8) = *(const u32x4*)(QI + src);
                    *(LAS u32x4*)(ks + t * 128 + pc * 8) = *(const u32x4*)(KI + src);
                    *(LAS u32x4*)(vs + t * 128 + pc * 8) = *(const u32x4*)(VB + src);
                }
                if (tid < 128) { const size_t eo = (((size_t)(b * BH + h)) * NCH + c) * 128 + tid; e1s[tid] = E1[eo]; e2s[tid] = E2[eo]; }
                if (tid < 64) rss[tid] = 0.f;
                __syncthreads();
#pragma unroll 1
                for (int i = 0; i < 8; ++i) { const int idx = tid + 512 * i, t = idx >> 6, s = idx & 63; float av = 0.f;
                    if (s <= t) { for (int d = 0; d < 128; ++d) av += bf2f(qs[t * 128 + d]) * bf2f(ks[s * 128 + d]); }
                    Am[t * 65 + s] = av; }
                __syncthreads();
                float o[16];
#pragma unroll
                for (int i = 0; i < 16; ++i) { const int idx = tid + 512 * i, t = idx >> 7, dv = idx & 127; float ov = 0.f;
                    for (int d = 0; d < 128; ++d) ov += bf2f(qs[t * 128 + d]) * e1s[d] * Sst[d * 128 + dv];
                    for (int s = 0; s <= t; ++s) ov += Am[t * 65 + s] * bf2f(vs[s * 128 + dv]);
                    o[i] = ov; const float ws_ = wave_sum(ov * ov); if (lane == 0) atomicAdd((float*)(rss + t), ws_); }
                __syncthreads();
#pragma unroll
                for (int i = 0; i < 16; ++i) { const int idx = tid + 512 * i, t = idx >> 7, dv = idx & 127;
                    const size_t dst = (dv < 64 ? pl0 : pl1) + ((size_t)(64 * c + t)) * 64 + (dv & 63);
                    const float val = o[i] * rsqrtf(rss[t] * (1.0f / 128.0f) + EPS) * a.g_hgrn[h * 128 + dv] * bf2f(OG[dst]);
                    QI[dst] = f2bf(val); }
#pragma unroll 1
                for (int i = 0; i < 32; ++i) { const int idx = tid + 512 * i, d = idx >> 7, dv = idx & 127; float sv = e1s[d] * Sst[idx];
                    for (int s = 0; s < 64; ++s) sv += bf2f(ks[s * 128 + d]) * bf2f(vs[s * 128 + dv]);
                    Sst[idx] = e2s[d] * sv; }
            }
            __syncthreads();
        }
#endif
#if STAGE_MOBA
        if (bx >= NB * BH) {
            unsigned* ctl = (unsigned*)(a.ws + WS_CTL);
            LAS int* tk = (LAS int*)(lds + LDS_BYTES - 16);
            const unsigned nmb = (unsigned)(G - NB * BH);
            unsigned* gcnt_all = ctl + 4096;
            bf16_t* PO = (bf16_t*)(a.ws + mb::WS_PO); float* PL = (float*)(a.ws + mb::WS_PL); unsigned short* GL = (unsigned short*)(a.ws + mb::WS_LIST);
#define MB_BARRIER(word) do { asm volatile("s_waitcnt vmcnt(0)" ::: "memory"); __syncthreads(); \
                if (tid == 0) { __builtin_amdgcn_fence(__ATOMIC_RELEASE, "agent"); asm volatile("s_waitcnt vmcnt(0)" ::: "memory");     \
                    __hip_atomic_fetch_add(ctl + 64 * (word), 1u, __ATOMIC_RELAXED, __HIP_MEMORY_SCOPE_AGENT); \
                    while (__hip_atomic_load(ctl + 64 * (word), __ATOMIC_RELAXED, __HIP_MEMORY_SCOPE_AGENT) < nmb) __builtin_amdgcn_s_sleep(2); \
                    __builtin_amdgcn_fence(__ATOMIC_ACQUIRE, "agent"); asm volatile("s_waitcnt vmcnt(0)" ::: "memory"); } \
                __syncthreads(); } while (0)
            const int mbi = bx - NB * BH;
#define MB_QUEUE(word, total, ...) do { for (int r_ = 0;; ++r_) { const int k = r_ * (int)nmb + ((r_ & 1) ? (int)nmb - 1 - mbi : mbi); if (r_ * (int)nmb >= (total)) break; if (k < (total)) { __VA_ARGS__ } } } while (0)
            LAS int* pfx = (LAS int*)(lds + LDS_BYTES - 4096);
            MB_QUEUE(1, 16 * 31, {
                const int bhl = k & 15, qb = 31 - (k >> 4), bh = (bhl >> 2) * 16 + (bhl & 3);
                moba_gate_item(lds, bh, bhl, qb, QP, kmean, gcnt_all, GL); });
            MB_BARRIER(16);
            for (int pass = 0; pass < 4; ++pass) {
                unsigned* gcnt = gcnt_all + pass * 512;
                { __syncthreads();
                  int v = (int)((gcnt[(tid & 15) * 32 + (tid >> 4)] + 511u) >> 9);
#pragma unroll
                  for (int o = 1; o < 64; o <<= 1) { const int t_ = __shfl_up(v, o); if (lane >= o) v += t_; }
                  LAS int* wtot = pfx + 512;
                  if (lane == 63) wtot[wave] = v;
                  __syncthreads();
                  int add = 0;
#pragma unroll
                  for (int w_ = 0; w_ < 8; ++w_) add += (w_ < wave) ? wtot[w_] : 0;
                  pfx[tid] = v + add;
                  __syncthreads(); }
                const int nitems = pfx[511];
                MB_QUEUE(2 + 2 * pass, nitems, {
                    int lo_ = 0, hi_ = 511;
                    while (lo_ < hi_) { const int mid = (lo_ + hi_) >> 1; if (pfx[mid] > k) hi_ = mid; else lo_ = mid + 1; }
                    const int n = lo_ >> 4, bhl = lo_ & 15, chunk = k - (lo_ ? pfx[lo_ - 1] : 0), bh = (bhl >> 2) * 16 + 4 * pass + (bhl & 3);
                    moba_part_item(lds, bh, bhl, n, chunk, QP, KP, VP, kamax, gcnt, GL, PO, PL); });
                MB_BARRIER(17 + 2 * pass);
#if PROBE_MB == 1
                MB_QUEUE(40 + pass, nitems, {
                    int lo_ = 0, hi_ = 511;
                    while (lo_ < hi_) { const int mid = (lo_ + hi_) >> 1; if (pfx[mid] > k) hi_ = mid; else lo_ = mid + 1; }
                    const int n = lo_ >> 4, bhl = lo_ & 15, chunk = k - (lo_ ? pfx[lo_ - 1] : 0), bh = (bhl >> 2) * 16 + 4 * pass + (bhl & 3);
                    moba_part_item(lds, bh, bhl, n, chunk, QP, KP, VP, kamax, gcnt, GL, PO, PL); });
                MB_BARRIER(50 + pass);
#endif
                MB_QUEUE(3 + 2 * pass, 16 * 32 + (pass < 3 ? 16 * 31 : 0), {
                    if (k < 16 * 32) { const int bhl = k & 15, qb = 31 - (k >> 4), bh = (bhl >> 2) * 16 + 4 * pass + (bhl & 3);
                        moba_comb_item(lds, bh, bhl, qb, QP, KP, VP, kamax, PO, PL); }
                    else { const int k2 = k - 16 * 32, bhl = k2 & 15, qb = 31 - (k2 >> 4), bh = (bhl >> 2) * 16 + 4 * (pass + 1) + (bhl & 3);
                        moba_gate_item(lds, bh, bhl, qb, QP, kmean, gcnt_all + (pass + 1) * 512, GL); } });
                MB_BARRIER(18 + 2 * pass);
            }
#undef MB_QUEUE
#undef MB_BARRIER
        }
#else
        {
            LAS float* psh = (LAS float*)(lds + wave * 4608); LAS float* qsh = psh + 1024;
            for (int it = gw; it < NB * AH * SEQ; it += NGW) {
                const int bh = it >> 13, q = it & (SEQ - 1), qb = q >> 8;
                const size_t prow = ((size_t)bh * SEQ + q) * 64;
                qsh[lane] = bf2f(QP[prow + lane]);
                asm volatile("s_waitcnt lgkmcnt(0)" ::: "memory");
                float gate = -INFINITY;
                if (lane < qb) { float gsum = 0.f; const float* km = kmean + ((size_t)bh * NBLK + lane) * 64;
                    for (int d = 0; d < 64; ++d) gsum += qsh[d] * km[d];
                    gate = gsum; }
                int sel[3];
#pragma unroll
                for (int j = 0; j < 3; ++j) {
                    float bv = gate; int bi = lane;
#pragma unroll
                    for (int o = 1; o < 64; o <<= 1) { const float ov = __shfl_xor(bv, o); const int oi = __shfl_xor(bi, o); if (ov > bv || (ov == bv && oi < bi)) { bv = ov; bi = oi; } }
                    sel[j] = (bv > -INFINITY) ? bi : -1;
                    if (lane == bi) gate = -INFINITY;
                }
                const int nown = q - 256 * qb + 1; int nsel = 0;
#pragma unroll
                for (int j = 0; j < 3; ++j) nsel += (sel[j] >= 0) ? 1 : 0;
                const int nk = nown + 256 * nsel;
                float mx = -INFINITY;
                for (int i = lane; i < nk; i += 64) {
                    int key;
                    if (i < nown) key = 256 * qb + i; else { const int jj = (i - nown) >> 8; const int blk = jj == 0 ? sel[0] : (jj == 1 ? sel[1] : sel[2]); key = 256 * blk + ((i - nown) & 255); }
                    const u32x4* kr = (const u32x4*)(KP + ((size_t)bh * SEQ + key) * 64); float sc = 0.f;
#pragma unroll
                    for (int c = 0; c < 8; ++c) { const u32x4 w = kr[c]; f32x4 x0, x1; unpack8(w, x0, x1);
#pragma unroll
                        for (int e = 0; e < 4; ++e) sc += x0[e] * qsh[8 * c + e] + x1[e] * qsh[8 * c + 4 + e]; }
                    psh[i] = sc; mx = fmaxf(mx, sc);
                }
                mx = wave_max(mx);
                float lsum = 0.f;
                for (int i = lane; i < nk; i += 64) { const float p = exp2f(psh[i] - mx); psh[i] = p; lsum += p; }
                lsum = wave_sum(lsum);
                asm volatile("s_waitcnt lgkmcnt(0)" ::: "memory");
                float ov = 0.f;
                for (int i = 0; i < nown; ++i) ov += psh[i] * bf2f(VP[((size_t)bh * SEQ + 256 * qb + i) * 64 + lane]);
                for (int jj = 0; jj < nsel; ++jj) { const int blk = jj == 0 ? sel[0] : (jj == 1 ? sel[1] : sel[2]); const bf16_t* vb = VP + ((size_t)bh * SEQ + 256 * blk) * 64 + lane; const LAS float* pp = psh + nown + 256 * jj;
                    for (int i = 0; i < 256; ++i) ov += pp[i] * bf2f(vb[(size_t)i * 64]); }
                QP[prow + lane] = f2bf(ov / lsum);
            }
        }
#endif
    }
    SEAM(2);
    if (IN(3)) {
        pg8::Gemm g{pg8::a_rowmajor(XN, D), WG, T, 2 * D, D}; pg8::PairOrder S; S.base.init(T, D, G, bx);
        EpiGate E{RAT, SGB};
        pg8::gemm_phase<EpiGate, true, pg8::PairOrder>(lds, g, S, E);
        asm volatile("s_waitcnt vmcnt(0)" ::: "memory"); __syncthreads();
    }
    if (IN(4)) {
        {
        pg8::AView av; av.b0 = (const char*)QP; av.b1 = (const char*)QI - 16 * MiB; av.tsplit = 16; av.bstride = 16 * MiB; av.tstride = 256 * 64 * 2; av.kstride = 1 * MiB; av.lda = 64;
        pg8::Gemm g{av, WBR, T, D, 2 * D}; pg8::StaticOrder S; S.init(T, D, G, bx);
        EpiMerged E{RAT, SGB, MG};
        pg8::gemm_phase<EpiMerged, true>(lds, g, S, E);
            }
#if (DUP_MASK >> 4) & 1
        {
        pg8::AView av; av.b0 = (const char*)QP; av.b1 = (const char*)QI - 16 * MiB; av.tsplit = 16; av.bstride = 16 * MiB; av.tstride = 256 * 64 * 2; av.kstride = 1 * MiB; av.lda = 64;
        pg8::Gemm g{av, WBR, T, D, 2 * D}; pg8::StaticOrder S; S.init(T, D, G, bx);
        EpiMerged E{RAT, SGB, MG};
        pg8::gemm_phase<EpiMerged, true>(lds, g, S, E);
            }
#endif
    }
    SEAM(4);
    if (IN(5)) {
        pg8::Gemm g{pg8::a_rowmajor(MG, D), WOUT, T, D, D}; pg8::StaticOrder S; S.init(T, D, G, bx);
        EpiRes<false> E{a.x, HB, ssq1};
        pg8::gemm_phase<EpiRes<false>, true>(lds, g, S, E);
    }
    SEAM(5);
    if (IN(6)) {
        {
        pg8::Gemm g{pg8::a_rowmajor(HB, D), WQ, T, D, D}; pg8::StaticOrder S; S.init(T, D, G, bx);
        EpiScaleRow E{ssq1, QX, XSCALE};
        pg8::gemm_phase<EpiScaleRow, true>(lds, g, S, E);
#if STAGE_XATTN
        asm volatile("s_waitcnt vmcnt(0)" ::: "memory"); __syncthreads();
        { pg8::Unit u; for (int i = 0; S.next(i, u); ++i) { xattn_item(lds, u.pm >> 5, u.pn, 2 * (u.pm & 31), QX, KX, VX, OX); xattn_item(lds, u.pm >> 5, u.pn, 2 * (u.pm & 31) + 1, QX, KX, VX, OX); } }
#endif
            }
#if (DUP_MASK >> 6) & 1
        {
        pg8::Gemm g{pg8::a_rowmajor(HB, D), WQ, T, D, D}; pg8::StaticOrder S; S.init(T, D, G, bx);
        EpiScaleRow E{ssq1, QX, XSCALE};
        pg8::gemm_phase<EpiScaleRow, true>(lds, g, S, E);
#if STAGE_XATTN
        asm volatile("s_waitcnt vmcnt(0)" ::: "memory"); __syncthreads();
        { pg8::Unit u; for (int i = 0; S.next(i, u); ++i) { xattn_item(lds, u.pm >> 5, u.pn, 2 * (u.pm & 31), QX, KX, VX, OX); xattn_item(lds, u.pm >> 5, u.pn, 2 * (u.pm & 31) + 1, QX, KX, VX, OX); } }
#endif
            }
#endif
    }
#if !STAGE_XATTN
    SEAM(6);
#endif
    if (IN(7)) {
#if STAGE_XATTN
#else
        LAS float* qsh = (LAS float*)(lds + wave * 2048); LAS float* psh = qsh + 256;
        for (int it = gw; it < T * XH; it += NGW) {
            const int tok = it >> 2, hx = it & 3, b = tok >> 13;
            { const u32x2 w = *(const u32x2*)(QX + (size_t)tok * D + hx * 256 + 4 * lane); qsh[4 * lane] = bflo(w.x); qsh[4 * lane + 1] = bfhi(w.x); qsh[4 * lane + 2] = bflo(w.y); qsh[4 * lane + 3] = bfhi(w.y); }
            asm volatile("s_waitcnt lgkmcnt(0)" ::: "memory");
            const bf16_t* kb = KX + (size_t)(b * 4 + hx) * 256 * 256; const bf16_t* vb = VX + (size_t)(b * 4 + hx) * 256 * 256;
            float sc[4]; float mx = -INFINITY;
#pragma unroll
            for (int i = 0; i < 4; ++i) { const u32x4* kr = (const u32x4*)(kb + (size_t)(lane + 64 * i) * 256); float s_ = 0.f;
#pragma unroll 2
                for (int c = 0; c < 32; ++c) { const u32x4 w = kr[c]; f32x4 x0, x1; unpack8(w, x0, x1);
#pragma unroll
                    for (int e = 0; e < 4; ++e) s_ += x0[e] * qsh[8 * c + e] + x1[e] * qsh[8 * c + 4 + e]; }
                sc[i] = s_; mx = fmaxf(mx, s_); }
            mx = wave_max(mx); float lsum = 0.f;
#pragma unroll
            for (int i = 0; i < 4; ++i) { const float p = exp2f(sc[i] - mx); psh[lane + 64 * i] = p; lsum += p; }
            lsum = wave_sum(lsum);
            asm volatile("s_waitcnt lgkmcnt(0)" ::: "memory");
            f32x4 ov = {0.f, 0.f, 0.f, 0.f};
#pragma unroll 4
            for (int m = 0; m < 256; ++m) { const u32x2 w = *(const u32x2*)(vb + (size_t)m * 256 + 4 * lane); const float p = psh[m]; ov[0] += p * bflo(w.x); ov[1] += p * bfhi(w.x); ov[2] += p * bflo(w.y); ov[3] += p * bfhi(w.y); }
            const float rl = 1.0f / lsum; u32x2 w; w.x = cvt_pk_bf16(ov[0] * rl, ov[1] * rl); w.y = cvt_pk_bf16(ov[2] * rl, ov[3] * rl);
            *(u32x2*)(OX + (size_t)tok * D + hx * 256 + 4 * lane) = w;
        }
#endif
    }
    SEAM(7);
    if (IN(8)) {
        pg8::Gemm g{pg8::a_rowmajor(OX, D), WO, T, D, D}; pg8::StaticOrder S; S.init(T, D, G, bx);
        EpiRes<true> E{HB, HB, ssq2};
        pg8::gemm_phase<EpiRes<true>, true>(lds, g, S, E);
    }
    SEAM(8);
    if (IN(9)) {
        pg8::Gemm g{pg8::a_rowmajor(HB, D), WFI, T, 2 * FFN, D}; pg8::StaticOrder S; S.init(T, 2 * FFN, G, bx);
        EpiSwiglu E{ssq2, ACT};
        pg8::gemm_phase<EpiSwiglu, true>(lds, g, S, E);
    }
    SEAM(9);
    if (IN(10)) {
        pg8::Gemm g{pg8::a_rowmajor(ACT, FFN), WFO, T, D, FFN}; pg8::StaticOrder S; S.init(T, D, G, bx);
        EpiRes<true> E{HB, HB, ssq3};
        pg8::gemm_phase<EpiRes<true>, true>(lds, g, S, E);
    }
    SEAM(10);
    if (IN(11)) {
        for (int m = gw; m < T; m += NGW) {
            const float rstd = rsqrtf(ssq3[m] * (1.0f / D) + EPS); const u32x2* hrow = (const u32x2*)(HB + (size_t)m * D); f32x4* row = (f32x4*)(a.out + (size_t)m * D);
#pragma unroll
            for (int j = 0; j < 4; ++j) { const f32x4 gg = ((const f32x4*)a.g_fin)[lane + 64 * j]; const u32x2 w = hrow[lane + 64 * j];
                row[lane + 64 * j] = (f32x4){bflo(w.x), bfhi(w.x), bflo(w.y), bfhi(w.y)} * rstd * gg; }
        }
    }
#undef IN
#undef SEAM
}
#undef kmean
#undef kamax
#undef ssq1
#undef ssq2
#undef ssq3
#undef WZ
#undef WG
#undef WBR
#undef WOUT
#undef WQ
#undef WKV
#undef WO
#undef WFI
#undef WFO
#undef RC
#undef RS
#undef MEMN
#undef KX
#undef VX
#undef E1
#undef E2
#undef XN
#undef HB
#undef QP
#undef QX
#undef QI
#undef OX
#undef KI
#undef RAT
#undef VB
#undef SGB
#undef OG
#undef MG
#undef ACT
#undef KP
#undef VP
#undef H

constexpr int N_PHASES = 12;
extern "C" void kernel_launch(void* const* d_in, const int* in_sizes, int n_in, void* d_out, int out_size, void* d_ws, size_t ws_size, hipStream_t stream) {
    static int grid = 0;
    if (grid == 0) {
        if (n_in != 19 || in_sizes[0] != T * D || out_size != T * D || ws_size < WS_END) { fprintf(stderr, "kernel_launch: unexpected shapes (n_in %d, in0 %d, out %d, ws %zu)\n", n_in, n_in > 0 ? in_sizes[0] : -1, out_size, ws_size); grid = -1; return; }
        int dev = 0, cus = 0, per_cu = 0;
        hipGetDevice(&dev); hipDeviceGetAttribute(&cus, hipDeviceAttributeMultiprocessorCount, dev);
        hipFuncSetAttribute((const void*)mega_fwd, hipFuncAttributeMaxDynamicSharedMemorySize, LDS_BYTES);
        if (hipOccupancyMaxActiveBlocksPerMultiprocessor(&per_cu, (const void*)mega_fwd, 512, LDS_BYTES) != hipSuccess || per_cu < 1) { fprintf(stderr, "kernel_launch: occupancy query says %d blocks/CU\n", per_cu); per_cu = 1; }
        (void)hipGetLastError();
        grid = cus;
    }
    if (grid < 0) return;
    hipMemsetAsync((char*)d_ws + WS_CTL, 0, CTL_ZERO_BYTES, stream);
    Args a{};
    a.x = (const float*)d_in[0]; a.mem = (const float*)d_in[1]; a.pos = (const int*)d_in[2]; a.g_mix = (const float*)d_in[3]; a.w_in = (const float*)d_in[4]; a.lbl = (const float*)d_in[5];
    a.g_hgrn = (const float*)d_in[6]; a.w_bra = (const float*)d_in[7]; a.w_brh = (const float*)d_in[8]; a.w_out = (const float*)d_in[9]; a.g_x = (const float*)d_in[10]; a.g_mem = (const float*)d_in[11];
    a.wq = (const float*)d_in[12]; a.wkv = (const float*)d_in[13]; a.wo = (const float*)d_in[14]; a.g_ffn = (const float*)d_in[15]; a.w_ffi = (const float*)d_in[16]; a.w_ffo = (const float*)d_in[17]; a.g_fin = (const float*)d_in[18];
    a.out = (float*)d_out; a.ws = (unsigned char*)d_ws;
#if MK_N_LAUNCHES == 1
    a.ph_lo = 0; a.ph_hi = N_PHASES;
    void* args[] = {&a};
    hipError_t e = hipLaunchCooperativeKernel((const void*)mega_fwd, dim3(grid), dim3(512), args, LDS_BYTES, stream);
    if (e != hipSuccess) fprintf(stderr, "cooperative launch failed: %s (grid %d)\n", hipGetErrorString(e), grid);
#else
    for (int p = 0; p < N_PHASES; ++p) { a.ph_lo = p; a.ph_hi = p + 1; hipLaunchKernelGGL(mega_fwd, dim3(grid), dim3(512), LDS_BYTES, stream, a); }
#endif
}
```

```cpp
#include <hip/hip_runtime.h>
#include <hip/hip_cooperative_groups.h>
#include <cstdio>
#include <cstdint>
namespace cg = cooperative_groups;

#ifndef MK_N_LAUNCHES
#define MK_N_LAUNCHES 1
#endif

#ifndef STAGE_HGRN
#define STAGE_HGRN 1
#endif
#ifndef STAGE_MOBA
#define STAGE_MOBA 1
#endif
#ifndef STAGE_XATTN
#define STAGE_XATTN 1
#endif
#define LAS __attribute__((address_space(3)))
typedef unsigned short bf16_t;
typedef short bf16x8 __attribute__((ext_vector_type(8)));
typedef float f32x4 __attribute__((ext_vector_type(4)));
typedef float f32x2 __attribute__((ext_vector_type(2)));
typedef unsigned u32x4 __attribute__((ext_vector_type(4)));
typedef unsigned u32x2 __attribute__((ext_vector_type(2)));

constexpr int NB = 4, SEQ = 8192, T = NB * SEQ, D = 1024;
constexpr int AH = 16, AHD = 64, NBLK = 32;
constexpr int BH = 8, BDK = 128, BDV = 128, NCH = SEQ / 64;
constexpr int XH = 4, XHD = 256, NMEM = 256;
constexpr int FFN = 2816;
constexpr int ZN = 7168;
constexpr float EPS = 1e-6f;
constexpr float LOG2E = 1.4426950408889634f;
constexpr float QSCALE = 0.125f * LOG2E;
constexpr float XSCALE = 0.0625f * LOG2E;
constexpr float DKS = 0.08838834764831845f;

constexpr size_t MiB = 1u << 20;
constexpr size_t WS_CTL = 0, CTL_ZERO_BYTES = 2 * MiB;
constexpr size_t CTL_KMEAN = 64 * 1024;
constexpr size_t CTL_KAMAX = CTL_KMEAN + 512 * 1024;
constexpr size_t CTL_SSQ1 = 1 * MiB, CTL_SSQ2 = CTL_SSQ1 + 128 * 1024, CTL_SSQ3 = CTL_SSQ2 + 128 * 1024;
constexpr size_t WS_WZ = 4 * MiB, WS_WG = 18 * MiB, WS_WBR = 22 * MiB, WS_WOUT = 26 * MiB, WS_WQ = 28 * MiB, WS_WKV = 30 * MiB, WS_WO = 34 * MiB, WS_WFI = 36 * MiB, WS_WFO = 47 * MiB;
constexpr size_t WS_RC = 53 * MiB, WS_RS = 57 * MiB, WS_MEMN = 61 * MiB, WS_KX = 63 * MiB, WS_VX = 65 * MiB, WS_E1 = 67 * MiB, WS_E2 = 69 * MiB;
constexpr size_t WS_XN = 72 * MiB;
constexpr size_t WS_Q = 136 * MiB;
constexpr size_t WS_QI = 200 * MiB;
constexpr size_t WS_KI = 264 * MiB;
constexpr size_t WS_VB = 328 * MiB;
constexpr size_t WS_OG = 392 * MiB;
constexpr size_t WS_ACT = 264 * MiB;
constexpr size_t WS_END = 512 * MiB;

typedef __bf16 bf16x2_t __attribute__((ext_vector_type(2)));
__device__ __forceinline__ unsigned cvt_pk_bf16(float lo, float hi) { const f32x2 v = {lo, hi}; const bf16x2_t b = __builtin_convertvector(v, bf16x2_t); return __builtin_bit_cast(unsigned, b); }
__device__ __forceinline__ float bf2f(bf16_t h) { return __uint_as_float(((unsigned)h) << 16); }
__device__ __forceinline__ float bflo(unsigned w) { return __uint_as_float(w << 16); }
__device__ __forceinline__ float bfhi(unsigned w) { return __uint_as_float(w & 0xffff0000u); }
__device__ __forceinline__ bf16_t f2bf(float f) { return (bf16_t)(cvt_pk_bf16(f, 0.f) & 0xffffu); }
__device__ __forceinline__ float sigmoidf_(float x) { return __builtin_amdgcn_rcpf(1.0f + __expf(-x)); }
__device__ __forceinline__ float wave_sum(float v) {
#pragma unroll
    for (int o = 1; o < 64; o <<= 1) v += __shfl_xor(v, o);
    return v;
}
__device__ __forceinline__ float wave_max(float v) {
#pragma unroll
    for (int o = 1; o < 64; o <<= 1) v = fmaxf(v, __shfl_xor(v, o));
    return v;
}
__device__ __forceinline__ u32x4 pack8(const f32x4& a, const f32x4& b) { u32x4 w; w.x = cvt_pk_bf16(a[0], a[1]); w.y = cvt_pk_bf16(a[2], a[3]); w.z = cvt_pk_bf16(b[0], b[1]); w.w = cvt_pk_bf16(b[2], b[3]); return w; }
__device__ __forceinline__ void unpack8(const u32x4& w, f32x4& a, f32x4& b) { a = (f32x4){bflo(w.x), bfhi(w.x), bflo(w.y), bfhi(w.y)}; b = (f32x4){bflo(w.z), bfhi(w.z), bflo(w.w), bfhi(w.w)}; }

namespace pg8 {
constexpr int BM = 256, BK = 64, HALF = 128, HTB = HALF * BK * 2, STAGE_BYTES = 8 * HTB, NXCD = 8, WGM = 8;
__host__ __device__ __forceinline__ int lds_byte(int r, int c) { const int st = (r >> 4) * 2 + (c >> 5), rr = r & 15, cc = c & 31, ob = rr * 64 + cc * 2; return st * 1024 + (ob ^ (((ob >> 9) & 1) << 5)); }
__host__ __device__ __forceinline__ void stage_rc(int b, int& R, int& C) { const int st = b / 1024, sb = b % 1024, swz = sb ^ (((sb >> 9) & 1) << 5); R = (st >> 1) * 16 + swz / 64; C = (st & 1) * 32 + (swz % 64) / 2; }
struct Unit { int pm, pn; };
struct AView {
    const char* b0; const char* b1; int tsplit; long bstride, tstride, kstride; int lda;
    __device__ __forceinline__ const char* ptr(int pm, int t) const { return (t < tsplit ? b0 : b1) + (long)(pm >> 5) * bstride + (long)(pm & 31) * tstride + (long)t * kstride; }
};
__device__ __forceinline__ AView a_rowmajor(const void* A, int lda) { AView v; v.b0 = (const char*)A; v.b1 = (const char*)A; v.tsplit = 1 << 30; v.tstride = (long)256 * lda * 2; v.bstride = 32 * v.tstride; v.kstride = 128; v.lda = lda; return v; }
struct Gemm { AView A; const bf16_t* Bt; int M, N, K; };
struct StaticOrder {
    int nM, nN, nwg, G, c;
    __device__ void init(int M, int N, int G_, int c_) { nM = M / BM; nN = N / BM; nwg = nM * nN; G = G_; c = c_; }
    __device__ bool next(int i, Unit& u) const {
        const long L = (long)i * G + c; if (L >= nwg) return false;
        int wgid = (int)L; { const int q = nwg / NXCD, r = nwg % NXCD, xcd = wgid % NXCD, off = wgid / NXCD; wgid = (xcd < r ? xcd * (q + 1) : r * (q + 1) + (xcd - r) * q) + off; }
        const int nig = WGM * nN, gid = wgid / nig, fm = gid * WGM, gsz = (nM - fm) < WGM ? (nM - fm) : WGM;
        u.pm = fm + ((wgid % nig) % gsz); u.pn = (wgid % nig) / gsz; return true;
    }
};
struct PairOrder { StaticOrder base;
    __device__ bool next(int i, Unit& u) const { Unit v; if (!base.next(i >> 1, v)) return false; u.pm = v.pm; u.pn = 2 * v.pn + (i & 1); return true; } };
template <class Epi, bool ALIGN_EPI, class Sched = StaticOrder>
__device__ __forceinline__ void gemm_phase(LAS unsigned char* lds, const Gemm g, const Sched& S, const Epi& E) {
    const int tid = threadIdx.x, wid = __builtin_amdgcn_readfirstlane(tid >> 6), lane = tid & 63, wr = wid >> 2, wc = wid & 3, fr = lane & 15, fq = lane >> 4;
    const int K = g.K, nt = K / BK;
    unsigned voffA[2], voffB[2];
#pragma unroll
    for (int i = 0; i < 2; ++i) { int R, C; stage_rc(tid * 16 + i * 8192, R, C); voffA[i] = (unsigned)(R * g.A.lda + C) * 2u; voffB[i] = (unsigned)(R * K + C) * 2u; }
    const size_t hstepA = (size_t)HALF * g.A.lda * 2, hstepB = (size_t)HALF * K * 2, tstepB = 2 * hstepB, kstep = 128;
    const unsigned ldsw = (unsigned)wid * 1024u;
    const int aoff = lds_byte(wr * 64 + fr, fq * 8), boff = lds_byte(wc * 32 + fr, fq * 8);
#define PG8_SA(b, h) (((b) * 2 + (h)) * HTB)
#define PG8_SB(b, h) ((4 + (b) * 2 + (h)) * HTB)
#define PG8_STAGE(bufoff, gbase, voff) do { _Pragma("unroll") for (int _i = 0; _i < 2; ++_i) \
        __builtin_amdgcn_global_load_lds((const unsigned*)((const char*)(gbase) + (voff)[_i]), (LAS unsigned*)(lds + (bufoff) + ldsw + _i * 8192), 16, 0, 0); } while (0)
#define PG8_LDA(dst, b, h) do { _Pragma("unroll") for (int m = 0; m < 4; ++m) _Pragma("unroll") for (int k = 0; k < 2; ++k) dst[m][k] = *(const LAS bf16x8*)(lds + PG8_SA(b, h) + aoff + m * 2048 + k * 1024); } while (0)
#define PG8_LDB(dst, b, h) do { _Pragma("unroll") for (int n = 0; n < 2; ++n) _Pragma("unroll") for (int k = 0; k < 2; ++k) dst[n][k] = *(const LAS bf16x8*)(lds + PG8_SB(b, h) + boff + n * 2048 + k * 1024); } while (0)
#define PG8_MMA(ai, bj, At, Bt) do { __builtin_amdgcn_s_setprio(1); _Pragma("unroll") for (int m = 0; m < 4; ++m) _Pragma("unroll") for (int n = 0; n < 2; ++n) _Pragma("unroll") for (int k = 0; k < 2; ++k) \
        acc[ai][bj][m][n] = __builtin_amdgcn_mfma_f32_16x16x32_bf16(Bt[n][k], At[m][k], acc[ai][bj][m][n], 0, 0, 0); __builtin_amdgcn_s_setprio(0); } while (0)
#define PG8_WAIT_V(n) asm volatile("s_waitcnt vmcnt(" #n ")" ::: "memory")
#define PG8_WAIT_L(n) asm volatile("s_waitcnt lgkmcnt(" #n ")" ::: "memory")
#define PG8_BAR __builtin_amdgcn_s_barrier()
#define PG8_SCHED __builtin_amdgcn_sched_barrier(0)
    Unit cur, nxt; int ui = 0;
    if (!S.next(0, cur)) return;
    f32x4 acc[2][2][4][2];
#pragma unroll
    for (int a = 0; a < 2; ++a)
#pragma unroll
        for (int b = 0; b < 2; ++b)
#pragma unroll
            for (int m = 0; m < 4; ++m)
#pragma unroll
                for (int n = 0; n < 2; ++n) acc[a][b][m][n] = (f32x4){0.f, 0.f, 0.f, 0.f};
    bf16x8 At[4][2], B0[2][2], B1[2][2];
    const char* cB = (const char*)g.Bt + (size_t)cur.pn * tstepB;
    {
        const char* cA = g.A.ptr(cur.pm, 0); const char* cA1 = g.A.ptr(cur.pm, 1);
        PG8_STAGE(PG8_SB(0, 0), cB, voffB); PG8_STAGE(PG8_SB(0, 1), cB + hstepB, voffB); PG8_STAGE(PG8_SA(0, 0), cA, voffA); PG8_STAGE(PG8_SA(0, 1), cA + hstepA, voffA);
        if (wr == 1) PG8_BAR;
        PG8_WAIT_V(2); PG8_BAR;
        PG8_STAGE(PG8_SB(1, 0), cB + kstep, voffB); PG8_STAGE(PG8_SA(1, 0), cA1, voffA); PG8_STAGE(PG8_SB(1, 1), cB + hstepB + kstep, voffB);
        PG8_WAIT_V(6); PG8_BAR;
    }
    for (;;) {
        const bool has_next = S.next(ui + 1, nxt);
        const int npm = has_next ? nxt.pm : cur.pm;
        const char* nB = has_next ? (const char*)g.Bt + (size_t)nxt.pn * tstepB : cB;
        for (int t = 0; t < nt; t += 2) {
            const bool last = (t == nt - 2);
            if constexpr (Epi::MID) { if (t == (nt >> 1)) E.mid(acc, cur, wr, wc, fr, fq); }
            const char* a1 = g.A.ptr(cur.pm, t + 1);
            const char* a2 = last ? g.A.ptr(npm, 0) : g.A.ptr(cur.pm, t + 2);
            const char* a3 = last ? g.A.ptr(npm, 1) : g.A.ptr(cur.pm, t + 3);
            const char* b2 = last ? nB : cB + (size_t)(t + 2) * kstep;
            const char* b3 = b2 + kstep;
            PG8_LDB(B0, 0, 0); PG8_LDB(B1, 0, 1); PG8_SCHED; PG8_LDA(At, 0, 0); PG8_STAGE(PG8_SA(1, 1), a1 + hstepA, voffA);
            PG8_WAIT_V(8); PG8_WAIT_L(0); PG8_BAR; PG8_MMA(0, 0, At, B0); PG8_MMA(0, 1, At, B1); PG8_BAR; PG8_SCHED;
            PG8_LDA(At, 0, 1); PG8_STAGE(PG8_SB(0, 0), b2, voffB); PG8_STAGE(PG8_SB(0, 1), b2 + hstepB, voffB); PG8_STAGE(PG8_SA(0, 0), a2, voffA);
            PG8_WAIT_V(8); PG8_WAIT_L(0); PG8_BAR; PG8_MMA(1, 0, At, B0); PG8_MMA(1, 1, At, B1); PG8_BAR; PG8_SCHED;
            PG8_LDB(B0, 1, 0); PG8_LDB(B1, 1, 1); PG8_SCHED; PG8_LDA(At, 1, 0); PG8_STAGE(PG8_SA(0, 1), a2 + hstepA, voffA);
            PG8_WAIT_V(8); PG8_WAIT_L(0); PG8_BAR; PG8_MMA(0, 0, At, B0); PG8_MMA(0, 1, At, B1); PG8_BAR; PG8_SCHED;
            PG8_LDA(At, 1, 1); PG8_STAGE(PG8_SB(1, 0), b3, voffB); PG8_STAGE(PG8_SB(1, 1), b3 + hstepB, voffB); PG8_STAGE(PG8_SA(1, 0), a3, voffA);
            PG8_WAIT_V(8); PG8_WAIT_L(0); PG8_BAR; PG8_MMA(1, 0, At, B0); PG8_MMA(1, 1, At, B1); PG8_BAR; PG8_SCHED;
        }
        if constexpr (ALIGN_EPI) { if (wr == 0) PG8_BAR; }
        E(acc, cur, wr, wc, fr, fq);
        if (!has_next) break;
#pragma unroll
        for (int a = 0; a < 2; ++a)
#pragma unroll
            for (int b = 0; b < 2; ++b)
#pragma unroll
                for (int m = 0; m < 4; ++m)
#pragma unroll
                    for (int n = 0; n < 2; ++n) acc[a][b][m][n] = (f32x4){0.f, 0.f, 0.f, 0.f};
        cur = nxt; cB = nB; ++ui;
        if constexpr (ALIGN_EPI) { if (wr == 1) PG8_BAR; }
    }
    PG8_WAIT_V(0);
    if constexpr (!ALIGN_EPI) { if (wr == 0) PG8_BAR; }
    PG8_BAR;
#undef PG8_SA
#undef PG8_SB
#undef PG8_STAGE
#undef PG8_LDA
#undef PG8_LDB
#undef PG8_MMA
#undef PG8_WAIT_V
#undef PG8_WAIT_L
#undef PG8_BAR
#undef PG8_SCHED
}
}
typedef f32x4 Acc[2][2][4][2];

__host__ __device__ __forceinline__ int perm8(int p) { return (p & ~31) | (((p >> 2) & 3) << 3) | (((p >> 4) & 1) << 2) | (p & 3); }

struct EpiZ {
    static constexpr bool MID = false;
    bf16_t *Q, *Kp, *Vp, *QI, *KI, *VB, *OG; float *E1, *E2; const float *rc, *rs; float* kmean; unsigned* kamax; const float* lbl;
    __device__ __forceinline__ void mid(Acc&, const pg8::Unit&, int, int, int, int) const {}
    template <bool ISK> __device__ __forceinline__ void rope_sec(bf16_t* dst, const Acc& acc, const pg8::Unit& u, int wr, int wc, int fr, int fq) const {
        const int pn = u.pn, b = u.pm >> 5, s0 = (u.pm & 31) * 256;
        const int dlo = 16 * (wc & 1) + 4 * fq;
#pragma unroll
        for (int bj = 0; bj < 2; ++bj) {
            const int plane = b * 16 + 4 * (pn & 3) + 2 * bj + (wc >> 1);
            f32x4 slo = {0.f, 0.f, 0.f, 0.f}, shi = {0.f, 0.f, 0.f, 0.f}; float amax = 0.f;
#pragma unroll
            for (int ai = 0; ai < 2; ++ai)
#pragma unroll
                for (int m = 0; m < 4; ++m) {
                    const int s = s0 + 128 * ai + 64 * wr + 16 * m + fr; const size_t tok = (size_t)b * SEQ + s;
                    const f32x4 c4 = *(const f32x4*)(rc + tok * 32 + dlo), s4 = *(const f32x4*)(rs + tok * 32 + dlo);
                    const f32x4 lo = acc[ai][bj][m][0], hi = acc[ai][bj][m][1];
                    f32x4 olo = lo * c4 - hi * s4, ohi = hi * c4 + lo * s4;
                    if (!ISK) { olo = olo * QSCALE; ohi = ohi * QSCALE; }
                    else { slo += olo; shi += ohi;
#pragma unroll
                        for (int j = 0; j < 4; ++j) amax = fmaxf(amax, fmaxf(fabsf(olo[j]), fabsf(ohi[j]))); }
                    bf16_t* p = dst + ((size_t)plane * SEQ + s) * 64 + dlo;
                    u32x2 w0, w1; w0.x = cvt_pk_bf16(olo[0], olo[1]); w0.y = cvt_pk_bf16(olo[2], olo[3]); w1.x = cvt_pk_bf16(ohi[0], ohi[1]); w1.y = cvt_pk_bf16(ohi[2], ohi[3]);
                    *(u32x2*)p = w0; *(u32x2*)(p + 32) = w1;
                }
            if (ISK) {
#pragma unroll
                for (int j = 0; j < 4; ++j) {
#pragma unroll
                    for (int o = 1; o < 16; o <<= 1) { slo[j] += __shfl_xor(slo[j], o); shi[j] += __shfl_xor(shi[j], o); } }
                amax = wave_max(amax);
                if (fr == 0) { float* km = kmean + ((size_t)plane * NBLK + (u.pm & 31)) * 64 + dlo;
#pragma unroll
                    for (int j = 0; j < 4; ++j) { atomicAdd(km + j, slo[j]); atomicAdd(km + 32 + j, shi[j]); } }
                if ((threadIdx.x & 63) == 0) atomicMax(kamax + plane, __float_as_uint(amax));
            }
        }
    }
    template <bool ACT> __device__ __forceinline__ void plane_sec(bf16_t* dst, int pbase, const Acc& acc, const pg8::Unit& u, int wr, int wc, int fr, int fq) const {
        const int b = u.pm >> 5, s0 = (u.pm & 31) * 256, dc0 = 32 * (wc & 1) + 8 * fq;
#pragma unroll
        for (int bj = 0; bj < 2; ++bj) {
            const int plane = b * 16 + pbase + 2 * bj + (wc >> 1);
#pragma unroll
            for (int ai = 0; ai < 2; ++ai)
#pragma unroll
                for (int m = 0; m < 4; ++m) {
                    const int s = s0 + 128 * ai + 64 * wr + 16 * m + fr;
                    f32x4 v0 = acc[ai][bj][m][0], v1 = acc[ai][bj][m][1];
                    if (ACT) {
#pragma unroll
                        for (int j = 0; j < 4; ++j) { v0[j] = v0[j] * sigmoidf_(v0[j]); v1[j] = v1[j] * sigmoidf_(v1[j]); } }
                    *(u32x4*)(dst + ((size_t)plane * SEQ + s) * 64 + dc0) = pack8(v0, v1);
                }
        }
    }
    __device__ __forceinline__ void qf_sec(const Acc& acc, const pg8::Unit& u, int wr, int wc, int fr, int fq) const {
        const int b = u.pm >> 5, s0 = (u.pm & 31) * 256;
        {
            const int h = u.pn, hp = b * 16 + 2 * h + (wc >> 1);
#pragma unroll
            for (int nn = 0; nn < 2; ++nn) {
                const int dc0 = 32 * (wc & 1) + 8 * fq + 4 * nn, lcol = h * 128 + 32 * wc + 8 * fq + 4 * nn;
                float lb[4];
#pragma unroll
                for (int i = 0; i < 4; ++i) { const float l0 = lbl[lcol + i], l1 = lbl[1024 + lcol + i]; lb[i] = 1.0f / (1.0f + __expf(l1 - l0)); }
#pragma unroll
                for (int ai = 0; ai < 2; ++ai) {
                    float bcs[4][4], kk[4][4];
#pragma unroll
                    for (int m = 0; m < 4; ++m)
#pragma unroll
                        for (int i = 0; i < 4; ++i) {
                            const float zf = acc[ai][1][m][nn][i];
                            const float e = __expf(-zf), sg = __builtin_amdgcn_rcpf(1.0f + e);
                            kk[m][i] = (1.0f - lb[i]) * (e * sg);
                            float v = __logf(lb[i] + (1.0f - lb[i]) * sg);
#pragma unroll
                            for (int o = 1; o < 16; o <<= 1) { const float t = __shfl_up(v, o, 16); if (fr >= o) v += t; }
                            bcs[m][i] = v;
                        }
                    float bmid[4], blast[4];
#pragma unroll
                    for (int i = 0; i < 4; ++i) {
                        float base = 0.f;
#pragma unroll
                        for (int m = 0; m < 4; ++m) { const float tot = __shfl(bcs[m][i], 15, 16); bcs[m][i] += base; base += tot; }
                        bmid[i] = __shfl(bcs[1][i], 15, 16); blast[i] = __shfl(bcs[3][i], 15, 16);
                    }
#pragma unroll
                    for (int m = 0; m < 4; ++m) {
                        const int s = s0 + 128 * ai + 64 * wr + 16 * m + fr;
                        f32x4 qv, kv;
#pragma unroll
                        for (int i = 0; i < 4; ++i) {
                            const float zq = acc[ai][0][m][nn][i];
                            const float ex = __expf(bcs[m][i] - bmid[i]);
                            qv[i] = zq * sigmoidf_(zq) * DKS * ex;
                            kv[i] = kk[m][i] * __builtin_amdgcn_rcpf(ex);
                        }
                        const size_t off = ((size_t)hp * SEQ + s) * 64 + dc0;
                        u32x2 wq_, wk_; wq_.x = cvt_pk_bf16(qv[0], qv[1]); wq_.y = cvt_pk_bf16(qv[2], qv[3]); wk_.x = cvt_pk_bf16(kv[0], kv[1]); wk_.y = cvt_pk_bf16(kv[2], kv[3]);
                        *(u32x2*)(QI + off) = wq_; *(u32x2*)(KI + off) = wk_;
                    }
                    if (fr == 15) {
                        const int chunk = (s0 + 128 * ai + 64 * wr) >> 6;
                        const size_t eo = (((size_t)(b * BH + h)) * NCH + chunk) * 128 + 32 * wc + 8 * fq + 4 * nn;
                        f32x4 a0, c0;
#pragma unroll
                        for (int i = 0; i < 4; ++i) { a0[i] = __expf(bmid[i]); c0[i] = __expf(blast[i] - bmid[i]); }
                        *(f32x4*)(E1 + eo) = a0; *(f32x4*)(E2 + eo) = c0;
                    }
                }
            }
        }
    }
};
template <bool ISK> struct EpiRope { static constexpr bool MID = false; EpiZ z;
    __device__ __forceinline__ void mid(Acc&, const pg8::Unit&, int, int, int, int) const {}
    __device__ __forceinline__ void operator()(const Acc& acc, const pg8::Unit& u, int wr, int wc, int fr, int fq) const { z.template rope_sec<ISK>(ISK ? z.Kp : z.Q, acc, u, wr, wc, fr, fq); } };
template <bool ACT> struct EpiPlane { static constexpr bool MID = false; EpiZ z; bf16_t* dst;
    __device__ __forceinline__ void mid(Acc&, const pg8::Unit&, int, int, int, int) const {}
    __device__ __forceinline__ void operator()(const Acc& acc, const pg8::Unit& u, int wr, int wc, int fr, int fq) const { z.template plane_sec<ACT>(dst, 4 * u.pn, acc, u, wr, wc, fr, fq); } };
struct EpiQF { static constexpr bool MID = false; EpiZ z;
    __device__ __forceinline__ void mid(Acc&, const pg8::Unit&, int, int, int, int) const {}
    __device__ __forceinline__ void operator()(const Acc& acc, const pg8::Unit& u, int wr, int wc, int fr, int fq) const { z.qf_sec(acc, u, wr, wc, fr, fq); } };
struct EpiKV {
    static constexpr bool MID = false;
    bf16_t *KX, *VX;
    __device__ __forceinline__ void mid(Acc&, const pg8::Unit&, int, int, int, int) const {}
    __device__ __forceinline__ void operator()(const Acc& acc, const pg8::Unit& u, int wr, int wc, int fr, int fq) const {
        bf16_t* dst = (u.pn < 4 ? KX : VX) + (size_t)(u.pm * 4 + (u.pn & 3)) * 256 * 256;
#pragma unroll
        for (int ai = 0; ai < 2; ++ai)
#pragma unroll
            for (int m = 0; m < 4; ++m) { const int r = 128 * ai + 64 * wr + 16 * m + fr;
#pragma unroll
                for (int bj = 0; bj < 2; ++bj) *(u32x4*)(dst + (size_t)r * 256 + 128 * bj + 32 * wc + 8 * fq) = pack8(acc[ai][bj][m][0], acc[ai][bj][m][1]); }
    }
};
struct EpiGate {
    static constexpr bool MID = false;
    bf16_t *RAT, *SGB;
    __device__ __forceinline__ void mid(Acc&, const pg8::Unit&, int, int, int, int) const {}
    __device__ __forceinline__ void operator()(const Acc& acc, const pg8::Unit& u, int wr, int wc, int fr, int fq) const {
        const int c0 = 128 * u.pn + 32 * wc + 8 * fq;
#pragma unroll
        for (int ai = 0; ai < 2; ++ai)
#pragma unroll
            for (int m = 0; m < 4; ++m) { const size_t r = (size_t)u.pm * 256 + 128 * ai + 64 * wr + 16 * m + fr;
                f32x4 ra[2], sb[2];
#pragma unroll
                for (int n = 0; n < 2; ++n)
#pragma unroll
                    for (int j = 0; j < 4; ++j) { const float ea = __expf(-acc[ai][0][m][n][j]), eb = __expf(-acc[ai][1][m][n][j]); sb[n][j] = __builtin_amdgcn_rcpf(1.0f + eb); ra[n][j] = (1.0f + eb) * __builtin_amdgcn_rcpf(1.0f + ea); }
                *(u32x4*)(RAT + r * D + c0) = pack8(ra[0], ra[1]); *(u32x4*)(SGB + r * D + c0) = pack8(sb[0], sb[1]); }
    }
};
struct EpiMerged {
    static constexpr bool MID = true;
    const bf16_t *RAT, *SGB; bf16_t* MG;
    __device__ __forceinline__ void mid(Acc& acc, const pg8::Unit& u, int wr, int wc, int fr, int fq) const {
        const int c0 = 256 * u.pn + 32 * wc + 8 * fq;
#pragma unroll
        for (int ai = 0; ai < 2; ++ai)
#pragma unroll
            for (int m = 0; m < 4; ++m) { const size_t r = (size_t)u.pm * 256 + 128 * ai + 64 * wr + 16 * m + fr;
#pragma unroll
                for (int bj = 0; bj < 2; ++bj) { const u32x4 wa = *(const u32x4*)(RAT + r * D + c0 + 128 * bj);
                    f32x4 a0, a1; unpack8(wa, a0, a1); acc[ai][bj][m][0] *= a0; acc[ai][bj][m][1] *= a1; }
                asm volatile("" ::: "memory"); }
    }
    __device__ __forceinline__ void operator()(const Acc& acc, const pg8::Unit& u, int wr, int wc, int fr, int fq) const {
        const int c0 = 256 * u.pn + 32 * wc + 8 * fq;
#pragma unroll
        for (int ai = 0; ai < 2; ++ai)
#pragma unroll
            for (int m = 0; m < 4; ++m) { const size_t r = (size_t)u.pm * 256 + 128 * ai + 64 * wr + 16 * m + fr;
#pragma unroll
                for (int bj = 0; bj < 2; ++bj) { const u32x4 wb = *(const u32x4*)(SGB + r * D + c0 + 128 * bj); f32x4 b0, b1; unpack8(wb, b0, b1);
                    *(u32x4*)(MG + r * D + c0 + 128 * bj) = pack8(acc[ai][bj][m][0] * b0, acc[ai][bj][m][1] * b1); } }
    }
};
template <bool RBF> struct EpiRes {
    static constexpr bool MID = false;
    const void* R; bf16_t* Hb; float* ssq;
    __device__ __forceinline__ void mid(Acc&, const pg8::Unit&, int, int, int, int) const {}
    __device__ __forceinline__ void operator()(const Acc& acc, const pg8::Unit& u, int wr, int wc, int fr, int fq) const {
        const int c0 = 256 * u.pn + 32 * wc + 4 * fq;
#pragma unroll
        for (int ai = 0; ai < 2; ++ai)
#pragma unroll
            for (int m = 0; m < 4; ++m) { const size_t r = (size_t)u.pm * 256 + 128 * ai + 64 * wr + 16 * m + fr; float ss = 0.f;
#pragma unroll
                for (int bj = 0; bj < 2; ++bj)
#pragma unroll
                    for (int n = 0; n < 2; ++n) { const size_t off = r * D + c0 + 128 * bj + 16 * n; f32x4 h = acc[ai][bj][m][n];
                        if (RBF) { const u32x2 w = *(const u32x2*)((const bf16_t*)R + off); h[0] += bflo(w.x); h[1] += bfhi(w.x); h[2] += bflo(w.y); h[3] += bfhi(w.y); }
                        else h += *(const f32x4*)((const float*)R + off);
                        ss += (h[0] * h[0] + h[1] * h[1]) + (h[2] * h[2] + h[3] * h[3]);
                        u32x2 w; w.x = cvt_pk_bf16(h[0], h[1]); w.y = cvt_pk_bf16(h[2], h[3]); *(u32x2*)(Hb + off) = w; }
                ss += __shfl_xor(ss, 16); ss += __shfl_xor(ss, 32);
                if (fq == 0) atomicAdd(ssq + r, ss); }
    }
};
struct EpiScaleRow {
    static constexpr bool MID = false;
    const float* ssq; bf16_t* O; float scale;
    __device__ __forceinline__ void mid(Acc&, const pg8::Unit&, int, int, int, int) const {}
    __device__ __forceinline__ void operator()(const Acc& acc, const pg8::Unit& u, int wr, int wc, int fr, int fq) const {
        const int c0 = 256 * u.pn + 32 * wc + 8 * fq;
#pragma unroll
        for (int ai = 0; ai < 2; ++ai)
#pragma unroll
            for (int m = 0; m < 4; ++m) { const size_t r = (size_t)u.pm * 256 + 128 * ai + 64 * wr + 16 * m + fr; const float rs = rsqrtf(ssq[r] * (1.0f / D) + EPS) * scale;
#pragma unroll
                for (int bj = 0; bj < 2; ++bj) *(u32x4*)(O + r * D + c0 + 128 * bj) = pack8(acc[ai][bj][m][0] * rs, acc[ai][bj][m][1] * rs); }
    }
};
struct EpiSwiglu {
    static constexpr bool MID = false;
    const float* ssq; bf16_t* ACT;
    __device__ __forceinline__ void mid(Acc&, const pg8::Unit&, int, int, int, int) const {}
    __device__ __forceinline__ void operator()(const Acc& acc, const pg8::Unit& u, int wr, int wc, int fr, int fq) const {
        const int c0 = 128 * u.pn + 32 * wc + 8 * fq;
#pragma unroll
        for (int ai = 0; ai < 2; ++ai)
#pragma unroll
            for (int m = 0; m < 4; ++m) { const size_t r = (size_t)u.pm * 256 + 128 * ai + 64 * wr + 16 * m + fr; const float rs = rsqrtf(ssq[r] * (1.0f / D) + EPS);
                f32x4 o[2];
#pragma unroll
                for (int n = 0; n < 2; ++n)
#pragma unroll
                    for (int j = 0; j < 4; ++j) { const float gv = acc[ai][0][m][n][j] * rs, uv = acc[ai][1][m][n][j] * rs; o[n][j] = gv * sigmoidf_(gv) * uv; }
                *(u32x4*)(ACT + r * FFN + c0) = pack8(o[0], o[1]); }
    }
};

typedef short s16x4 __attribute__((ext_vector_type(4)));
typedef short v4i16_t __attribute__((ext_vector_type(4)));
__device__ __forceinline__ s16x4 tr_read(const LAS unsigned char* p) { return __builtin_bit_cast(s16x4, __builtin_amdgcn_ds_read_tr16_b64_v4i16((LAS v4i16_t*)p)); }
__device__ __forceinline__ bf16x8 mk8(s16x4 lo, s16x4 hi) { return (bf16x8){lo[0], lo[1], lo[2], lo[3], hi[0], hi[1], hi[2], hi[3]}; }
__device__ __forceinline__ bf16x8 tr_frag(const LAS unsigned char* base, int pitch, int r0, int c0, int lane) {
    const int g = lane >> 4, i = lane & 15; const LAS unsigned char* p = base + (r0 + 8 * g + (i >> 2)) * pitch + (c0 + 4 * (i & 3)) * 2;
    return mk8(tr_read(p), tr_read(p + 4 * pitch));
}
__device__ __forceinline__ bf16x8 tr_frag_split(const LAS unsigned char* base, int pitch, int r0, int c0, int lane) {
    const int g = lane >> 4, i = lane & 15; const LAS unsigned char* p = base + (r0 + 4 * g + (i >> 2)) * pitch + (c0 + 4 * (i & 3)) * 2;
    return mk8(tr_read(p), tr_read(p + 16 * pitch));
}
__device__ __forceinline__ bf16x8 ld_frag(const LAS unsigned char* base, int pitch, int row, int col) { return *(const LAS bf16x8*)(base + row * pitch + col * 2); }
#define MFMA16(A, B, C) __builtin_amdgcn_mfma_f32_16x16x32_bf16((A), (B), (C), 0, 0, 0)
#define LDS_FADD(p, v) ((void)__hip_atomic_fetch_add((LAS float*)(p), (v), __ATOMIC_RELAXED, __HIP_MEMORY_SCOPE_WORKGROUP))

namespace hg {
constexpr int PITCH = 272;
constexpr int TILE = 64 * PITCH, HBUF = 3 * TILE;
constexpr int OFF_SP = 2 * HBUF, OFF_AM = OFF_SP + 128 * PITCH, AMP = 144, OFF_RSS = OFF_AM + 64 * AMP, OFF_E = OFF_RSS + 512, END = OFF_E + 2 * 1024;
static_assert(END <= 160 * 1024, "hgrn lds");
}
__device__ __forceinline__ void hgrn_item(LAS unsigned char* lds, int b, int h, const bf16_t* QIp, bf16_t* OUTp, size_t omask, const bf16_t* KIp, const bf16_t* VBp, const bf16_t* OGp, const float* E1p, const float* E2p, const float* gh) {
    using namespace hg;
    const int tid = threadIdx.x, lane = tid & 63, w = __builtin_amdgcn_readfirstlane(tid >> 6), c = lane & 15, g = lane >> 4;
    const size_t pl0 = ((size_t)(b * 16 + 2 * h)) * SEQ * 64, pl1 = pl0 + (size_t)SEQ * 64;
    const size_t eb = ((size_t)(b * BH + h)) * NCH * 128;
    const int tt = w >> 1, dvh = w & 1;
    f32x4 S[8];
#pragma unroll
    for (int j = 0; j < 8; ++j) S[j] = (f32x4){0.f, 0.f, 0.f, 0.f};
    f32x4 ghv[4];
#pragma unroll
    for (int jj = 0; jj < 4; ++jj) ghv[jj] = *(const f32x4*)(gh + h * 128 + 64 * dvh + 16 * jj + 4 * g);
    const size_t oplane = (dvh ? pl1 : pl0) + (size_t)(16 * tt + c) * 64 + 4 * g;
    u32x4 pq[2], pk[2], pv[2]; float pe = 0.f;
    auto issue = [&](int ch) {
#pragma unroll
        for (int k = 0; k < 2; ++k) { const int i = tid + 512 * k, row = i >> 4, pc = i & 15; const size_t src = (pc < 8 ? pl0 : pl1) + ((size_t)(64 * ch + row)) * 64 + (pc & 7) * 8;
            pq[k] = *(const u32x4*)(QIp + src); pk[k] = *(const u32x4*)(KIp + src); pv[k] = *(const u32x4*)(VBp + src); }
        if (tid < 256) pe = (tid < 128 ? E1p : E2p)[eb + (size_t)ch * 128 + (tid & 127)];
    };
    auto commit = [&](int p) {
        LAS unsigned char* bufp = lds + p * HBUF;
#pragma unroll
        for (int k = 0; k < 2; ++k) { const int i = tid + 512 * k, row = i >> 4, pc = i & 15; const int o = row * PITCH + pc * 16;
            *(LAS u32x4*)(bufp + o) = pq[k]; *(LAS u32x4*)(bufp + TILE + o) = pk[k]; *(LAS u32x4*)(bufp + 2 * TILE + o) = pv[k]; }
        if (tid < 256) ((LAS float*)(lds + OFF_E + p * 1024))[tid] = pe;
    };
    __syncthreads();
    issue(0); commit(0);
    __syncthreads();
    for (int ch = 0; ch < NCH; ++ch) {
        const int p = ch & 1;
        const LAS unsigned char* qb_ = lds + p * HBUF; const LAS unsigned char* kb_ = qb_ + TILE; const LAS unsigned char* vb_ = qb_ + 2 * TILE;
        const LAS float* e1s = (const LAS float*)(lds + OFF_E + p * 1024); const LAS float* e2s = e1s + 128;
        u32x2 ogv[4];
#pragma unroll
        for (int jj = 0; jj < 4; ++jj) ogv[jj] = *(const u32x2*)(OGp + oplane + (size_t)ch * 4096 + 16 * jj);
        issue(ch + 1 < NCH ? ch + 1 : ch);
#pragma unroll
        for (int s2 = 0; s2 < 2; ++s2) {
            const int si = 2 * (w & 1) + s2; f32x4 acc = {0.f, 0.f, 0.f, 0.f};
#pragma unroll
            for (int ks = 0; ks < 4; ++ks) acc = MFMA16(ld_frag(kb_, PITCH, 16 * si + c, 32 * ks + 8 * g), ld_frag(qb_, PITCH, 16 * tt + c, 32 * ks + 8 * g), acc);
#pragma unroll
            for (int r = 0; r < 4; ++r) acc[r] = (16 * si + 4 * g + r > 16 * tt + c) ? 0.f : acc[r];
            u32x2 w_; w_.x = cvt_pk_bf16(acc[0], acc[1]); w_.y = cvt_pk_bf16(acc[2], acc[3]);
            *(LAS u32x2*)(lds + OFF_AM + (16 * tt + c) * AMP + (16 * si + 4 * g) * 2) = w_;
        }
        {
            const f32x4 e1v = *(const LAS f32x4*)(e1s + 16 * w + 4 * g);
#pragma unroll
            for (int j = 0; j < 8; ++j) { S[j] = S[j] * e1v; u32x2 w_; w_.x = cvt_pk_bf16(S[j][0], S[j][1]); w_.y = cvt_pk_bf16(S[j][2], S[j][3]);
                *(LAS u32x2*)(lds + OFF_SP + (16 * j + c) * PITCH + (16 * w + 4 * g) * 2) = w_; }
        }
        __syncthreads();
        f32x4 o[4];
        {
            bf16x8 aq[4], aa[2];
#pragma unroll
            for (int ks = 0; ks < 4; ++ks) aq[ks] = ld_frag(qb_, PITCH, 16 * tt + c, 32 * ks + 8 * g);
#pragma unroll
            for (int j2 = 0; j2 < 2; ++j2) aa[j2] = ld_frag(lds + OFF_AM, AMP, 16 * tt + c, 32 * j2 + 8 * g);
            float ss = 0.f;
#pragma unroll
            for (int jj = 0; jj < 4; ++jj) {
                const int j = 4 * dvh + jj; f32x4 acc = {0.f, 0.f, 0.f, 0.f};
#pragma unroll
                for (int ks = 0; ks < 4; ++ks) acc = MFMA16(ld_frag(lds + OFF_SP, PITCH, 16 * j + c, 32 * ks + 8 * g), aq[ks], acc);
#pragma unroll
                for (int j2 = 0; j2 < 2; ++j2) acc = MFMA16(tr_frag(vb_, PITCH, 32 * j2, 16 * j, lane), aa[j2], acc);
                o[jj] = acc; ss += (acc[0] * acc[0] + acc[1] * acc[1]) + (acc[2] * acc[2] + acc[3] * acc[3]);
            }
            ss += __shfl_xor(ss, 16); ss += __shfl_xor(ss, 32);
            if (g == 0) ((LAS float*)(lds + OFF_RSS))[(16 * tt + c) * 2 + dvh] = ss;
        }
        __syncthreads();
        {
            const LAS float* rp = (const LAS float*)(lds + OFF_RSS) + (16 * tt + c) * 2; const float rs = rsqrtf((rp[0] + rp[1]) * (1.0f / 128.0f) + EPS);
#pragma unroll
            for (int jj = 0; jj < 4; ++jj) { const f32x4 v = o[jj] * rs * ghv[jj]; u32x2 w_;
                w_.x = cvt_pk_bf16(v[0] * bflo(ogv[jj].x), v[1] * bfhi(ogv[jj].x)); w_.y = cvt_pk_bf16(v[2] * bflo(ogv[jj].y), v[3] * bfhi(ogv[jj].y));
                *(u32x2*)(OUTp + ((oplane + (size_t)ch * 4096 + 16 * jj) & omask)) = w_; }
            bf16x8 ak[2];
#pragma unroll
            for (int k2 = 0; k2 < 2; ++k2) ak[k2] = tr_frag(kb_, PITCH, 32 * k2, 16 * w, lane);
            const f32x4 e2v = *(const LAS f32x4*)(e2s + 16 * w + 4 * g);
#pragma unroll
            for (int j = 0; j < 8; ++j) {
#pragma unroll
                for (int k2 = 0; k2 < 2; ++k2) S[j] = MFMA16(ak[k2], tr_frag(vb_, PITCH, 32 * k2, 16 * j, lane), S[j]);
                S[j] = S[j] * e2v;
            }
            commit(p ^ 1);
        }
        __syncthreads();
    }
}

namespace hg {
constexpr int NSEG = 8, SEGCH = NCH / NSEG;
}
__device__ __forceinline__ void hgrn_seg_a(LAS unsigned char* lds, int b, int h, int seg, const bf16_t* QIp, bf16_t* KIp, bf16_t* VBp, const float* E1p, const float* E2p) {
    using namespace hg;
    const int tid = threadIdx.x, lane = tid & 63, w = __builtin_amdgcn_readfirstlane(tid >> 6), c = lane & 15, g = lane >> 4;
    const size_t pl0 = ((size_t)(b * 16 + 2 * h)) * SEQ * 64, pl1 = pl0 + (size_t)SEQ * 64;
    const size_t eb = ((size_t)(b * BH + h)) * NCH * 128;
    const int tt = w >> 1, dvh = w & 1, ch0 = seg * SEGCH;
    f32x4 S[8];
#pragma unroll
    for (int j = 0; j < 8; ++j) S[j] = (f32x4){0.f, 0.f, 0.f, 0.f};
    f32x4 Dv = {1.f, 1.f, 1.f, 1.f};
    const size_t oplane = (dvh ? pl1 : pl0) + (size_t)(16 * tt + c) * 64 + 4 * g;
    u32x4 pq[2], pk[2], pv[2]; float pe = 0.f;
    auto issue = [&](int ch) {
#pragma unroll
        for (int k = 0; k < 2; ++k) { const int i = tid + 512 * k, row = i >> 4, pc = i & 15; const size_t src = (pc < 8 ? pl0 : pl1) + ((size_t)(64 * ch + row)) * 64 + (pc & 7) * 8;
            pq[k] = *(const u32x4*)(QIp + src); pk[k] = *(const u32x4*)(KIp + src); pv[k] = *(const u32x4*)(VBp + src); }
        if (tid < 256) pe = (tid < 128 ? E1p : E2p)[eb + (size_t)ch * 128 + (tid & 127)];
    };
    auto commit = [&](int p) {
        LAS unsigned char* bufp = lds + p * HBUF;
#pragma unroll
        for (int k = 0; k < 2; ++k) { const int i = tid + 512 * k, row = i >> 4, pc = i & 15; const int o = row * PITCH + pc * 16;
            *(LAS u32x4*)(bufp + o) = pq[k]; *(LAS u32x4*)(bufp + TILE + o) = pk[k]; *(LAS u32x4*)(bufp + 2 * TILE + o) = pv[k]; }
        if (tid < 256) ((LAS float*)(lds + OFF_E + p * 1024))[tid] = pe;
    };
    __syncthreads();
    issue(ch0); commit(0);
    __syncthreads();
    for (int cc = 0; cc < SEGCH; ++cc) {
        const int ch = ch0 + cc, p = cc & 1;
        const LAS unsigned char* qb_ = lds + p * HBUF; const LAS unsigned char* kb_ = qb_ + TILE; const LAS unsigned char* vb_ = qb_ + 2 * TILE;
        const LAS float* e1s = (const LAS float*)(lds + OFF_E + p * 1024); const LAS float* e2s = e1s + 128;
        issue(cc + 1 < SEGCH ? ch + 1 : ch);
#pragma unroll
        for (int s2 = 0; s2 < 2; ++s2) {
            const int si = 2 * (w & 1) + s2; f32x4 acc = {0.f, 0.f, 0.f, 0.f};
#pragma unroll
            for (int ks = 0; ks < 4; ++ks) acc = MFMA16(ld_frag(kb_, PITCH, 16 * si + c, 32 * ks + 8 * g), ld_frag(qb_, PITCH, 16 * tt + c, 32 * ks + 8 * g), acc);
#pragma unroll
            for (int r = 0; r < 4; ++r) acc[r] = (16 * si + 4 * g + r > 16 * tt + c) ? 0.f : acc[r];
            u32x2 w_; w_.x = cvt_pk_bf16(acc[0], acc[1]); w_.y = cvt_pk_bf16(acc[2], acc[3]);
            *(LAS u32x2*)(lds + OFF_AM + (16 * tt + c) * AMP + (16 * si + 4 * g) * 2) = w_;
        }
        const f32x4 e1v = *(const LAS f32x4*)(e1s + 16 * w + 4 * g), e2v = *(const LAS f32x4*)(e2s + 16 * w + 4 * g);
#pragma unroll
        for (int j = 0; j < 8; ++j) { S[j] = S[j] * e1v; u32x2 w_; w_.x = cvt_pk_bf16(S[j][0], S[j][1]); w_.y = cvt_pk_bf16(S[j][2], S[j][3]);
            *(LAS u32x2*)(lds + OFF_SP + (16 * j + c) * PITCH + (16 * w + 4 * g) * 2) = w_; }
        Dv = Dv * e1v * e2v;
        __syncthreads();
        {
            bf16x8 aq[4], aa[2];
#pragma unroll
            for (int ks = 0; ks < 4; ++ks) aq[ks] = ld_frag(qb_, PITCH, 16 * tt + c, 32 * ks + 8 * g);
#pragma unroll
            for (int j2 = 0; j2 < 2; ++j2) aa[j2] = ld_frag(lds + OFF_AM, AMP, 16 * tt + c, 32 * j2 + 8 * g);
#pragma unroll
            for (int jj = 0; jj < 4; ++jj) {
                const int j = 4 * dvh + jj; f32x4 acc = {0.f, 0.f, 0.f, 0.f};
#pragma unroll
                for (int ks = 0; ks < 4; ++ks) acc = MFMA16(ld_frag(lds + OFF_SP, PITCH, 16 * j + c, 32 * ks + 8 * g), aq[ks], acc);
#pragma unroll
                for (int j2 = 0; j2 < 2; ++j2) acc = MFMA16(tr_frag(vb_, PITCH, 32 * j2, 16 * j, lane), aa[j2], acc);
                u32x2 w_; w_.x = cvt_pk_bf16(acc[0], acc[1]); w_.y = cvt_pk_bf16(acc[2], acc[3]);
                *(u32x2*)(KIp + oplane + (size_t)ch * 4096 + 16 * jj) = w_;
            }
        }
        {
            bf16x8 ak[2];
#pragma unroll
            for (int k2 = 0; k2 < 2; ++k2) ak[k2] = tr_frag(kb_, PITCH, 32 * k2, 16 * w, lane);
#pragma unroll
            for (int j = 0; j < 8; ++j) {
#pragma unroll
                for (int k2 = 0; k2 < 2; ++k2) S[j] = MFMA16(ak[k2], tr_frag(vb_, PITCH, 32 * k2, 16 * j, lane), S[j]);
                S[j] = S[j] * e2v;
            }
            commit(p ^ 1);
        }
        __syncthreads();
    }
    float* Lg = (float*)(VBp + pl0 + (size_t)seg * SEGCH * 4096); float* Dg = (float*)(VBp + pl1 + (size_t)seg * SEGCH * 4096);
#pragma unroll
    for (int j = 0; j < 8; ++j)
#pragma unroll
        for (int r = 0; r < 4; ++r) Lg[(16 * w + 4 * g + r) * 128 + 16 * j + c] = S[j][r];
    if (c == 0) *(f32x4*)(Dg + 16 * w + 4 * g) = Dv;
}
__device__ __forceinline__ void hgrn_seg_b(LAS unsigned char* lds, int b, int h, int seg, bf16_t* QIp, const bf16_t* KIp, const bf16_t* VBp, const bf16_t* OGp, const float* E1p, const float* E2p, const float* gh) {
    using namespace hg;
    const int tid = threadIdx.x, lane = tid & 63, w = __builtin_amdgcn_readfirstlane(tid >> 6), c = lane & 15, g = lane >> 4;
    const size_t pl0 = ((size_t)(b * 16 + 2 * h)) * SEQ * 64, pl1 = pl0 + (size_t)SEQ * 64;
    const size_t eb = ((size_t)(b * BH + h)) * NCH * 128;
    const int tt = w >> 1, dvh = w & 1, ch0 = seg * SEGCH;
    f32x4 S[8];
#pragma unroll
    for (int j = 0; j < 8; ++j) S[j] = (f32x4){0.f, 0.f, 0.f, 0.f};
    for (int gp = 0; gp < seg; ++gp) {
        const float* Lg = (const float*)(VBp + pl0 + (size_t)gp * SEGCH * 4096); const float* Dg = (const float*)(VBp + pl1 + (size_t)gp * SEGCH * 4096);
        const f32x4 dv_ = *(const f32x4*)(Dg + 16 * w + 4 * g);
#pragma unroll
        for (int j = 0; j < 8; ++j)
#pragma unroll
            for (int r = 0; r < 4; ++r) S[j][r] = dv_[r] * S[j][r] + Lg[(16 * w + 4 * g + r) * 128 + 16 * j + c];
    }
    f32x4 ghv[4];
#pragma unroll
    for (int jj = 0; jj < 4; ++jj) ghv[jj] = *(const f32x4*)(gh + h * 128 + 64 * dvh + 16 * jj + 4 * g);
    const size_t oplane = (dvh ? pl1 : pl0) + (size_t)(16 * tt + c) * 64 + 4 * g;
    const size_t qrow = (size_t)(16 * tt + c) * 64 + 8 * g;
    f32x4 P = {1.f, 1.f, 1.f, 1.f};
    __syncthreads();
    for (int cc = 0; cc < SEGCH; ++cc) {
        const int ch = ch0 + cc;
        bf16x8 qf[4]; u32x2 ol[4], ogv[4];
#pragma unroll
        for (int ks = 0; ks < 4; ++ks) qf[ks] = *(const bf16x8*)(QIp + ((ks >> 1) ? pl1 : pl0) + (size_t)ch * 4096 + qrow + 32 * (ks & 1));
#pragma unroll
        for (int jj = 0; jj < 4; ++jj) { ol[jj] = *(const u32x2*)(KIp + oplane + (size_t)ch * 4096 + 16 * jj); ogv[jj] = *(const u32x2*)(OGp + oplane + (size_t)ch * 4096 + 16 * jj); }
        const f32x4 e1r = *(const f32x4*)(E1p + eb + (size_t)ch * 128 + 16 * w + 4 * g), e2r = *(const f32x4*)(E2p + eb + (size_t)ch * 128 + 16 * w + 4 * g);
        const f32x4 cv = e1r * P;
#pragma unroll
        for (int j = 0; j < 8; ++j) { const f32x4 sv = S[j] * cv; u32x2 w_; w_.x = cvt_pk_bf16(sv[0], sv[1]); w_.y = cvt_pk_bf16(sv[2], sv[3]);
            *(LAS u32x2*)(lds + OFF_SP + (16 * j + c) * PITCH + (16 * w + 4 * g) * 2) = w_; }
        P = P * e1r * e2r;
        __syncthreads();
        f32x4 o[4]; float ss = 0.f;
#pragma unroll
        for (int jj = 0; jj < 4; ++jj) {
            const int j = 4 * dvh + jj; f32x4 acc = {bflo(ol[jj].x), bfhi(ol[jj].x), bflo(ol[jj].y), bfhi(ol[jj].y)};
#pragma unroll
            for (int ks = 0; ks < 4; ++ks) acc = MFMA16(ld_frag(lds + OFF_SP, PITCH, 16 * j + c, 32 * ks + 8 * g), qf[ks], acc);
            o[jj] = acc; ss += (acc[0] * acc[0] + acc[1] * acc[1]) + (acc[2] * acc[2] + acc[3] * acc[3]);
        }
        ss += __shfl_xor(ss, 16); ss += __shfl_xor(ss, 32);
        if (g == 0) ((LAS float*)(lds + OFF_RSS))[(16 * tt + c) * 2 + dvh] = ss;
        __syncthreads();
        const LAS float* rp = (const LAS float*)(lds + OFF_RSS) + (16 * tt + c) * 2; const float rs = rsqrtf((rp[0] + rp[1]) * (1.0f / 128.0f) + EPS);
#pragma unroll
        for (int jj = 0; jj < 4; ++jj) { const f32x4 v = o[jj] * rs * ghv[jj]; u32x2 w_;
            w_.x = cvt_pk_bf16(v[0] * bflo(ogv[jj].x), v[1] * bfhi(ogv[jj].x)); w_.y = cvt_pk_bf16(v[2] * bflo(ogv[jj].y), v[3] * bfhi(ogv[jj].y));
            *(u32x2*)(QIp + oplane + (size_t)ch * 4096 + 16 * jj) = w_; }
    }
}

namespace mb {
constexpr int KP_ = 144;
constexpr int OFF_K = 0, OFF_V = 256 * KP_, OFF_KM = 2 * 256 * KP_, OFF_CNT = OFF_KM + 8192, OFF_BASE = OFF_CNT + 128, END = OFF_BASE + 128;
static_assert(END <= 160 * 1024, "moba lds");
constexpr size_t WS_PO = 264 * MiB, WS_PL = 456 * MiB, WS_LIST = 462 * MiB;
constexpr int LIST_PER_BH = 256 * 496;
static_assert(WS_PO + (size_t)64 * SEQ * 3 * 128 <= WS_PL && WS_PL + (size_t)64 * SEQ * 3 * 4 <= WS_LIST && WS_LIST + (size_t)64 * LIST_PER_BH * 2 <= 512 * MiB, "moba ws");
__device__ __forceinline__ int list_off(int n) { return 256 * (31 * n - (n * (n - 1)) / 2); }
}
__device__ __forceinline__ void mb_stage(LAS unsigned char* dst, const bf16_t* g, int tid) {
    u32x4 r[4];
#pragma unroll
    for (int k = 0; k < 4; ++k) { const int i = tid + 512 * k; r[k] = *(const u32x4*)(g + (size_t)(i >> 3) * 64 + (i & 7) * 8); }
#pragma unroll
    for (int k = 0; k < 4; ++k) { const int i = tid + 512 * k; *(LAS u32x4*)(dst + (i >> 3) * mb::KP_ + (i & 7) * 16) = r[k]; }
}
struct MbStage { u32x4 rk[4], rv[4]; };
__device__ __forceinline__ void mb_stage_issue(MbStage& st, const bf16_t* gk, const bf16_t* gv, int tid) {
#pragma unroll
    for (int k = 0; k < 4; ++k) { const int i = tid + 512 * k; const size_t o = (size_t)(i >> 3) * 64 + (i & 7) * 8; st.rk[k] = *(const u32x4*)(gk + o); st.rv[k] = *(const u32x4*)(gv + o); }
}
__device__ __forceinline__ void mb_stage_commit(const MbStage& st, LAS unsigned char* lds, int tid) {
#pragma unroll
    for (int k = 0; k < 4; ++k) { const int i = tid + 512 * k; const int o = (i >> 3) * mb::KP_ + (i & 7) * 16; *(LAS u32x4*)(lds + mb::OFF_K + o) = st.rk[k]; *(LAS u32x4*)(lds + mb::OFF_V + o) = st.rv[k]; }
}
__device__ __forceinline__ void mb_granule(const LAS unsigned char* lds, int lane, bf16x8 q0, bf16x8 q1, float mref, int qpos, int nstep, f32x4 (&o)[4], float& l) {
    using namespace mb;
    const int c = lane & 15, g = lane >> 4;
    float ls = 0.f;
#pragma unroll
    for (int dt = 0; dt < 4; ++dt) o[dt] = (f32x4){0.f, 0.f, 0.f, 0.f};
#pragma unroll
    for (int j = 0; j < 8; ++j) {
        if (j < nstep) {
            f32x4 s0 = {0.f, 0.f, 0.f, 0.f}, s1 = {0.f, 0.f, 0.f, 0.f};
            s0 = MFMA16(ld_frag(lds + OFF_K, KP_, 32 * j + c, 8 * g), q0, s0); s0 = MFMA16(ld_frag(lds + OFF_K, KP_, 32 * j + c, 32 + 8 * g), q1, s0);
            s1 = MFMA16(ld_frag(lds + OFF_K, KP_, 32 * j + 16 + c, 8 * g), q0, s1); s1 = MFMA16(ld_frag(lds + OFF_K, KP_, 32 * j + 16 + c, 32 + 8 * g), q1, s1);
#pragma unroll
            for (int r = 0; r < 4; ++r) { float p0 = __builtin_amdgcn_exp2f(s0[r] - mref), p1 = __builtin_amdgcn_exp2f(s1[r] - mref);
                p0 = (32 * j + 4 * g + r > qpos) ? 0.f : p0; p1 = (32 * j + 16 + 4 * g + r > qpos) ? 0.f : p1; s0[r] = p0; s1[r] = p1; ls += p0 + p1; }
            u32x4 w_; w_.x = cvt_pk_bf16(s0[0], s0[1]); w_.y = cvt_pk_bf16(s0[2], s0[3]); w_.z = cvt_pk_bf16(s1[0], s1[1]); w_.w = cvt_pk_bf16(s1[2], s1[3]);
            const bf16x8 pf = __builtin_bit_cast(bf16x8, w_);
#pragma unroll
            for (int dt = 0; dt < 4; ++dt) o[dt] = MFMA16(tr_frag_split(lds + OFF_V, KP_, 32 * j, 16 * dt, lane), pf, o[dt]);
        }
    }
    asm volatile("s_nop 15" : "+v"(o[0]), "+v"(o[1]), "+v"(o[2]), "+v"(o[3]));
    ls += __shfl_xor(ls, 16); ls += __shfl_xor(ls, 32); l = ls;
}
__device__ __forceinline__ float mb_mref(bf16x8 q0, bf16x8 q1, float kam) {
    float s = 0.f;
#pragma unroll
    for (int i = 0; i < 8; ++i) s += fabsf(bf2f((bf16_t)q0[i])) + fabsf(bf2f((bf16_t)q1[i]));
    s += __shfl_xor(s, 16); s += __shfl_xor(s, 32); return s * kam;
}
__device__ __forceinline__ void moba_gate_item(LAS unsigned char* lds, int bh, int bhl, int qb, const bf16_t* Qg, const float* kmeang, unsigned* gcnt, unsigned short* glist) {
    using namespace mb;
    int tid_ = threadIdx.x; asm volatile("" : "+v"(tid_)); const int tid = tid_;
    const size_t pbase = (size_t)bh * SEQ * 64;
    u32x4 rq[4]; float rkm[4];
#pragma unroll
    for (int k = 0; k < 4; ++k) { const int i = tid + 512 * k; rq[k] = *(const u32x4*)(Qg + pbase + (size_t)256 * qb * 64 + (size_t)(i >> 3) * 64 + (i & 7) * 8); rkm[k] = (i < qb * 64) ? kmeang[(size_t)bh * NBLK * 64 + i] : 0.f; }
    __syncthreads();
    LAS float* kms = (LAS float*)(lds + OFF_KM);
#pragma unroll
    for (int k = 0; k < 4; ++k) { const int i = tid + 512 * k; *(LAS u32x4*)(lds + OFF_K + (i >> 3) * KP_ + (i & 7) * 16) = rq[k]; kms[i] = rkm[k]; }
    if (tid < 32) ((LAS int*)(lds + OFF_CNT))[tid] = 0;
    __syncthreads();
    const int q = tid >> 1, hf = tid & 1; float qv[32];
#pragma unroll
    for (int k = 0; k < 4; ++k) { const u32x4 w_ = *(const LAS u32x4*)(lds + OFF_K + q * KP_ + hf * 64 + k * 16); f32x4 x0, x1; unpack8(w_, x0, x1);
#pragma unroll
        for (int e = 0; e < 4; ++e) { qv[8 * k + e] = x0[e]; qv[8 * k + 4 + e] = x1[e]; } }
    float v0 = -INFINITY, v1 = -INFINITY, v2 = -INFINITY; int i0 = -1, i1 = -1, i2 = -1;
    for (int n = 0; n < qb; ++n) { float gsum = 0.f; const LAS float* km = kms + n * 64 + hf * 32;
#pragma unroll
        for (int d = 0; d < 32; ++d) gsum += qv[d] * km[d];
        gsum += __shfl_xor(gsum, 1);
        if (gsum > v0) { v2 = v1; i2 = i1; v1 = v0; i1 = i0; v0 = gsum; i0 = n; } else if (gsum > v1) { v2 = v1; i2 = i1; v1 = gsum; i1 = n; } else if (gsum > v2) { v2 = gsum; i2 = n; } }
    int p0 = 0, p1 = 0, p2 = 0; LAS int* cnt = (LAS int*)(lds + OFF_CNT);
    if (hf == 0) {
        if (i0 >= 0) p0 = __hip_atomic_fetch_add(cnt + i0, 1, __ATOMIC_RELAXED, __HIP_MEMORY_SCOPE_WORKGROUP);
        if (i1 >= 0) p1 = __hip_atomic_fetch_add(cnt + i1, 1, __ATOMIC_RELAXED, __HIP_MEMORY_SCOPE_WORKGROUP);
        if (i2 >= 0) p2 = __hip_atomic_fetch_add(cnt + i2, 1, __ATOMIC_RELAXED, __HIP_MEMORY_SCOPE_WORKGROUP);
    }
    __syncthreads();
    if (tid < 32) { const int cn = cnt[tid]; ((LAS int*)(lds + OFF_BASE))[tid] = cn > 0 ? (int)atomicAdd(gcnt + bhl * 32 + tid, (unsigned)cn) : 0; }
    __syncthreads();
    if (hf == 0) {
        const LAS int* base = (const LAS int*)(lds + OFF_BASE); unsigned short* gl = glist + (size_t)bhl * LIST_PER_BH; const unsigned qg = (unsigned)(256 * qb + q);
        if (i0 >= 0) gl[list_off(i0) + base[i0] + p0] = (unsigned short)(qg);
        if (i1 >= 0) gl[list_off(i1) + base[i1] + p1] = (unsigned short)(qg | (1u << 13));
        if (i2 >= 0) gl[list_off(i2) + base[i2] + p2] = (unsigned short)(qg | (2u << 13));
    }
}
__device__ __forceinline__ void moba_part_item(LAS unsigned char* lds, int bh, int bhl, int n, int chunk, const bf16_t* Qg, const bf16_t* Kg, const bf16_t* Vg, const unsigned* kamaxg, const unsigned* gcnt, const unsigned short* glist, bf16_t* PO, float* PL) {
    using namespace mb;
    int tid_ = threadIdx.x; asm volatile("" : "+v"(tid_)); const int tid = tid_, lane = tid & 63, w = __builtin_amdgcn_readfirstlane(tid >> 6), c = lane & 15, g = lane >> 4;
    const int cnt = (int)gcnt[bhl * 32 + n], e0 = 512 * chunk;
    if (e0 >= cnt) return;
    const size_t pbase = (size_t)bh * SEQ * 64;
    MbStage st; mb_stage_issue(st, Kg + pbase + (size_t)256 * n * 64, Vg + pbase + (size_t)256 * n * 64, tid);
    const float kam = __uint_as_float(kamaxg[bh]); const unsigned short* gl = glist + (size_t)bhl * LIST_PER_BH + list_off(n);
    unsigned ent[4]; bool valid[4]; bf16x8 q0[4], q1[4];
#pragma unroll
    for (int k = 0; k < 4; ++k) { const int e = e0 + 16 * (w + 8 * k) + c; valid[k] = e < cnt; ent[k] = gl[valid[k] ? e : e0]; }
#pragma unroll
    for (int k = 0; k < 4; ++k) { const bf16_t* qr = Qg + pbase + (size_t)(ent[k] & 8191) * 64; q0[k] = *(const bf16x8*)(qr + 8 * g); q1[k] = *(const bf16x8*)(qr + 32 + 8 * g); }
    __syncthreads();
    mb_stage_commit(st, lds, tid);
    __syncthreads();
    if (e0 + 16 * w >= cnt) return;
    float mref[4], ls[4]; f32x4 o[4][4];
#pragma unroll
    for (int k = 0; k < 4; ++k) { mref[k] = valid[k] ? mb_mref(q0[k], q1[k], kam) : INFINITY; ls[k] = 0.f;
#pragma unroll
        for (int dt = 0; dt < 4; ++dt) o[k][dt] = (f32x4){0.f, 0.f, 0.f, 0.f}; }
#pragma unroll 1
    for (int j = 0; j < 8; ++j) {
        const bf16x8 ka0 = ld_frag(lds + OFF_K, KP_, 32 * j + c, 8 * g), ka1 = ld_frag(lds + OFF_K, KP_, 32 * j + c, 32 + 8 * g);
        const bf16x8 kb0 = ld_frag(lds + OFF_K, KP_, 32 * j + 16 + c, 8 * g), kb1 = ld_frag(lds + OFF_K, KP_, 32 * j + 16 + c, 32 + 8 * g);
        bf16x8 pf[4];
#pragma unroll
        for (int k = 0; k < 4; ++k) {
            f32x4 s0 = {0.f, 0.f, 0.f, 0.f}, s1 = {0.f, 0.f, 0.f, 0.f};
            s0 = MFMA16(ka0, q0[k], s0); s0 = MFMA16(ka1, q1[k], s0); s1 = MFMA16(kb0, q0[k], s1); s1 = MFMA16(kb1, q1[k], s1);
#pragma unroll
            for (int r = 0; r < 4; ++r) { s0[r] = __builtin_amdgcn_exp2f(s0[r] - mref[k]); s1[r] = __builtin_amdgcn_exp2f(s1[r] - mref[k]); ls[k] += s0[r] + s1[r]; }
            u32x4 w_; w_.x = cvt_pk_bf16(s0[0], s0[1]); w_.y = cvt_pk_bf16(s0[2], s0[3]); w_.z = cvt_pk_bf16(s1[0], s1[1]); w_.w = cvt_pk_bf16(s1[2], s1[3]);
            pf[k] = __builtin_bit_cast(bf16x8, w_); __builtin_amdgcn_sched_barrier(0);
        }
#pragma unroll
        for (int dt = 0; dt < 4; ++dt) { const bf16x8 vf = tr_frag_split(lds + OFF_V, KP_, 32 * j, 16 * dt, lane);
#pragma unroll
            for (int k = 0; k < 4; ++k) o[k][dt] = MFMA16(vf, pf[k], o[k][dt]); }
    }
#pragma unroll
    for (int k = 0; k < 4; ++k) {
        float l = ls[k]; l += __shfl_xor(l, 16); l += __shfl_xor(l, 32);
        if (valid[k]) { const int q = ent[k] & 8191, j = ent[k] >> 13; const size_t slot = ((size_t)bhl * SEQ + q) * 3 + j; bf16_t* po = PO + slot * 64 + 4 * g;
#pragma unroll
            for (int dt = 0; dt < 4; ++dt) { u32x2 w_; w_.x = cvt_pk_bf16(o[k][dt][0], o[k][dt][1]); w_.y = cvt_pk_bf16(o[k][dt][2], o[k][dt][3]); *(u32x2*)(po + 16 * dt) = w_; }
            if (g == 0) PL[slot] = l; }
    }
}
__device__ __forceinline__ void moba_part_phase(LAS unsigned char* lds, const LAS int* pfx, int nitems, int mbi, int nmb, const bf16_t* Qg, const bf16_t* Kg, const bf16_t* Vg, const unsigned* kamaxg, const unsigned* gcnt, const unsigned short* glist, bf16_t* PO, float* PL) {
    using namespace mb;
    int tid_ = threadIdx.x; asm volatile("" : "+v"(tid_)); const int tid = tid_, lane = tid & 63, w = __builtin_amdgcn_readfirstlane(tid >> 6), c = lane & 15, g = lane >> 4;
    MbStage st; unsigned ent[4]; bool valid[4]; int bh = 0, bhl = 0, cnt = 0, e0 = 0; bool have = false;
    auto fetch = [&](int r) {
        const int k = r * nmb + ((r & 1) ? nmb - 1 - mbi : mbi);
        have = (r * nmb < nitems) && (k < nitems);
        if (!have) return;
        int lo_ = 0, hi_ = 2047;
        while (lo_ < hi_) { const int mid = (lo_ + hi_) >> 1; if (pfx[mid] > k) hi_ = mid; else lo_ = mid + 1; }
        const int n = lo_ >> 6; bhl = lo_ & 63; const int chunk = k - (lo_ ? pfx[lo_ - 1] : 0); bh = bhl;
        cnt = (int)gcnt[bhl * 32 + n]; e0 = 512 * chunk;
        const size_t pbase = (size_t)bh * SEQ * 64;
        mb_stage_issue(st, Kg + pbase + (size_t)256 * n * 64, Vg + pbase + (size_t)256 * n * 64, tid);
        const unsigned short* gl = glist + (size_t)bhl * LIST_PER_BH + list_off(n);
#pragma unroll
        for (int k4 = 0; k4 < 4; ++k4) { const int e = e0 + 16 * (w + 8 * k4) + c; valid[k4] = e < cnt; ent[k4] = gl[valid[k4] ? e : e0]; }
    };
    fetch(0);
    for (int r = 0; have; ++r) {
        const int cbh = bh, cbhl = bhl, ccnt = cnt, ce0 = e0; unsigned cent[4]; bool cval[4]; bf16x8 q0[4], q1[4];
        const size_t pbase = (size_t)cbh * SEQ * 64;
#pragma unroll
        for (int k = 0; k < 4; ++k) { cent[k] = ent[k]; cval[k] = valid[k]; const bf16_t* qr = Qg + pbase + (size_t)(cent[k] & 8191) * 64; q0[k] = *(const bf16x8*)(qr + 8 * g); q1[k] = *(const bf16x8*)(qr + 32 + 8 * g); }
        const float kam = __uint_as_float(kamaxg[cbh]);
        __syncthreads();
        mb_stage_commit(st, lds, tid);
        __syncthreads();
        fetch(r + 1);
        if (ce0 + 16 * w < ccnt) {
            float mref[4], ls[4]; f32x4 o[4][4];
#pragma unroll
            for (int k = 0; k < 4; ++k) { mref[k] = cval[k] ? mb_mref(q0[k], q1[k], kam) : INFINITY; ls[k] = 0.f;
#pragma unroll
                for (int dt = 0; dt < 4; ++dt) o[k][dt] = (f32x4){0.f, 0.f, 0.f, 0.f}; }
#pragma unroll 1
            for (int j = 0; j < 8; ++j) {
                const bf16x8 ka0 = ld_frag(lds + OFF_K, KP_, 32 * j + c, 8 * g), ka1 = ld_frag(lds + OFF_K, KP_, 32 * j + c, 32 + 8 * g);
                const bf16x8 kb0 = ld_frag(lds + OFF_K, KP_, 32 * j + 16 + c, 8 * g), kb1 = ld_frag(lds + OFF_K, KP_, 32 * j + 16 + c, 32 + 8 * g);
                bf16x8 pf[4];
#pragma unroll
                for (int k = 0; k < 4; ++k) {
                    f32x4 s0 = {0.f, 0.f, 0.f, 0.f}, s1 = {0.f, 0.f, 0.f, 0.f};
                    s0 = MFMA16(ka0, q0[k], s0); s0 = MFMA16(ka1, q1[k], s0); s1 = MFMA16(kb0, q0[k], s1); s1 = MFMA16(kb1, q1[k], s1);
#pragma unroll
                    for (int rr = 0; rr < 4; ++rr) { s0[rr] = __builtin_amdgcn_exp2f(s0[rr] - mref[k]); s1[rr] = __builtin_amdgcn_exp2f(s1[rr] - mref[k]); ls[k] += s0[rr] + s1[rr]; }
                    u32x4 w_; w_.x = cvt_pk_bf16(s0[0], s0[1]); w_.y = cvt_pk_bf16(s0[2], s0[3]); w_.z = cvt_pk_bf16(s1[0], s1[1]); w_.w = cvt_pk_bf16(s1[2], s1[3]);
                    pf[k] = __builtin_bit_cast(bf16x8, w_); __builtin_amdgcn_sched_barrier(0);
                }
#pragma unroll
                for (int dt = 0; dt < 4; ++dt) { const bf16x8 vf = tr_frag_split(lds + OFF_V, KP_, 32 * j, 16 * dt, lane);
#pragma unroll
                    for (int k = 0; k < 4; ++k) o[k][dt] = MFMA16(vf, pf[k], o[k][dt]); }
            }
#pragma unroll
            for (int k = 0; k < 4; ++k) {
                float l = ls[k]; l += __shfl_xor(l, 16); l += __shfl_xor(l, 32);
                if (cval[k]) { const int q = cent[k] & 8191, j = cent[k] >> 13; const size_t slot = ((size_t)cbhl * SEQ + q) * 3 + j; bf16_t* po = PO + slot * 64 + 4 * g;
#pragma unroll
                    for (int dt = 0; dt < 4; ++dt) { u32x2 w_; w_.x = cvt_pk_bf16(o[k][dt][0], o[k][dt][1]); w_.y = cvt_pk_bf16(o[k][dt][2], o[k][dt][3]); *(u32x2*)(po + 16 * dt) = w_; }
                    if (g == 0) PL[slot] = l; }
            }
        }
    }
}
__device__ __forceinline__ void moba_comb_item(LAS unsigned char* lds, int bh, int bhl, int qb, bf16_t* Qg, const bf16_t* Kg, const bf16_t* Vg, const unsigned* kamaxg, const bf16_t* PO, const float* PL) {
    using namespace mb;
    int tid_ = threadIdx.x; asm volatile("" : "+v"(tid_)); const int tid = tid_, lane = tid & 63, w = __builtin_amdgcn_readfirstlane(tid >> 6), c = lane & 15, g = lane >> 4;
    const size_t pbase = (size_t)bh * SEQ * 64;
    MbStage st; mb_stage_issue(st, Kg + pbase + (size_t)256 * qb * 64, Vg + pbase + (size_t)256 * qb * 64, tid);
    const float kam = __uint_as_float(kamaxg[bh]); const int nsel = qb < 3 ? qb : 3;
    bf16x8 q0[2], q1[2];
#pragma unroll
    for (int k = 0; k < 2; ++k) { const int gq = k ? 15 - w : w; const bf16_t* qr = Qg + pbase + (size_t)(256 * qb + 16 * gq + c) * 64; q0[k] = *(const bf16x8*)(qr + 8 * g); q1[k] = *(const bf16x8*)(qr + 32 + 8 * g); }
    __syncthreads();
    mb_stage_commit(st, lds, tid);
    __syncthreads();
#pragma unroll 1
    for (int k = 0; k < 2; ++k) {
        const int gq = k ? 15 - w : w, ql = 16 * gq + c, q = 256 * qb + ql;
        const bf16x8 qa = k ? q0[1] : q0[0], qb_ = k ? q1[1] : q1[0];
        const size_t slot = ((size_t)bhl * SEQ + q) * 3;
        u32x2 pp[3][4]; float pl[3];
#pragma unroll
        for (int j = 0; j < 3; ++j) { const bool on = j < nsel; pl[j] = on ? PL[slot + j] : 0.f; const bf16_t* po = PO + (slot + (on ? j : 0)) * 64 + 4 * g;
#pragma unroll
            for (int dt = 0; dt < 4; ++dt) pp[j][dt] = on ? *(const u32x2*)(po + 16 * dt) : (u32x2){0u, 0u}; }
        const float mref = mb_mref(qa, qb_, kam);
        f32x4 o[4]; float l; mb_granule(lds, lane, qa, qb_, mref, ql, (gq >> 1) + 1, o, l);
#pragma unroll
        for (int j = 0; j < 3; ++j) { l += pl[j];
#pragma unroll
            for (int dt = 0; dt < 4; ++dt) { o[dt][0] += bflo(pp[j][dt].x); o[dt][1] += bfhi(pp[j][dt].x); o[dt][2] += bflo(pp[j][dt].y); o[dt][3] += bfhi(pp[j][dt].y); } }
        const float rl = 1.0f / l; bf16_t* qr = Qg + pbase + (size_t)q * 64;
#pragma unroll
        for (int dt = 0; dt < 4; ++dt) { u32x2 w_; w_.x = cvt_pk_bf16(o[dt][0] * rl, o[dt][1] * rl); w_.y = cvt_pk_bf16(o[dt][2] * rl, o[dt][3] * rl); *(u32x2*)(qr + 16 * dt + 4 * g) = w_; }
    }
}

namespace xa {
constexpr int P = 528;
constexpr int OFF_K = 0, OFF_V = 128 * P, END = 2 * 128 * P;
static_assert(END <= 160 * 1024, "xattn lds");
}
__device__ __forceinline__ void xattn_item(LAS unsigned char* lds, int b, int hx, int tile, const bf16_t* QXg, const bf16_t* KXg, const bf16_t* VXg, bf16_t* OXg) {
    using namespace xa;
    const int tid = threadIdx.x, lane = tid & 63, w = __builtin_amdgcn_readfirstlane(tid >> 6), c = lane & 15, g = lane >> 4;
    const size_t tok = (size_t)b * SEQ + 128 * tile + 16 * w + c;
    bf16x8 qf[8];
#pragma unroll
    for (int ks = 0; ks < 8; ++ks) qf[ks] = *(const bf16x8*)(QXg + tok * D + hx * 256 + 32 * ks + 8 * g);
    f32x4 o[16];
#pragma unroll
    for (int dt = 0; dt < 16; ++dt) o[dt] = (f32x4){0.f, 0.f, 0.f, 0.f};
    float m = -INFINITY, l = 0.f;
    const bf16_t* kb = KXg + (size_t)(b * 4 + hx) * 256 * 256; const bf16_t* vb = VXg + (size_t)(b * 4 + hx) * 256 * 256;
    for (int hb = 0; hb < 2; ++hb) {
        __syncthreads();
#pragma unroll
        for (int k = 0; k < 8; ++k) { const int i = tid + 512 * k, row = i >> 5, pc = i & 31;
            *(LAS u32x4*)(lds + OFF_K + row * P + pc * 16) = *(const u32x4*)(kb + (size_t)(128 * hb + row) * 256 + pc * 8);
            *(LAS u32x4*)(lds + OFF_V + row * P + pc * 16) = *(const u32x4*)(vb + (size_t)(128 * hb + row) * 256 + pc * 8); }
        __syncthreads();
        f32x4 s[8]; float mx = -INFINITY;
#pragma unroll
        for (int t = 0; t < 8; ++t) { f32x4 acc = {0.f, 0.f, 0.f, 0.f};
#pragma unroll
            for (int ks = 0; ks < 8; ++ks) acc = MFMA16(ld_frag(lds + OFF_K, P, 16 * t + c, 32 * ks + 8 * g), qf[ks], acc);
            s[t] = acc; mx = fmaxf(mx, fmaxf(fmaxf(acc[0], acc[1]), fmaxf(acc[2], acc[3]))); }
        mx = fmaxf(mx, __shfl_xor(mx, 16)); mx = fmaxf(mx, __shfl_xor(mx, 32));
        const float mn = fmaxf(m, mx), alpha = __builtin_amdgcn_exp2f(m - mn); m = mn;
        float ls = 0.f;
#pragma unroll
        for (int t = 0; t < 8; ++t)
#pragma unroll
            for (int r = 0; r < 4; ++r) { const float p = __builtin_amdgcn_exp2f(s[t][r] - mn); s[t][r] = p; ls += p; }
        ls += __shfl_xor(ls, 16); ls += __shfl_xor(ls, 32);
        l = l * alpha + ls;
#pragma unroll
        for (int dt = 0; dt < 16; ++dt) o[dt] = o[dt] * alpha;
#pragma unroll
        for (int j = 0; j < 4; ++j) {
            u32x4 w_; w_.x = cvt_pk_bf16(s[2 * j][0], s[2 * j][1]); w_.y = cvt_pk_bf16(s[2 * j][2], s[2 * j][3]); w_.z = cvt_pk_bf16(s[2 * j + 1][0], s[2 * j + 1][1]); w_.w = cvt_pk_bf16(s[2 * j + 1][2], s[2 * j + 1][3]);
            const bf16x8 pf = __builtin_bit_cast(bf16x8, w_);
#pragma unroll
            for (int dt = 0; dt < 16; ++dt) o[dt] = MFMA16(tr_frag_split(lds + OFF_V, P, 32 * j, 16 * dt, lane), pf, o[dt]);
        }
    }
    const float rl = 1.0f / l;
#pragma unroll
    for (int dt = 0; dt < 16; ++dt) { u32x2 w_; w_.x = cvt_pk_bf16(o[dt][0] * rl, o[dt][1] * rl); w_.y = cvt_pk_bf16(o[dt][2] * rl, o[dt][3] * rl); *(u32x2*)(OXg + tok * D + hx * 256 + 16 * dt + 4 * g) = w_; }
}

struct Args {
    const float* x; const float* mem; const int* pos; const float* g_mix; const float* w_in; const float* lbl; const float* g_hgrn; const float* w_bra; const float* w_brh; const float* w_out;
    const float* g_x; const float* g_mem; const float* wq; const float* wkv; const float* wo; const float* g_ffn; const float* w_ffi; const float* w_ffo; const float* g_fin;
    float* out; unsigned char* ws; int ph_lo, ph_hi;
};

template <class MapFn>
__device__ __forceinline__ void wt_item(const float* W, int ldw, const float* gain, bf16_t* WT, int ldwt, int koff, int nblk, int item, LAS float* scr, int lane, MapFn colmap) {
    const int kb = item / nblk, nb = item % nblk, k0 = 64 * kb, n0 = 32 * nb;
    const int col = colmap(n0 + (lane & 31));
    float wv[32];
#pragma unroll
    for (int i = 0; i < 32; ++i) wv[i] = W[(size_t)(k0 + 2 * i + (lane >> 5)) * ldw + col];
    if (gain) {
#pragma unroll
        for (int i = 0; i < 32; ++i) wv[i] *= gain[k0 + 2 * i + (lane >> 5)]; }
#pragma unroll
    for (int i = 0; i < 32; ++i) scr[(2 * i + (lane >> 5)) * 33 + (lane & 31)] = wv[i];
    asm volatile("s_waitcnt lgkmcnt(0)" ::: "memory");
    const int c = lane & 7;
#pragma unroll
    for (int j = 0; j < 4; ++j) { const int n = (lane >> 3) + 8 * j; const LAS float* s = scr + (8 * c) * 33 + n;
        u32x4 o; o.x = cvt_pk_bf16(s[0 * 33], s[1 * 33]); o.y = cvt_pk_bf16(s[2 * 33], s[3 * 33]); o.z = cvt_pk_bf16(s[4 * 33], s[5 * 33]); o.w = cvt_pk_bf16(s[6 * 33], s[7 * 33]);
        *(u32x4*)(WT + (size_t)(n0 + n) * ldwt + koff + k0 + 8 * c) = o; }
    asm volatile("s_waitcnt lgkmcnt(0)" ::: "memory");
}
__device__ __forceinline__ int zmap(int n) {
    const int tile = n >> 8, p = n & 255, bj = p >> 7, wc = (p >> 5) & 3, nn = (p >> 4) & 1, fq = (p >> 2) & 3, j = p & 3;
    if (tile < 8) return 256 * tile + 64 * (2 * bj + (wc >> 1)) + 32 * nn + 16 * (wc & 1) + 4 * fq + j;
    if (tile < 12) return 2048 + 256 * (tile - 8) + perm8(p);
    if (tile < 20) return (bj ? 4096 : 3072) + 128 * (tile - 12) + (perm8(p) & 127);
    if (tile < 24) return 5120 + 256 * (tile - 20) + perm8(p);
    return 6144 + 256 * (tile - 24) + perm8(p);
}
__device__ __forceinline__ void norm_row_bf16(const float* xrow, const float* g, bf16_t* orow, int lane) {
    f32x4 v[4]; float s = 0.f;
#pragma unroll
    for (int j = 0; j < 4; ++j) { v[j] = ((const f32x4*)xrow)[lane + 64 * j]; s += (v[j][0] * v[j][0] + v[j][1] * v[j][1]) + (v[j][2] * v[j][2] + v[j][3] * v[j][3]); }
    const float rstd = rsqrtf(wave_sum(s) * (1.0f / D) + EPS);
#pragma unroll
    for (int j = 0; j < 4; ++j) { const f32x4 gg = ((const f32x4*)g)[lane + 64 * j]; u32x2 w; w.x = cvt_pk_bf16(v[j][0] * rstd * gg[0], v[j][1] * rstd * gg[1]); w.y = cvt_pk_bf16(v[j][2] * rstd * gg[2], v[j][3] * rstd * gg[3]);
        ((u32x2*)orow)[lane + 64 * j] = w; }
}
__device__ __forceinline__ void sincos_acc(float ang, float& sn, float& cs) {
    const double a = (double)ang; const double q = __builtin_rint(a * 0.6366197723675814);
    const double t = __builtin_fma(-q, 1.5707963267948966, a) - q * 6.123233995736766e-17;
    const double t2 = t * t;
    double sp = -2.5052108385441720e-08; sp = sp * t2 + 2.7557319223985893e-06; sp = sp * t2 - 1.9841269841269841e-04; sp = sp * t2 + 8.3333333333333332e-03; sp = sp * t2 - 1.6666666666666666e-01; sp = sp * t2 * t + t;
    double cp = 2.0876756987868099e-09; cp = cp * t2 - 2.7557319223985888e-07; cp = cp * t2 + 2.4801587301587302e-05; cp = cp * t2 - 1.3888888888888889e-03; cp = cp * t2 + 4.1666666666666664e-02; cp = cp * t2 - 0.5; cp = cp * t2 + 1.0;
    const int qi = ((int)q) & 3;
    const double s_ = (qi & 1) ? cp : sp, c_ = (qi & 1) ? sp : cp;
    sn = (float)((qi & 2) ? -s_ : s_); cs = (float)(((qi == 1) || (qi == 2)) ? -c_ : c_);
}

constexpr int LDS_BYTES = 160 * 1024;
__global__ void __launch_bounds__(512, 2) mega_fwd(Args a) {
    extern __shared__ __attribute__((aligned(16))) unsigned char lds_raw[];
    LAS unsigned char* lds = (LAS unsigned char*)lds_raw;
    const int tid = threadIdx.x, lane = tid & 63, wave = __builtin_amdgcn_readfirstlane(tid >> 6);
    const int G = gridDim.x, bx = blockIdx.x;
    const int vcu = (G % 8 == 0) ? (bx % 8) * (G / 8) + bx / 8 : bx;
    const int gw = vcu * 8 + wave, NGW = G * 8;
#define kmean ((float*)(a.ws + CTL_KMEAN))
#define kamax ((unsigned*)(a.ws + CTL_KAMAX))
#define ssq1 ((float*)(a.ws + CTL_SSQ1))
#define ssq2 ((float*)(a.ws + CTL_SSQ2))
#define ssq3 ((float*)(a.ws + CTL_SSQ3))
#define WZ ((bf16_t*)(a.ws + WS_WZ))
#define WG ((bf16_t*)(a.ws + WS_WG))
#define WBR ((bf16_t*)(a.ws + WS_WBR))
#define WOUT ((bf16_t*)(a.ws + WS_WOUT))
#define WQ ((bf16_t*)(a.ws + WS_WQ))
#define WKV ((bf16_t*)(a.ws + WS_WKV))
#define WO ((bf16_t*)(a.ws + WS_WO))
#define WFI ((bf16_t*)(a.ws + WS_WFI))
#define WFO ((bf16_t*)(a.ws + WS_WFO))
#define RC ((float*)(a.ws + WS_RC))
#define RS ((float*)(a.ws + WS_RS))
#define MEMN ((bf16_t*)(a.ws + WS_MEMN))
#define KX ((bf16_t*)(a.ws + WS_KX))
#define VX ((bf16_t*)(a.ws + WS_VX))
#define E1 ((float*)(a.ws + WS_E1))
#define E2 ((float*)(a.ws + WS_E2))
#define XN ((bf16_t*)(a.ws + WS_XN))
#define HB XN
#define QP ((bf16_t*)(a.ws + WS_Q))
#define QX QP
#define QI ((bf16_t*)(a.ws + WS_QI))
#define OX QI
#define KI ((bf16_t*)(a.ws + WS_KI))
#define RAT KI
#define VB ((bf16_t*)(a.ws + WS_VB))
#define SGB VB
#define OG ((bf16_t*)(a.ws + WS_OG))
#define MG OG
#define ACT ((bf16_t*)(a.ws + WS_ACT))
#define KP ((bf16_t*)a.out)
#define VP ((bf16_t*)((unsigned char*)a.out + 64 * MiB))
#define H (a.out)
    cg::grid_group grid = cg::this_grid();
    const int lo = a.ph_lo, hi = a.ph_hi;
#ifndef PH_MASK
#define PH_MASK 0xfff
#endif
#define IN(k) (((PH_MASK >> (k)) & 1) && lo <= (k) && (k) < hi)
#define XBAR(word, count) do { asm volatile("s_waitcnt vmcnt(0)" ::: "memory"); __syncthreads(); \
        if (tid == 0) { unsigned* bw_ = (unsigned*)(a.ws + WS_CTL) + 64 * (word); __builtin_amdgcn_fence(__ATOMIC_RELEASE, "agent"); asm volatile("s_waitcnt vmcnt(0)" ::: "memory"); \
            __hip_atomic_fetch_add(bw_, 1u, __ATOMIC_RELAXED, __HIP_MEMORY_SCOPE_AGENT); \
            while (__hip_atomic_load(bw_, __ATOMIC_RELAXED, __HIP_MEMORY_SCOPE_AGENT) < (unsigned)(count)) __builtin_amdgcn_s_sleep(2); \
            __builtin_amdgcn_fence(__ATOMIC_ACQUIRE, "agent"); asm volatile("s_waitcnt vmcnt(0)" ::: "memory"); } \
        __syncthreads(); } while (0)
#define SEAM(k) do { if (IN(k) && IN((k) + 1)) { if (a.ph_lo < 0) grid.sync(); else XBAR(100 + (k), G); } } while (0)
#ifndef DUP_MASK
#define DUP_MASK 0
#endif
#define REPS(k) for (int rep_ = 0; rep_ < (((DUP_MASK >> (k)) & 1) ? 2 : 1); ++rep_)

    if (IN(0)) {
        LAS float* scr = (LAS float*)(lds + wave * 16384);
        constexpr int I_Z = 16 * (ZN / 32), I_G = 16 * 64, I_BR = 16 * 32, I_SQ = 16 * 32, I_KV = 16 * 64, I_FI = 16 * 176, I_FO = 44 * 32;
        constexpr int NITEMS = I_Z + I_G + 2 * I_BR + 3 * I_SQ + I_KV + I_FI + I_FO;
        for (int it = gw; it < NITEMS; it += NGW) {
            int r = it;
            if (r < I_Z) { wt_item(a.w_in, 9216, nullptr, WZ, 1024, 0, ZN / 32, r, scr, lane, [](int n) { return zmap(n); }); continue; } r -= I_Z;
            if (r < I_G) { wt_item(a.w_in, 9216, nullptr, WG, 1024, 0, 64, r, scr, lane, [](int n) { const int p = n & 255; return ((p >> 7) ? 8192 : 7168) + 128 * (n >> 8) + (perm8(p) & 127); }); continue; } r -= I_G;
            if (r < I_BR) { wt_item(a.w_bra, 1024, nullptr, WBR, 2048, 0, 32, r, scr, lane, [](int n) { return (n & ~255) + perm8(n & 255); }); continue; } r -= I_BR;
            if (r < I_BR) { wt_item(a.w_brh, 1024, nullptr, WBR, 2048, 1024, 32, r, scr, lane, [](int n) { return (n & ~255) + perm8(n & 255); }); continue; } r -= I_BR;
            if (r < I_SQ) { wt_item(a.w_out, 1024, nullptr, WOUT, 1024, 0, 32, r, scr, lane, [](int n) { return n; }); continue; } r -= I_SQ;
            if (r < I_SQ) { wt_item(a.wq, 1024, a.g_x, WQ, 1024, 0, 32, r, scr, lane, [](int n) { return (n & ~255) + perm8(n & 255); }); continue; } r -= I_SQ;
            if (r < I_SQ) { wt_item(a.wo, 1024, nullptr, WO, 1024, 0, 32, r, scr, lane, [](int n) { return n; }); continue; } r -= I_SQ;
            if (r < I_KV) { wt_item(a.wkv, 2048, nullptr, WKV, 1024, 0, 64, r, scr, lane, [](int n) { return (n & ~255) + perm8(n & 255); }); continue; } r -= I_KV;
            if (r < I_FI) { wt_item(a.w_ffi, 2 * FFN, a.g_ffn, WFI, 1024, 0, 176, r, scr, lane, [](int n) { const int p = n & 255; return ((p >> 7) ? FFN : 0) + 128 * (n >> 8) + (perm8(p) & 127); }); continue; } r -= I_FI;
            wt_item(a.w_ffo, 1024, nullptr, WFO, FFN, 0, 32, r, scr, lane, [](int n) { return n; });
        }
        for (int m = gw; m < T; m += 2 * NGW) {
            const int m2 = m + NGW; f32x4 v0[4], v1[4]; float s0 = 0.f, s1 = 0.f;
#pragma unroll
            for (int j = 0; j < 4; ++j) { v0[j] = ((const f32x4*)(a.x + (size_t)m * D))[lane + 64 * j]; v1[j] = ((const f32x4*)(a.x + (size_t)m2 * D))[lane + 64 * j]; }
#pragma unroll
            for (int j = 0; j < 4; ++j) { s0 += (v0[j][0] * v0[j][0] + v0[j][1] * v0[j][1]) + (v0[j][2] * v0[j][2] + v0[j][3] * v0[j][3]); s1 += (v1[j][0] * v1[j][0] + v1[j][1] * v1[j][1]) + (v1[j][2] * v1[j][2] + v1[j][3] * v1[j][3]); }
            const float r0 = rsqrtf(wave_sum(s0) * (1.0f / D) + EPS), r1 = rsqrtf(wave_sum(s1) * (1.0f / D) + EPS);
#pragma unroll
            for (int j = 0; j < 4; ++j) { const f32x4 gg = ((const f32x4*)a.g_mix)[lane + 64 * j]; const f32x4 a0 = v0[j] * r0 * gg, a1 = v1[j] * r1 * gg; u32x2 w0, w1;
                w0.x = cvt_pk_bf16(a0[0], a0[1]); w0.y = cvt_pk_bf16(a0[2], a0[3]); w1.x = cvt_pk_bf16(a1[0], a1[1]); w1.y = cvt_pk_bf16(a1[2], a1[3]);
                ((u32x2*)(XN + (size_t)m * D))[lane + 64 * j] = w0; ((u32x2*)(XN + (size_t)m2 * D))[lane + 64 * j] = w1; }
        }
        for (int m = gw; m < NB * NMEM; m += NGW) norm_row_bf16(a.mem + (size_t)m * D, a.g_mem, MEMN + (size_t)m * D, lane);
        for (int i = bx * 512 + tid; i < T * 32; i += G * 512) {
            const int tok = i >> 5, f = i & 31;
            const float inv = powf(10000.0f, -(float)(2 * f) * (1.0f / 64.0f));
            const float ang = (float)a.pos[tok] * inv;
            float sn, cs; sincos_acc(ang, sn, cs); RC[i] = cs; RS[i] = sn;
        }
    }
    SEAM(0);
    if (IN(1)) {

        const EpiZ Z{QP, KP, VP, QI, KI, VB, OG, E1, E2, RC, RS, kmean, kamax, a.lbl};
#define ZSEC(EPI, einit, tile0, ntile) { pg8::Gemm g{pg8::a_rowmajor(XN, D), WZ + (size_t)(tile0) * 256 * D, T, (ntile) * 256, D}; pg8::StaticOrder S; S.init(T, (ntile) * 256, G, bx); \
            const EPI E einit; pg8::gemm_phase<EPI, true>(lds, g, S, E); }
        ZSEC(EpiRope<false>, {Z}, 0, 4)
        ZSEC(EpiRope<true>, {Z}, 4, 4)
        ZSEC(EpiPlane<false>, ({Z, VP}), 8, 4)
        ZSEC(EpiQF, {Z}, 12, 8)
        ZSEC(EpiPlane<false>, ({Z, VB}), 20, 4)
        ZSEC(EpiPlane<true>, ({Z, OG}), 24, 4)
        { pg8::Gemm g{pg8::a_rowmajor(MEMN, D), WKV, NB * NMEM, 2 * D, D}; pg8::StaticOrder S; S.init(NB * NMEM, 2 * D, G, (bx + 128) % G);
          EpiKV E{KX, VX};
          pg8::gemm_phase<EpiKV, true>(lds, g, S, E); }
    #if (DUP_MASK >> 1) & 1
        ZSEC(EpiRope<false>, {Z}, 0, 4)
        ZSEC(EpiRope<true>, {Z}, 4, 4)
        ZSEC(EpiPlane<false>, ({Z, VP}), 8, 4)
        ZSEC(EpiQF, {Z}, 12, 8)
        ZSEC(EpiPlane<false>, ({Z, VB}), 20, 4)
        ZSEC(EpiPlane<true>, ({Z, OG}), 24, 4)
        { pg8::Gemm g{pg8::a_rowmajor(MEMN, D), WKV, NB * NMEM, 2 * D, D}; pg8::StaticOrder S; S.init(NB * NMEM, 2 * D, G, (bx + 128) % G);
          EpiKV E{KX, VX};
          pg8::gemm_phase<EpiKV, true>(lds, g, S, E); }
    #endif
#undef ZSEC
    }
    SEAM(1);
    if (IN(2)) {
        for (int it = bx; it < NB * BH * hg::NSEG; it += G) hgrn_seg_a(lds, it / (BH * hg::NSEG), (it / hg::NSEG) % BH, it % hg::NSEG, QI, KI, VB, E1, E2);
        XBAR(120, G);
        for (int it = bx; it < NB * BH * hg::NSEG; it += G) hgrn_seg_b(lds, it / (BH * hg::NSEG), (it / hg::NSEG) % BH, it % hg::NSEG, QI, KI, VB, OG, E1, E2, a.g_hgrn);
        {
            unsigned* ctl = (unsigned*)(a.ws + WS_CTL);
            unsigned* gcnt = ctl + 4096;
            bf16_t* PO = (bf16_t*)(a.ws + mb::WS_PO); float* PL = (float*)(a.ws + mb::WS_PL); unsigned short* GL = (unsigned short*)(a.ws + mb::WS_LIST);
            const int nmb = G, mbi = bx;
#define MB_QUEUE(total, ...) do { for (int r_ = 0;; ++r_) { const int k = r_ * nmb + ((r_ & 1) ? nmb - 1 - mbi : mbi); if (r_ * nmb >= (total)) break; if (k < (total)) { __VA_ARGS__ } } } while (0)
            MB_QUEUE(64 * 31, {
                const int bh = k & 63, qb = 31 - (k >> 6);
                moba_gate_item(lds, bh, bh, qb, QP, kmean, gcnt, GL); });
            XBAR(121, G);
            LAS int* pfx = (LAS int*)(lds + LDS_BYTES - 12288);
            { __syncthreads();
              int v4[4], v = 0;
#pragma unroll
              for (int q4 = 0; q4 < 4; ++q4) { const int i = 4 * tid + q4; v4[q4] = (int)((gcnt[(i & 63) * 32 + (i >> 6)] + 511u) >> 9); v += v4[q4]; }
              const int mine = v;
#pragma unroll
              for (int o = 1; o < 64; o <<= 1) { const int t_ = __shfl_up(v, o); if (lane >= o) v += t_; }
              LAS int* wtot = pfx + 2048;
              if (lane == 63) wtot[wave] = v;
              __syncthreads();
              int add = v - mine;
#pragma unroll
              for (int w_ = 0; w_ < 8; ++w_) add += (w_ < wave) ? wtot[w_] : 0;
#pragma unroll
              for (int q4 = 0; q4 < 4; ++q4) { add += v4[q4]; pfx[4 * tid + q4] = add; }
              __syncthreads(); }
            const int nitems = pfx[2047];
            moba_part_phase(lds, pfx, nitems, mbi, nmb, QP, KP, VP, kamax, gcnt, GL, PO, PL);
            XBAR(122, G);
            MB_QUEUE(64 * 32, {
                const int bh = k & 63, qb = 31 - (k >> 6);
                moba_comb_item(lds, bh, bh, qb, QP, KP, VP, kamax, PO, PL); });
#undef MB_QUEUE
        }
    }
    SEAM(2);
    if (IN(3)) {
        pg8::Gemm g{pg8::a_rowmajor(XN, D), WG, T, 2 * D, D}; pg8::PairOrder S; S.base.init(T, D, G, bx);
        EpiGate E{RAT, SGB};
        pg8::gemm_phase<EpiGate, true, pg8::PairOrder>(lds, g, S, E);
        asm volatile("s_waitcnt vmcnt(0)" ::: "memory"); __syncthreads();
    }
    if (IN(4)) {
        {
        pg8::AView av; av.b0 = (const char*)QP; av.b1 = (const char*)QI - 16 * MiB; av.tsplit = 16; av.bstride = 16 * MiB; av.tstride = 256 * 64 * 2; av.kstride = 1 * MiB; av.lda = 64;
        pg8::Gemm g{av, WBR, T, D, 2 * D}; pg8::StaticOrder S; S.init(T, D, G, bx);
        EpiMerged E{RAT, SGB, MG};
        pg8::gemm_phase<EpiMerged, true>(lds, g, S, E);
            }
#if (DUP_MASK >> 4) & 1
        {
        pg8::AView av; av.b0 = (const char*)QP; av.b1 = (const char*)QI - 16 * MiB; av.tsplit = 16; av.bstride = 16 * MiB; av.tstride = 256 * 64 * 2; av.kstride = 1 * MiB; av.lda = 64;
        pg8::Gemm g{av, WBR, T, D, 2 * D}; pg8::StaticOrder S; S.init(T, D, G, bx);
        EpiMerged E{RAT, SGB, MG};
        pg8::gemm_phase<EpiMerged, true>(lds, g, S, E);
            }
#endif
    }
    SEAM(4);
    if (IN(5)) {
        pg8::Gemm g{pg8::a_rowmajor(MG, D), WOUT, T, D, D}; pg8::StaticOrder S; S.init(T, D, G, bx);
        EpiRes<false> E{a.x, HB, ssq1};
        pg8::gemm_phase<EpiRes<false>, true>(lds, g, S, E);
    }
    SEAM(5);
    if (IN(6)) {
        {
        pg8::Gemm g{pg8::a_rowmajor(HB, D), WQ, T, D, D}; pg8::StaticOrder S; S.init(T, D, G, bx);
        EpiScaleRow E{ssq1, QX, XSCALE};
        pg8::gemm_phase<EpiScaleRow, true>(lds, g, S, E);
#if STAGE_XATTN
        asm volatile("s_waitcnt vmcnt(0)" ::: "memory"); __syncthreads();
        { pg8::Unit u; for (int i = 0; S.next(i, u); ++i) { xattn_item(lds, u.pm >> 5, u.pn, 2 * (u.pm & 31), QX, KX, VX, OX); xattn_item(lds, u.pm >> 5, u.pn, 2 * (u.pm & 31) + 1, QX, KX, VX, OX); } }
#endif
            }
#if (DUP_MASK >> 6) & 1
        {
        pg8::Gemm g{pg8::a_rowmajor(HB, D), WQ, T, D, D}; pg8::StaticOrder S; S.init(T, D, G, bx);
        EpiScaleRow E{ssq1, QX, XSCALE};
        pg8::gemm_phase<EpiScaleRow, true>(lds, g, S, E);
#if STAGE_XATTN
        asm volatile("s_waitcnt vmcnt(0)" ::: "memory"); __syncthreads();
        { pg8::Unit u; for (int i = 0; S.next(i, u); ++i) { xattn_item(lds, u.pm >> 5, u.pn, 2 * (u.pm & 31), QX, KX, VX, OX); xattn_item(lds, u.pm >> 5, u.pn, 2 * (u.pm & 31) + 1, QX, KX, VX, OX); } }
#endif
            }
#endif
    }
#if !STAGE_XATTN
    SEAM(6);
#endif
    if (IN(7)) {
#if STAGE_XATTN
#else
        LAS float* qsh = (LAS float*)(lds + wave * 2048); LAS float* psh = qsh + 256;
        for (int it = gw; it < T * XH; it += NGW) {
            const int tok = it >> 2, hx = it & 3, b = tok >> 13;
            { const u32x2 w = *(const u32x2*)(QX + (size_t)tok * D + hx * 256 + 4 * lane); qsh[4 * lane] = bflo(w.x); qsh[4 * lane + 1] = bfhi(w.x); qsh[4 * lane + 2] = bflo(w.y); qsh[4 * lane + 3] = bfhi(w.y); }
            asm volatile("s_waitcnt lgkmcnt(0)" ::: "memory");
            const bf16_t* kb = KX + (size_t)(b * 4 + hx) * 256 * 256; const bf16_t* vb = VX + (size_t)(b * 4 + hx) * 256 * 256;
            float sc[4]; float mx = -INFINITY;
#pragma unroll
            for (int i = 0; i < 4; ++i) { const u32x4* kr = (const u32x4*)(kb + (size_t)(lane + 64 * i) * 256); float s_ = 0.f;
#pragma unroll 2
                for (int c = 0; c < 32; ++c) { const u32x4 w = kr[c]; f32x4 x0, x1; unpack8(w, x0, x1);
#pragma unroll
                    for (int e = 0; e < 4; ++e) s_ += x0[e] * qsh[8 * c + e] + x1[e] * qsh[8 * c + 4 + e]; }
                sc[i] = s_; mx = fmaxf(mx, s_); }
            mx = wave_max(mx); float lsum = 0.f;
#pragma unroll
            for (int i = 0; i < 4; ++i) { const float p = exp2f(sc[i] - mx); psh[lane + 64 * i] = p; lsum += p; }
            lsum = wave_sum(lsum);
            asm volatile("s_waitcnt lgkmcnt(0)" ::: "memory");
            f32x4 ov = {0.f, 0.f, 0.f, 0.f};
#pragma unroll 4
            for (int m = 0; m < 256; ++m) { const u32x2 w = *(const u32x2*)(vb + (size_t)m * 256 + 4 * lane); const float p = psh[m]; ov[0] += p * bflo(w.x); ov[1] += p * bfhi(w.x); ov[2] += p * bflo(w.y); ov[3] += p * bfhi(w.y); }
            const float rl = 1.0f / lsum; u32x2 w; w.x = cvt_pk_bf16(ov[0] * rl, ov[1] * rl); w.y = cvt_pk_bf16(ov[2] * rl, ov[3] * rl);
            *(u32x2*)(OX + (size_t)tok * D + hx * 256 + 4 * lane) = w;
        }
#endif
    }
    SEAM(7);
    if (IN(8)) {
        pg8::Gemm g{pg8::a_rowmajor(OX, D), WO, T, D, D}; pg8::StaticOrder S; S.init(T, D, G, bx);
        EpiRes<true> E{HB, HB, ssq2};
        pg8::gemm_phase<EpiRes<true>, true>(lds, g, S, E);
    }
    SEAM(8);
    if (IN(9)) {
        pg8::Gemm g{pg8::a_rowmajor(HB, D), WFI, T, 2 * FFN, D}; pg8::StaticOrder S; S.init(T, 2 * FFN, G, bx);
        EpiSwiglu E{ssq2, ACT};
        pg8::gemm_phase<EpiSwiglu, true>(lds, g, S, E);
    }
    SEAM(9);
    if (IN(10)) {
        pg8::Gemm g{pg8::a_rowmajor(ACT, FFN), WFO, T, D, FFN}; pg8::StaticOrder S; S.init(T, D, G, bx);
        EpiRes<true> E{HB, HB, ssq3};
        pg8::gemm_phase<EpiRes<true>, true>(lds, g, S, E);
    }
    SEAM(10);
    if (IN(11)) {
        for (int m = gw; m < T; m += NGW) {
            const float rstd = rsqrtf(ssq3[m] * (1.0f / D) + EPS); const u32x2* hrow = (const u32x2*)(HB + (size_t)m * D); f32x4* row = (f32x4*)(a.out + (size_t)m * D);
#pragma unroll
            for (int j = 0; j < 4; ++j) { const f32x4 gg = ((const f32x4*)a.g_fin)[lane + 64 * j]; const u32x2 w = hrow[lane + 64 * j];
                row[lane + 64 * j] = (f32x4){bflo(w.x), bfhi(w.x), bflo(w.y), bfhi(w.y)} * rstd * gg; }
        }
    }
#undef IN
#undef SEAM
}
#undef kmean
#undef kamax
#undef ssq1
#undef ssq2
#undef ssq3
#undef WZ
#undef WG
#undef WBR
#undef WOUT
#undef WQ
#undef WKV
#undef WO
#undef WFI
#undef WFO
#undef RC
#undef RS
#undef MEMN
#undef KX
#undef VX
#undef E1
#undef E2
#undef XN
#undef HB
#undef QP
#undef QX
#undef QI
#undef OX
#undef KI
#undef RAT
#undef VB
#undef SGB
#undef OG
#undef MG
#undef ACT
#undef KP
#undef VP
#undef H

constexpr int N_PHASES = 12;
extern "C" void kernel_launch(void* const* d_in, const int* in_sizes, int n_in, void* d_out, int out_size, void* d_ws, size_t ws_size, hipStream_t stream) {
    static int grid = 0;
    if (grid == 0) {
        if (n_in != 19 || in_sizes[0] != T * D || out_size != T * D || ws_size < WS_END) { fprintf(stderr, "kernel_launch: unexpected shapes (n_in %d, in0 %d, out %d, ws %zu)\n", n_in, n_in > 0 ? in_sizes[0] : -1, out_size, ws_size); grid = -1; return; }
        int dev = 0, cus = 0, per_cu = 0;
        hipGetDevice(&dev); hipDeviceGetAttribute(&cus, hipDeviceAttributeMultiprocessorCount, dev);
        hipFuncSetAttribute((const void*)mega_fwd, hipFuncAttributeMaxDynamicSharedMemorySize, LDS_BYTES);
        if (hipOccupancyMaxActiveBlocksPerMultiprocessor(&per_cu, (const void*)mega_fwd, 512, LDS_BYTES) != hipSuccess || per_cu < 1) { fprintf(stderr, "kernel_launch: occupancy query says %d blocks/CU\n", per_cu); per_cu = 1; }
        (void)hipGetLastError();
        grid = cus;
    }
    if (grid < 0) return;
    hipMemsetAsync((char*)d_ws + WS_CTL, 0, CTL_ZERO_BYTES, stream);
    Args a{};
    a.x = (const float*)d_in[0]; a.mem = (const float*)d_in[1]; a.pos = (const int*)d_in[2]; a.g_mix = (const float*)d_in[3]; a.w_in = (const float*)d_in[4]; a.lbl = (const float*)d_in[5];
    a.g_hgrn = (const float*)d_in[6]; a.w_bra = (const float*)d_in[7]; a.w_brh = (const float*)d_in[8]; a.w_out = (const float*)d_in[9]; a.g_x = (const float*)d_in[10]; a.g_mem = (const float*)d_in[11];
    a.wq = (const float*)d_in[12]; a.wkv = (const float*)d_in[13]; a.wo = (const float*)d_in[14]; a.g_ffn = (const float*)d_in[15]; a.w_ffi = (const float*)d_in[16]; a.w_ffo = (const float*)d_in[17]; a.g_fin = (const float*)d_in[18];
    a.out = (float*)d_out; a.ws = (unsigned char*)d_ws;
#if MK_N_LAUNCHES == 1
    a.ph_lo = 0; a.ph_hi = N_PHASES;
    void* args[] = {&a};
    hipError_t e = hipLaunchCooperativeKernel((const void*)mega_fwd, dim3(grid), dim3(512), args, LDS_BYTES, stream);
    if (e != hipSuccess) fprintf(stderr, "cooperative launch failed: %s (grid %d)\n", hipGetErrorString(e), grid);
#else
    for (int p = 0; p < N_PHASES; ++p) { a.ph_lo = p; a.ph_hi = p + 1; hipLaunchKernelGGL(mega_fwd, dim3(grid), dim3(512), LDS_BYTES, stream, a); }
#endif
}
```

```cpp
#include <hip/hip_runtime.h>
#include <hip/hip_cooperative_groups.h>
#include <cstdio>
#include <cstdint>
namespace cg = cooperative_groups;

#ifndef MK_N_LAUNCHES
#define MK_N_LAUNCHES 1
#endif

#ifndef STAGE_HGRN
#define STAGE_HGRN 1
#endif
#ifndef STAGE_MOBA
#define STAGE_MOBA 1
#endif
#ifndef STAGE_XATTN
#define STAGE_XATTN 1
#endif
#define LAS __attribute__((address_space(3)))
typedef unsigned short bf16_t;
typedef short bf16x8 __attribute__((ext_vector_type(8)));
typedef float f32x4 __attribute__((ext_vector_type(4)));
typedef float f32x2 __attribute__((ext_vector_type(2)));
typedef unsigned u32x4 __attribute__((ext_vector_type(4)));
typedef unsigned u32x2 __attribute__((ext_vector_type(2)));

constexpr int NB = 4, SEQ = 8192, T = NB * SEQ, D = 1024;
constexpr int AH = 16, AHD = 64, NBLK = 32;
constexpr int BH = 8, BDK = 128, BDV = 128, NCH = SEQ / 64;
constexpr int XH = 4, XHD = 256, NMEM = 256;
constexpr int FFN = 2816;
constexpr int ZN = 7168;
constexpr float EPS = 1e-6f;
constexpr float LOG2E = 1.4426950408889634f;
constexpr float QSCALE = 0.125f * LOG2E;
constexpr float XSCALE = 0.0625f * LOG2E;
constexpr float DKS = 0.08838834764831845f;

constexpr size_t MiB = 1u << 20;
constexpr size_t WS_CTL = 0, CTL_ZERO_BYTES = 2 * MiB;
constexpr size_t CTL_KMEAN = 64 * 1024;
constexpr size_t CTL_KAMAX = CTL_KMEAN + 512 * 1024;
constexpr size_t CTL_SSQ1 = 1 * MiB, CTL_SSQ2 = CTL_SSQ1 + 128 * 1024, CTL_SSQ3 = CTL_SSQ2 + 128 * 1024;
constexpr size_t WS_WZ = 4 * MiB, WS_WG = 18 * MiB, WS_WBR = 22 * MiB, WS_WOUT = 26 * MiB, WS_WQ = 28 * MiB, WS_WKV = 30 * MiB, WS_WO = 34 * MiB, WS_WFI = 36 * MiB, WS_WFO = 47 * MiB;
constexpr size_t WS_RC = 53 * MiB, WS_RS = 57 * MiB, WS_MEMN = 61 * MiB, WS_KX = 63 * MiB, WS_VX = 65 * MiB, WS_E1 = 67 * MiB, WS_E2 = 69 * MiB;
constexpr size_t WS_XN = 72 * MiB;
constexpr size_t WS_Q = 136 * MiB;
constexpr size_t WS_QI = 200 * MiB;
constexpr size_t WS_KI = 264 * MiB;
constexpr size_t WS_VB = 328 * MiB;
constexpr size_t WS_OG = 392 * MiB;
constexpr size_t WS_ACT = 264 * MiB;
constexpr size_t WS_END = 512 * MiB;

typedef __bf16 bf16x2_t __attribute__((ext_vector_type(2)));
__device__ __forceinline__ unsigned cvt_pk_bf16(float lo, float hi) { const f32x2 v = {lo, hi}; const bf16x2_t b = __builtin_convertvector(v, bf16x2_t); return __builtin_bit_cast(unsigned, b); }
__device__ __forceinline__ float bf2f(bf16_t h) { return __uint_as_float(((unsigned)h) << 16); }
__device__ __forceinline__ float bflo(unsigned w) { return __uint_as_float(w << 16); }
__device__ __forceinline__ float bfhi(unsigned w) { return __uint_as_float(w & 0xffff0000u); }
__device__ __forceinline__ bf16_t f2bf(float f) { return (bf16_t)(cvt_pk_bf16(f, 0.f) & 0xffffu); }
__device__ __forceinline__ float sigmoidf_(float x) { return __builtin_amdgcn_rcpf(1.0f + __expf(-x)); }
__device__ __forceinline__ float wave_sum(float v) {
#pragma unroll
    for (int o = 1; o < 64; o <<= 1) v += __shfl_xor(v, o);
    return v;
}
__device__ __forceinline__ float wave_max(float v) {
#pragma unroll
    for (int o = 1; o < 64; o <<= 1) v = fmaxf(v, __shfl_xor(v, o));
    return v;
}
__device__ __forceinline__ u32x4 pack8(const f32x4& a, const f32x4& b) { u32x4 w; w.x = cvt_pk_bf16(a[0], a[1]); w.y = cvt_pk_bf16(a[2], a[3]); w.z = cvt_pk_bf16(b[0], b[1]); w.w = cvt_pk_bf16(b[2], b[3]); return w; }
__device__ __forceinline__ void unpack8(const u32x4& w, f32x4& a, f32x4& b) { a = (f32x4){bflo(w.x), bfhi(w.x), bflo(w.y), bfhi(w.y)}; b = (f32x4){bflo(w.z), bfhi(w.z), bflo(w.w), bfhi(w.w)}; }

namespace pg8 {
constexpr int BM = 256, BK = 64, HALF = 128, HTB = HALF * BK * 2, STAGE_BYTES = 8 * HTB, NXCD = 8, WGM = 8;
__host__ __device__ __forceinline__ int lds_byte(int r, int c) { const int st = (r >> 4) * 2 + (c >> 5), rr = r & 15, cc = c & 31, ob = rr * 64 + cc * 2; return st * 1024 + (ob ^ (((ob >> 9) & 1) << 5)); }
__host__ __device__ __forceinline__ void stage_rc(int b, int& R, int& C) { const int st = b / 1024, sb = b % 1024, swz = sb ^ (((sb >> 9) & 1) << 5); R = (st >> 1) * 16 + swz / 64; C = (st & 1) * 32 + (swz % 64) / 2; }
struct Unit { int pm, pn; };
struct AView {
    const char* b0; const char* b1; int tsplit; long bstride, tstride, kstride; int lda;
    __device__ __forceinline__ const char* ptr(int pm, int t) const { return (t < tsplit ? b0 : b1) + (long)(pm >> 5) * bstride + (long)(pm & 31) * tstride + (long)t * kstride; }
};
__device__ __forceinline__ AView a_rowmajor(const void* A, int lda) { AView v; v.b0 = (const char*)A; v.b1 = (const char*)A; v.tsplit = 1 << 30; v.tstride = (long)256 * lda * 2; v.bstride = 32 * v.tstride; v.kstride = 128; v.lda = lda; return v; }
struct Gemm { AView A; const bf16_t* Bt; int M, N, K; };
struct StaticOrder {
    int nM, nN, nwg, G, c;
    __device__ void init(int M, int N, int G_, int c_) { nM = M / BM; nN = N / BM; nwg = nM * nN; G = G_; c = c_; }
    __device__ bool next(int i, Unit& u) const {
        const long L = (long)i * G + c; if (L >= nwg) return false;
        int wgid = (int)L; { const int q = nwg / NXCD, r = nwg % NXCD, xcd = wgid % NXCD, off = wgid / NXCD; wgid = (xcd < r ? xcd * (q + 1) : r * (q + 1) + (xcd - r) * q) + off; }
        const int nig = WGM * nN, gid = wgid / nig, fm = gid * WGM, gsz = (nM - fm) < WGM ? (nM - fm) : WGM;
        u.pm = fm + ((wgid % nig) % gsz); u.pn = (wgid % nig) / gsz; return true;
    }
};
struct PairOrder { StaticOrder base;
    __device__ bool next(int i, Unit& u) const { Unit v; if (!base.next(i >> 1, v)) return false; u.pm = v.pm; u.pn = 2 * v.pn + (i & 1); return true; } };
template <class Epi, bool ALIGN_EPI, class Sched = StaticOrder>
__device__ __forceinline__ void gemm_phase(LAS unsigned char* lds, const Gemm g, const Sched& S, const Epi& E) {
    const int tid = threadIdx.x, wid = __builtin_amdgcn_readfirstlane(tid >> 6), lane = tid & 63, wr = wid >> 2, wc = wid & 3, fr = lane & 15, fq = lane >> 4;
    const int K = g.K, nt = K / BK;
    unsigned voffA[2], voffB[2];
#pragma unroll
    for (int i = 0; i < 2; ++i) { int R, C; stage_rc(tid * 16 + i * 8192, R, C); voffA[i] = (unsigned)(R * g.A.lda + C) * 2u; voffB[i] = (unsigned)(R * K + C) * 2u; }
    const size_t hstepA = (size_t)HALF * g.A.lda * 2, hstepB = (size_t)HALF * K * 2, tstepB = 2 * hstepB, kstep = 128;
    const unsigned ldsw = (unsigned)wid * 1024u;
    const int aoff = lds_byte(wr * 64 + fr, fq * 8), boff = lds_byte(wc * 32 + fr, fq * 8);
#define PG8_SA(b, h) (((b) * 2 + (h)) * HTB)
#define PG8_SB(b, h) ((4 + (b) * 2 + (h)) * HTB)
#define PG8_STAGE(bufoff, gbase, voff) do { _Pragma("unroll") for (int _i = 0; _i < 2; ++_i) \
        __builtin_amdgcn_global_load_lds((const unsigned*)((const char*)(gbase) + (voff)[_i]), (LAS unsigned*)(lds + (bufoff) + ldsw + _i * 8192), 16, 0, 0); } while (0)
#define PG8_LDA(dst, b, h) do { _Pragma("unroll") for (int m = 0; m < 4; ++m) _Pragma("unroll") for (int k = 0; k < 2; ++k) dst[m][k] = *(const LAS bf16x8*)(lds + PG8_SA(b, h) + aoff + m * 2048 + k * 1024); } while (0)
#define PG8_LDB(dst, b, h) do { _Pragma("unroll") for (int n = 0; n < 2; ++n) _Pragma("unroll") for (int k = 0; k < 2; ++k) dst[n][k] = *(const LAS bf16x8*)(lds + PG8_SB(b, h) + boff + n * 2048 + k * 1024); } while (0)
#define PG8_MMA(ai, bj, At, Bt) do { __builtin_amdgcn_s_setprio(1); _Pragma("unroll") for (int m = 0; m < 4; ++m) _Pragma("unroll") for (int n = 0; n < 2; ++n) _Pragma("unroll") for (int k = 0; k < 2; ++k) \
        acc[ai][bj][m][n] = __builtin_amdgcn_mfma_f32_16x16x32_bf16(Bt[n][k], At[m][k], acc[ai][bj][m][n], 0, 0, 0); __builtin_amdgcn_s_setprio(0); } while (0)
#define PG8_WAIT_V(n) asm volatile("s_waitcnt vmcnt(" #n ")" ::: "memory")
#define PG8_WAIT_L(n) asm volatile("s_waitcnt lgkmcnt(" #n ")" ::: "memory")
#define PG8_BAR __builtin_amdgcn_s_barrier()
#define PG8_SCHED __builtin_amdgcn_sched_barrier(0)
    Unit cur, nxt; int ui = 0;
    if (!S.next(0, cur)) return;
    f32x4 acc[2][2][4][2];
#pragma unroll
    for (int a = 0; a < 2; ++a)
#pragma unroll
        for (int b = 0; b < 2; ++b)
#pragma unroll
            for (int m = 0; m < 4; ++m)
#pragma unroll
                for (int n = 0; n < 2; ++n) acc[a][b][m][n] = (f32x4){0.f, 0.f, 0.f, 0.f};
    bf16x8 At[4][2], B0[2][2], B1[2][2];
    const char* cB = (const char*)g.Bt + (size_t)cur.pn * tstepB;
    {
        const char* cA = g.A.ptr(cur.pm, 0); const char* cA1 = g.A.ptr(cur.pm, 1);
        PG8_STAGE(PG8_SB(0, 0), cB, voffB); PG8_STAGE(PG8_SB(0, 1), cB + hstepB, voffB); PG8_STAGE(PG8_SA(0, 0), cA, voffA); PG8_STAGE(PG8_SA(0, 1), cA + hstepA, voffA);
        if (wr == 1) PG8_BAR;
        PG8_WAIT_V(2); PG8_BAR;
        PG8_STAGE(PG8_SB(1, 0), cB + kstep, voffB); PG8_STAGE(PG8_SA(1, 0), cA1, voffA); PG8_STAGE(PG8_SB(1, 1), cB + hstepB + kstep, voffB);
        PG8_WAIT_V(6); PG8_BAR;
    }
    for (;;) {
        const bool has_next = S.next(ui + 1, nxt);
        const int npm = has_next ? nxt.pm : cur.pm;
        const char* nB = has_next ? (const char*)g.Bt + (size_t)nxt.pn * tstepB : cB;
        for (int t = 0; t < nt; t += 2) {
            const bool last = (t == nt - 2);
            if constexpr (Epi::MID) { if (t == (nt >> 1)) E.mid(acc, cur, wr, wc, fr, fq); }
            const char* a1 = g.A.ptr(cur.pm, t + 1);
            const char* a2 = last ? g.A.ptr(npm, 0) : g.A.ptr(cur.pm, t + 2);
            const char* a3 = last ? g.A.ptr(npm, 1) : g.A.ptr(cur.pm, t + 3);
            const char* b2 = last ? nB : cB + (size_t)(t + 2) * kstep;
            const char* b3 = b2 + kstep;
            PG8_LDB(B0, 0, 0); PG8_LDB(B1, 0, 1); PG8_SCHED; PG8_LDA(At, 0, 0); PG8_STAGE(PG8_SA(1, 1), a1 + hstepA, voffA);
            PG8_WAIT_V(8); PG8_WAIT_L(0); PG8_BAR; PG8_MMA(0, 0, At, B0); PG8_MMA(0, 1, At, B1); PG8_BAR; PG8_SCHED;
            PG8_LDA(At, 0, 1); PG8_STAGE(PG8_SB(0, 0), b2, voffB); PG8_STAGE(PG8_SB(0, 1), b2 + hstepB, voffB); PG8_STAGE(PG8_SA(0, 0), a2, voffA);
            PG8_WAIT_V(8); PG8_WAIT_L(0); PG8_BAR; PG8_MMA(1, 0, At, B0); PG8_MMA(1, 1, At, B1); PG8_BAR; PG8_SCHED;
            PG8_LDB(B0, 1, 0); PG8_LDB(B1, 1, 1); PG8_SCHED; PG8_LDA(At, 1, 0); PG8_STAGE(PG8_SA(0, 1), a2 + hstepA, voffA);
            PG8_WAIT_V(8); PG8_WAIT_L(0); PG8_BAR; PG8_MMA(0, 0, At, B0); PG8_MMA(0, 1, At, B1); PG8_BAR; PG8_SCHED;
            PG8_LDA(At, 1, 1); PG8_STAGE(PG8_SB(1, 0), b3, voffB); PG8_STAGE(PG8_SB(1, 1), b3 + hstepB, voffB); PG8_STAGE(PG8_SA(1, 0), a3, voffA);
            PG8_WAIT_V(8); PG8_WAIT_L(0); PG8_BAR; PG8_MMA(1, 0, At, B0); PG8_MMA(1, 1, At, B1); PG8_BAR; PG8_SCHED;
        }
        if constexpr (ALIGN_EPI) { if (wr == 0) PG8_BAR; }
        E(acc, cur, wr, wc, fr, fq);
        if (!has_next) break;
#pragma unroll
        for (int a = 0; a < 2; ++a)
#pragma unroll
            for (int b = 0; b < 2; ++b)
#pragma unroll
                for (int m = 0; m < 4; ++m)
#pragma unroll
                    for (int n = 0; n < 2; ++n) acc[a][b][m][n] = (f32x4){0.f, 0.f, 0.f, 0.f};
        cur = nxt; cB = nB; ++ui;
        if constexpr (ALIGN_EPI) { if (wr == 1) PG8_BAR; }
    }
    PG8_WAIT_V(0);
    if constexpr (!ALIGN_EPI) { if (wr == 0) PG8_BAR; }
    PG8_BAR;
#undef PG8_SA
#undef PG8_SB
#undef PG8_STAGE
#undef PG8_LDA
#undef PG8_LDB
#undef PG8_MMA
#undef PG8_WAIT_V
#undef PG8_WAIT_L
#undef PG8_BAR
#undef PG8_SCHED
}
}
typedef f32x4 Acc[2][2][4][2];

__host__ __device__ __forceinline__ int perm8(int p) { return (p & ~31) | (((p >> 2) & 3) << 3) | (((p >> 4) & 1) << 2) | (p & 3); }

struct EpiZ {
    static constexpr bool MID = false;
    bf16_t *Q, *Kp, *Vp, *QI, *KI, *VB, *OG; float *E1, *E2; const float *rc, *rs; float* kmean; unsigned* kamax; const float* lbl;
    __device__ __forceinline__ void mid(Acc&, const pg8::Unit&, int, int, int, int) const {}
    template <bool ISK> __device__ __forceinline__ void rope_sec(bf16_t* dst, const Acc& acc, const pg8::Unit& u, int wr, int wc, int fr, int fq) const {
        const int pn = u.pn, b = u.pm >> 5, s0 = (u.pm & 31) * 256;
        const int dlo = 16 * (wc & 1) + 4 * fq;
#pragma unroll
        for (int bj = 0; bj < 2; ++bj) {
            const int plane = b * 16 + 4 * (pn & 3) + 2 * bj + (wc >> 1);
            f32x4 slo = {0.f, 0.f, 0.f, 0.f}, shi = {0.f, 0.f, 0.f, 0.f}; float amax = 0.f;
#pragma unroll
            for (int ai = 0; ai < 2; ++ai)
#pragma unroll
                for (int m = 0; m < 4; ++m) {
                    const int s = s0 + 128 * ai + 64 * wr + 16 * m + fr; const size_t tok = (size_t)b * SEQ + s;
                    const f32x4 c4 = *(const f32x4*)(rc + tok * 32 + dlo), s4 = *(const f32x4*)(rs + tok * 32 + dlo);
                    const f32x4 lo = acc[ai][bj][m][0], hi = acc[ai][bj][m][1];
                    f32x4 olo = lo * c4 - hi * s4, ohi = hi * c4 + lo * s4;
                    if (!ISK) { olo = olo * QSCALE; ohi = ohi * QSCALE; }
                    else { slo += olo; shi += ohi;
#pragma unroll
                        for (int j = 0; j < 4; ++j) amax = fmaxf(amax, fmaxf(fabsf(olo[j]), fabsf(ohi[j]))); }
                    bf16_t* p = dst + ((size_t)plane * SEQ + s) * 64 + dlo;
                    u32x2 w0, w1; w0.x = cvt_pk_bf16(olo[0], olo[1]); w0.y = cvt_pk_bf16(olo[2], olo[3]); w1.x = cvt_pk_bf16(ohi[0], ohi[1]); w1.y = cvt_pk_bf16(ohi[2], ohi[3]);
                    *(u32x2*)p = w0; *(u32x2*)(p + 32) = w1;
                }
            if (ISK) {
#pragma unroll
                for (int j = 0; j < 4; ++j) {
#pragma unroll
                    for (int o = 1; o < 16; o <<= 1) { slo[j] += __shfl_xor(slo[j], o); shi[j] += __shfl_xor(shi[j], o); } }
                amax = wave_max(amax);
                if (fr == 0) { float* km = kmean + ((size_t)plane * NBLK + (u.pm & 31)) * 64 + dlo;
#pragma unroll
                    for (int j = 0; j < 4; ++j) { atomicAdd(km + j, slo[j]); atomicAdd(km + 32 + j, shi[j]); } }
                if ((threadIdx.x & 63) == 0) atomicMax(kamax + plane, __float_as_uint(amax));
            }
        }
    }
    template <bool ACT> __device__ __forceinline__ void plane_sec(bf16_t* dst, int pbase, const Acc& acc, const pg8::Unit& u, int wr, int wc, int fr, int fq) const {
        const int b = u.pm >> 5, s0 = (u.pm & 31) * 256, dc0 = 32 * (wc & 1) + 8 * fq;
#pragma unroll
        for (int bj = 0; bj < 2; ++bj) {
            const int plane = b * 16 + pbase + 2 * bj + (wc >> 1);
#pragma unroll
            for (int ai = 0; ai < 2; ++ai)
#pragma unroll
                for (int m = 0; m < 4; ++m) {
                    const int s = s0 + 128 * ai + 64 * wr + 16 * m + fr;
                    f32x4 v0 = acc[ai][bj][m][0], v1 = acc[ai][bj][m][1];
                    if (ACT) {
#pragma unroll
                        for (int j = 0; j < 4; ++j) { v0[j] = v0[j] * sigmoidf_(v0[j]); v1[j] = v1[j] * sigmoidf_(v1[j]); } }
                    *(u32x4*)(dst + ((size_t)plane * SEQ + s) * 64 + dc0) = pack8(v0, v1);
                }
        }
    }
    __device__ __forceinline__ void qf_sec(const Acc& acc, const pg8::Unit& u, int wr, int wc, int fr, int fq) const {
        const int b = u.pm >> 5, s0 = (u.pm & 31) * 256;
        {
            const int h = u.pn, hp = b * 16 + 2 * h + (wc >> 1);
#pragma unroll
            for (int nn = 0; nn < 2; ++nn) {
                const int dc0 = 32 * (wc & 1) + 8 * fq + 4 * nn, lcol = h * 128 + 32 * wc + 8 * fq + 4 * nn;
                float lb[4];
#pragma unroll
                for (int i = 0; i < 4; ++i) { const float l0 = lbl[lcol + i], l1 = lbl[1024 + lcol + i]; lb[i] = 1.0f / (1.0f + __expf(l1 - l0)); }
#pragma unroll
                for (int ai = 0; ai < 2; ++ai) {
                    float bcs[4][4], kk[4][4];
#pragma unroll
                    for (int m = 0; m < 4; ++m)
#pragma unroll
                        for (int i = 0; i < 4; ++i) {
                            const float zf = acc[ai][1][m][nn][i];
                            const float e = __expf(-zf), sg = __builtin_amdgcn_rcpf(1.0f + e);
                            kk[m][i] = (1.0f - lb[i]) * (e * sg);
                            float v = __logf(lb[i] + (1.0f - lb[i]) * sg);
#pragma unroll
                            for (int o = 1; o < 16; o <<= 1) { const float t = __shfl_up(v, o, 16); if (fr >= o) v += t; }
                            bcs[m][i] = v;
                        }
                    float bmid[4], blast[4];
#pragma unroll
                    for (int i = 0; i < 4; ++i) {
                        float base = 0.f;
#pragma unroll
                        for (int m = 0; m < 4; ++m) { const float tot = __shfl(bcs[m][i], 15, 16); bcs[m][i] += base; base += tot; }
                        bmid[i] = __shfl(bcs[1][i], 15, 16); blast[i] = __shfl(bcs[3][i], 15, 16);
                    }
#pragma unroll
                    for (int m = 0; m < 4; ++m) {
                        const int s = s0 + 128 * ai + 64 * wr + 16 * m + fr;
                        f32x4 qv, kv;
#pragma unroll
                        for (int i = 0; i < 4; ++i) {
                            const float zq = acc[ai][0][m][nn][i];
                            const float ex = __expf(bcs[m][i] - bmid[i]);
                            qv[i] = zq * sigmoidf_(zq) * DKS * ex;
                            kv[i] = kk[m][i] * __builtin_amdgcn_rcpf(ex);
                        }
                        const size_t off = ((size_t)hp * SEQ + s) * 64 + dc0;
                        u32x2 wq_, wk_; wq_.x = cvt_pk_bf16(qv[0], qv[1]); wq_.y = cvt_pk_bf16(qv[2], qv[3]); wk_.x = cvt_pk_bf16(kv[0], kv[1]); wk_.y = cvt_pk_bf16(kv[2], kv[3]);
                        *(u32x2*)(QI + off) = wq_; *(u32x2*)(KI + off) = wk_;
                    }
                    if (fr == 15) {
                        const int chunk = (s0 + 128 * ai + 64 * wr) >> 6;
                        const size_t eo = (((size_t)(b * BH + h)) * NCH + chunk) * 128 + 32 * wc + 8 * fq + 4 * nn;
                        f32x4 a0, c0;
#pragma unroll
                        for (int i = 0; i < 4; ++i) { a0[i] = __expf(bmid[i]); c0[i] = __expf(blast[i] - bmid[i]); }
                        *(f32x4*)(E1 + eo) = a0; *(f32x4*)(E2 + eo) = c0;
                    }
                }
            }
        }
    }
};
template <bool ISK> struct EpiRope { static constexpr bool MID = false; EpiZ z;
    __device__ __forceinline__ void mid(Acc&, const pg8::Unit&, int, int, int, int) const {}
    __device__ __forceinline__ void operator()(const Acc& acc, const pg8::Unit& u, int wr, int wc, int fr, int fq) const { z.template rope_sec<ISK>(ISK ? z.Kp : z.Q, acc, u, wr, wc, fr, fq); } };
template <bool ACT> struct EpiPlane { static constexpr bool MID = false; EpiZ z; bf16_t* dst;
    __device__ __forceinline__ void mid(Acc&, const pg8::Unit&, int, int, int, int) const {}
    __device__ __forceinline__ void operator()(const Acc& acc, const pg8::Unit& u, int wr, int wc, int fr, int fq) const { z.template plane_sec<ACT>(dst, 4 * u.pn, acc, u, wr, wc, fr, fq); } };
struct EpiQF { static constexpr bool MID = false; EpiZ z;
    __device__ __forceinline__ void mid(Acc&, const pg8::Unit&, int, int, int, int) const {}
    __device__ __forceinline__ void operator()(const Acc& acc, const pg8::Unit& u, int wr, int wc, int fr, int fq) const { z.qf_sec(acc, u, wr, wc, fr, fq); } };
struct EpiKV {
    static constexpr bool MID = false;
    bf16_t *KX, *VX;
    __device__ __forceinline__ void mid(Acc&, const pg8::Unit&, int, int, int, int) const {}
    __device__ __forceinline__ void operator()(const Acc& acc, const pg8::Unit& u, int wr, int wc, int fr, int fq) const {
        bf16_t* dst = (u.pn < 4 ? KX : VX) + (size_t)(u.pm * 4 + (u.pn & 3)) * 256 * 256;
#pragma unroll
        for (int ai = 0; ai < 2; ++ai)
#pragma unroll
            for (int m = 0; m < 4; ++m) { const int r = 128 * ai + 64 * wr + 16 * m + fr;
#pragma unroll
                for (int bj = 0; bj < 2; ++bj) *(u32x4*)(dst + (size_t)r * 256 + 128 * bj + 32 * wc + 8 * fq) = pack8(acc[ai][bj][m][0], acc[ai][bj][m][1]); }
    }
};
struct EpiGate {
    static constexpr bool MID = false;
    bf16_t *RAT, *SGB;
    __device__ __forceinline__ void mid(Acc&, const pg8::Unit&, int, int, int, int) const {}
    __device__ __forceinline__ void operator()(const Acc& acc, const pg8::Unit& u, int wr, int wc, int fr, int fq) const {
        const int c0 = 128 * u.pn + 32 * wc + 8 * fq;
#pragma unroll
        for (int ai = 0; ai < 2; ++ai)
#pragma unroll
            for (int m = 0; m < 4; ++m) { const size_t r = (size_t)u.pm * 256 + 128 * ai + 64 * wr + 16 * m + fr;
                f32x4 ra[2], sb[2];
#pragma unroll
                for (int n = 0; n < 2; ++n)
#pragma unroll
                    for (int j = 0; j < 4; ++j) { const float ea = __expf(-acc[ai][0][m][n][j]), eb = __expf(-acc[ai][1][m][n][j]); sb[n][j] = __builtin_amdgcn_rcpf(1.0f + eb); ra[n][j] = (1.0f + eb) * __builtin_amdgcn_rcpf(1.0f + ea); }
                *(u32x4*)(RAT + r * D + c0) = pack8(ra[0], ra[1]); *(u32x4*)(SGB + r * D + c0) = pack8(sb[0], sb[1]); }
    }
};
struct EpiMerged {
    static constexpr bool MID = true;
    const bf16_t *RAT, *SGB; bf16_t* MG;
    __device__ __forceinline__ void mid(Acc& acc, const pg8::Unit& u, int wr, int wc, int fr, int fq) const {
        const int c0 = 256 * u.pn + 32 * wc + 8 * fq;
#pragma unroll
        for (int ai = 0; ai < 2; ++ai)
#pragma unroll
            for (int m = 0; m < 4; ++m) { const size_t r = (size_t)u.pm * 256 + 128 * ai + 64 * wr + 16 * m + fr;
#pragma unroll
                for (int bj = 0; bj < 2; ++bj) { const u32x4 wa = *(const u32x4*)(RAT + r * D + c0 + 128 * bj);
                    f32x4 a0, a1; unpack8(wa, a0, a1); acc[ai][bj][m][0] *= a0; acc[ai][bj][m][1] *= a1; }
                asm volatile("" ::: "memory"); }
    }
    __device__ __forceinline__ void operator()(const Acc& acc, const pg8::Unit& u, int wr, int wc, int fr, int fq) const {
        const int c0 = 256 * u.pn + 32 * wc + 8 * fq;
#pragma unroll
        for (int ai = 0; ai < 2; ++ai)
#pragma unroll
            for (int m = 0; m < 4; ++m) { const size_t r = (size_t)u.pm * 256 + 128 * ai + 64 * wr + 16 * m + fr;
#pragma unroll
                for (int bj = 0; bj < 2; ++bj) { const u32x4 wb = *(const u32x4*)(SGB + r * D + c0 + 128 * bj); f32x4 b0, b1; unpack8(wb, b0, b1);
                    *(u32x4*)(MG + r * D + c0 + 128 * bj) = pack8(acc[ai][bj][m][0] * b0, acc[ai][bj][m][1] * b1); } }
    }
};
template <bool RBF> struct EpiRes {
    static constexpr bool MID = false;
    const void* R; bf16_t* Hb; float* ssq;
    __device__ __forceinline__ void mid(Acc&, const pg8::Unit&, int, int, int, int) const {}
    __device__ __forceinline__ void operator()(const Acc& acc, const pg8::Unit& u, int wr, int wc, int fr, int fq) const {
        const int c0 = 256 * u.pn + 32 * wc + 4 * fq;
#pragma unroll
        for (int ai = 0; ai < 2; ++ai)
#pragma unroll
            for (int m = 0; m < 4; ++m) { const size_t r = (size_t)u.pm * 256 + 128 * ai + 64 * wr + 16 * m + fr; float ss = 0.f;
#pragma unroll
                for (int bj = 0; bj < 2; ++bj)
#pragma unroll
                    for (int n = 0; n < 2; ++n) { const size_t off = r * D + c0 + 128 * bj + 16 * n; f32x4 h = acc[ai][bj][m][n];
                        if (RBF) { const u32x2 w = *(const u32x2*)((const bf16_t*)R + off); h[0] += bflo(w.x); h[1] += bfhi(w.x); h[2] += bflo(w.y); h[3] += bfhi(w.y); }
                        else h += *(const f32x4*)((const float*)R + off);
                        ss += (h[0] * h[0] + h[1] * h[1]) + (h[2] * h[2] + h[3] * h[3]);
                        u32x2 w; w.x = cvt_pk_bf16(h[0], h[1]); w.y = cvt_pk_bf16(h[2], h[3]); *(u32x2*)(Hb + off) = w; }
                ss += __shfl_xor(ss, 16); ss += __shfl_xor(ss, 32);
                if (fq == 0) atomicAdd(ssq + r, ss); }
    }
};
struct EpiScaleRow {
    static constexpr bool MID = false;
    const float* ssq; bf16_t* O; float scale;
    __device__ __forceinline__ void mid(Acc&, const pg8::Unit&, int, int, int, int) const {}
    __device__ __forceinline__ void operator()(const Acc& acc, const pg8::Unit& u, int wr, int wc, int fr, int fq) const {
        const int c0 = 256 * u.pn + 32 * wc + 8 * fq;
#pragma unroll
        for (int ai = 0; ai < 2; ++ai)
#pragma unroll
            for (int m = 0; m < 4; ++m) { const size_t r = (size_t)u.pm * 256 + 128 * ai + 64 * wr + 16 * m + fr; const float rs = rsqrtf(ssq[r] * (1.0f / D) + EPS) * scale;
#pragma unroll
                for (int bj = 0; bj < 2; ++bj) *(u32x4*)(O + r * D + c0 + 128 * bj) = pack8(acc[ai][bj][m][0] * rs, acc[ai][bj][m][1] * rs); }
    }
};
struct EpiSwiglu {
    static constexpr bool MID = false;
    const float* ssq; bf16_t* ACT;
    __device__ __forceinline__ void mid(Acc&, const pg8::Unit&, int, int, int, int) const {}
    __device__ __forceinline__ void operator()(const Acc& acc, const pg8::Unit& u, int wr, int wc, int fr, int fq) const {
        const int c0 = 128 * u.pn + 32 * wc + 8 * fq;
#pragma unroll
        for (int ai = 0; ai < 2; ++ai)
#pragma unroll
            for (int m = 0; m < 4; ++m) { const size_t r = (size_t)u.pm * 256 + 128 * ai + 64 * wr + 16 * m + fr; const float rs = rsqrtf(ssq[r] * (1.0f / D) + EPS);
                f32x4 o[2];
#pragma unroll
                for (int n = 0; n < 2; ++n)
#pragma unroll
                    for (int j = 0; j < 4; ++j) { const float gv = acc[ai][0][m][n][j] * rs, uv = acc[ai][1][m][n][j] * rs; o[n][j] = gv * sigmoidf_(gv) * uv; }
                *(u32x4*)(ACT + r * FFN + c0) = pack8(o[0], o[1]); }
    }
};

typedef short s16x4 __attribute__((ext_vector_type(4)));
typedef short v4i16_t __attribute__((ext_vector_type(4)));
__device__ __forceinline__ s16x4 tr_read(const LAS unsigned char* p) { return __builtin_bit_cast(s16x4, __builtin_amdgcn_ds_read_tr16_b64_v4i16((LAS v4i16_t*)p)); }
__device__ __forceinline__ bf16x8 mk8(s16x4 lo, s16x4 hi) { return (bf16x8){lo[0], lo[1], lo[2], lo[3], hi[0], hi[1], hi[2], hi[3]}; }
__device__ __forceinline__ bf16x8 tr_frag(const LAS unsigned char* base, int pitch, int r0, int c0, int lane) {
    const int g = lane >> 4, i = lane & 15; const LAS unsigned char* p = base + (r0 + 8 * g + (i >> 2)) * pitch + (c0 + 4 * (i & 3)) * 2;
    return mk8(tr_read(p), tr_read(p + 4 * pitch));
}
__device__ __forceinline__ bf16x8 tr_frag_split(const LAS unsigned char* base, int pitch, int r0, int c0, int lane) {
    const int g = lane >> 4, i = lane & 15; const LAS unsigned char* p = base + (r0 + 4 * g + (i >> 2)) * pitch + (c0 + 4 * (i & 3)) * 2;
    return mk8(tr_read(p), tr_read(p + 16 * pitch));
}
__device__ __forceinline__ bf16x8 ld_frag(const LAS unsigned char* base, int pitch, int row, int col) { return *(const LAS bf16x8*)(base + row * pitch + col * 2); }
#define MFMA16(A, B, C) __builtin_amdgcn_mfma_f32_16x16x32_bf16((A), (B), (C), 0, 0, 0)
#define LDS_FADD(p, v) ((void)__hip_atomic_fetch_add((LAS float*)(p), (v), __ATOMIC_RELAXED, __HIP_MEMORY_SCOPE_WORKGROUP))

namespace hg {
constexpr int PITCH = 272;
constexpr int TILE = 64 * PITCH, HBUF = 3 * TILE;
constexpr int OFF_SP = 2 * HBUF, OFF_AM = OFF_SP + 128 * PITCH, AMP = 144, OFF_RSS = OFF_AM + 64 * AMP, OFF_E = OFF_RSS + 512, END = OFF_E + 2 * 1024;
static_assert(END <= 160 * 1024, "hgrn lds");
}
__device__ __forceinline__ void hgrn_item(LAS unsigned char* lds, int b, int h, const bf16_t* QIp, bf16_t* OUTp, size_t omask, const bf16_t* KIp, const bf16_t* VBp, const bf16_t* OGp, const float* E1p, const float* E2p, const float* gh) {
    using namespace hg;
    const int tid = threadIdx.x, lane = tid & 63, w = __builtin_amdgcn_readfirstlane(tid >> 6), c = lane & 15, g = lane >> 4;
    const size_t pl0 = ((size_t)(b * 16 + 2 * h)) * SEQ * 64, pl1 = pl0 + (size_t)SEQ * 64;
    const size_t eb = ((size_t)(b * BH + h)) * NCH * 128;
    const int tt = w >> 1, dvh = w & 1;
    f32x4 S[8];
#pragma unroll
    for (int j = 0; j < 8; ++j) S[j] = (f32x4){0.f, 0.f, 0.f, 0.f};
    f32x4 ghv[4];
#pragma unroll
    for (int jj = 0; jj < 4; ++jj) ghv[jj] = *(const f32x4*)(gh + h * 128 + 64 * dvh + 16 * jj + 4 * g);
    const size_t oplane = (dvh ? pl1 : pl0) + (size_t)(16 * tt + c) * 64 + 4 * g;
    u32x4 pq[2], pk[2], pv[2]; float pe = 0.f;
    auto issue = [&](int ch) {
#pragma unroll
        for (int k = 0; k < 2; ++k) { const int i = tid + 512 * k, row = i >> 4, pc = i & 15; const size_t src = (pc < 8 ? pl0 : pl1) + ((size_t)(64 * ch + row)) * 64 + (pc & 7) * 8;
            pq[k] = *(const u32x4*)(QIp + src); pk[k] = *(const u32x4*)(KIp + src); pv[k] = *(const u32x4*)(VBp + src); }
        if (tid < 256) pe = (tid < 128 ? E1p : E2p)[eb + (size_t)ch * 128 + (tid & 127)];
    };
    auto commit = [&](int p) {
        LAS unsigned char* bufp = lds + p * HBUF;
#pragma unroll
        for (int k = 0; k < 2; ++k) { const int i = tid + 512 * k, row = i >> 4, pc = i & 15; const int o = row * PITCH + pc * 16;
            *(LAS u32x4*)(bufp + o) = pq[k]; *(LAS u32x4*)(bufp + TILE + o) = pk[k]; *(LAS u32x4*)(bufp + 2 * TILE + o) = pv[k]; }
        if (tid < 256) ((LAS float*)(lds + OFF_E + p * 1024))[tid] = pe;
    };
    __syncthreads();
    issue(0); commit(0);
    __syncthreads();
    for (int ch = 0; ch < NCH; ++ch) {
        const int p = ch & 1;
        const LAS unsigned char* qb_ = lds + p * HBUF; const LAS unsigned char* kb_ = qb_ + TILE; const LAS unsigned char* vb_ = qb_ + 2 * TILE;
        const LAS float* e1s = (const LAS float*)(lds + OFF_E + p * 1024); const LAS float* e2s = e1s + 128;
        u32x2 ogv[4];
#pragma unroll
        for (int jj = 0; jj < 4; ++jj) ogv[jj] = *(const u32x2*)(OGp + oplane + (size_t)ch * 4096 + 16 * jj);
        issue(ch + 1 < NCH ? ch + 1 : ch);
#pragma unroll
        for (int s2 = 0; s2 < 2; ++s2) {
            const int si = 2 * (w & 1) + s2; f32x4 acc = {0.f, 0.f, 0.f, 0.f};
#pragma unroll
            for (int ks = 0; ks < 4; ++ks) acc = MFMA16(ld_frag(kb_, PITCH, 16 * si + c, 32 * ks + 8 * g), ld_frag(qb_, PITCH, 16 * tt + c, 32 * ks + 8 * g), acc);
#pragma unroll
            for (int r = 0; r < 4; ++r) acc[r] = (16 * si + 4 * g + r > 16 * tt + c) ? 0.f : acc[r];
            u32x2 w_; w_.x = cvt_pk_bf16(acc[0], acc[1]); w_.y = cvt_pk_bf16(acc[2], acc[3]);
            *(LAS u32x2*)(lds + OFF_AM + (16 * tt + c) * AMP + (16 * si + 4 * g) * 2) = w_;
        }
        {
            const f32x4 e1v = *(const LAS f32x4*)(e1s + 16 * w + 4 * g);
#pragma unroll
            for (int j = 0; j < 8; ++j) { S[j] = S[j] * e1v; u32x2 w_; w_.x = cvt_pk_bf16(S[j][0], S[j][1]); w_.y = cvt_pk_bf16(S[j][2], S[j][3]);
                *(LAS u32x2*)(lds + OFF_SP + (16 * j + c) * PITCH + (16 * w + 4 * g) * 2) = w_; }
        }
        __syncthreads();
        f32x4 o[4];
        {
            bf16x8 aq[4], aa[2];
#pragma unroll
            for (int ks = 0; ks < 4; ++ks) aq[ks] = ld_frag(qb_, PITCH, 16 * tt + c, 32 * ks + 8 * g);
#pragma unroll
            for (int j2 = 0; j2 < 2; ++j2) aa[j2] = ld_frag(lds + OFF_AM, AMP, 16 * tt + c, 32 * j2 + 8 * g);
            float ss = 0.f;
#pragma unroll
            for (int jj = 0; jj < 4; ++jj) {
                const int j = 4 * dvh + jj; f32x4 acc = {0.f, 0.f, 0.f, 0.f};
#pragma unroll
                for (int ks = 0; ks < 4; ++ks) acc = MFMA16(ld_frag(lds + OFF_SP, PITCH, 16 * j + c, 32 * ks + 8 * g), aq[ks], acc);
#pragma unroll
                for (int j2 = 0; j2 < 2; ++j2) acc = MFMA16(tr_frag(vb_, PITCH, 32 * j2, 16 * j, lane), aa[j2], acc);
                o[jj] = acc; ss += (acc[0] * acc[0] + acc[1] * acc[1]) + (acc[2] * acc[2] + acc[3] * acc[3]);
            }
            ss += __shfl_xor(ss, 16); ss += __shfl_xor(ss, 32);
            if (g == 0) ((LAS float*)(lds + OFF_RSS))[(16 * tt + c) * 2 + dvh] = ss;
        }
        __syncthreads();
        {
            const LAS float* rp = (const LAS float*)(lds + OFF_RSS) + (16 * tt + c) * 2; const float rs = rsqrtf((rp[0] + rp[1]) * (1.0f / 128.0f) + EPS);
#pragma unroll
            for (int jj = 0; jj < 4; ++jj) { const f32x4 v = o[jj] * rs * ghv[jj]; u32x2 w_;
                w_.x = cvt_pk_bf16(v[0] * bflo(ogv[jj].x), v[1] * bfhi(ogv[jj].x)); w_.y = cvt_pk_bf16(v[2] * bflo(ogv[jj].y), v[3] * bfhi(ogv[jj].y));
                *(u32x2*)(OUTp + ((oplane + (size_t)ch * 4096 + 16 * jj) & omask)) = w_; }
            bf16x8 ak[2];
#pragma unroll
            for (int k2 = 0; k2 < 2; ++k2) ak[k2] = tr_frag(kb_, PITCH, 32 * k2, 16 * w, lane);
            const f32x4 e2v = *(const LAS f32x4*)(e2s + 16 * w + 4 * g);
#pragma unroll
            for (int j = 0; j < 8; ++j) {
#pragma unroll
                for (int k2 = 0; k2 < 2; ++k2) S[j] = MFMA16(ak[k2], tr_frag(vb_, PITCH, 32 * k2, 16 * j, lane), S[j]);
                S[j] = S[j] * e2v;
            }
            commit(p ^ 1);
        }
        __syncthreads();
    }
}

namespace hg {
constexpr int NSEG = 8, SEGCH = NCH / NSEG;
}
__device__ __forceinline__ void hgrn_seg_a(LAS unsigned char* lds, int b, int h, int seg, const bf16_t* QIp, bf16_t* KIp, bf16_t* VBp, const float* E1p, const float* E2p) {
    using namespace hg;
    const int tid = threadIdx.x, lane = tid & 63, w = __builtin_amdgcn_readfirstlane(tid >> 6), c = lane & 15, g = lane >> 4;
    const size_t pl0 = ((size_t)(b * 16 + 2 * h)) * SEQ * 64, pl1 = pl0 + (size_t)SEQ * 64;
    const size_t eb = ((size_t)(b * BH + h)) * NCH * 128;
    const int tt = w >> 1, dvh = w & 1, ch0 = seg * SEGCH;
    f32x4 S[8];
#pragma unroll
    for (int j = 0; j < 8; ++j) S[j] = (f32x4){0.f, 0.f, 0.f, 0.f};
    f32x4 Dv = {1.f, 1.f, 1.f, 1.f};
    const size_t oplane = (dvh ? pl1 : pl0) + (size_t)(16 * tt + c) * 64 + 4 * g;
    u32x4 pq[2], pk[2], pv[2]; float pe = 0.f;
    auto issue = [&](int ch) {
#pragma unroll
        for (int k = 0; k < 2; ++k) { const int i = tid + 512 * k, row = i >> 4, pc = i & 15; const size_t src = (pc < 8 ? pl0 : pl1) + ((size_t)(64 * ch + row)) * 64 + (pc & 7) * 8;
            pq[k] = *(const u32x4*)(QIp + src); pk[k] = *(const u32x4*)(KIp + src); pv[k] = *(const u32x4*)(VBp + src); }
        if (tid < 256) pe = (tid < 128 ? E1p : E2p)[eb + (size_t)ch * 128 + (tid & 127)];
    };
    auto commit = [&](int p) {
        LAS unsigned char* bufp = lds + p * HBUF;
#pragma unroll
        for (int k = 0; k < 2; ++k) { const int i = tid + 512 * k, row = i >> 4, pc = i & 15; const int o = row * PITCH + pc * 16;
            *(LAS u32x4*)(bufp + o) = pq[k]; *(LAS u32x4*)(bufp + TILE + o) = pk[k]; *(LAS u32x4*)(bufp + 2 * TILE + o) = pv[k]; }
        if (tid < 256) ((LAS float*)(lds + OFF_E + p * 1024))[tid] = pe;
    };
    __syncthreads();
    issue(ch0); commit(0);
    __syncthreads();
    for (int cc = 0; cc < SEGCH; ++cc) {
        const int ch = ch0 + cc, p = cc & 1;
        const LAS unsigned char* qb_ = lds + p * HBUF; const LAS unsigned char* kb_ = qb_ + TILE; const LAS unsigned char* vb_ = qb_ + 2 * TILE;
        const LAS float* e1s = (const LAS float*)(lds + OFF_E + p * 1024); const LAS float* e2s = e1s + 128;
        issue(cc + 1 < SEGCH ? ch + 1 : ch);
#pragma unroll
        for (int s2 = 0; s2 < 2; ++s2) {
            const int si = 2 * (w & 1) + s2; f32x4 acc = {0.f, 0.f, 0.f, 0.f};
#pragma unroll
            for (int ks = 0; ks < 4; ++ks) acc = MFMA16(ld_frag(kb_, PITCH, 16 * si + c, 32 * ks + 8 * g), ld_frag(qb_, PITCH, 16 * tt + c, 32 * ks + 8 * g), acc);
#pragma unroll
            for (int r = 0; r < 4; ++r) acc[r] = (16 * si + 4 * g + r > 16 * tt + c) ? 0.f : acc[r];
            u32x2 w_; w_.x = cvt_pk_bf16(acc[0], acc[1]); w_.y = cvt_pk_bf16(acc[2], acc[3]);
            *(LAS u32x2*)(lds + OFF_AM + (16 * tt + c) * AMP + (16 * si + 4 * g) * 2) = w_;
        }
        const f32x4 e1v = *(const LAS f32x4*)(e1s + 16 * w + 4 * g), e2v = *(const LAS f32x4*)(e2s + 16 * w + 4 * g);
#pragma unroll
        for (int j = 0; j < 8; ++j) { S[j] = S[j] * e1v; u32x2 w_; w_.x = cvt_pk_bf16(S[j][0], S[j][1]); w_.y = cvt_pk_bf16(S[j][2], S[j][3]);
            *(LAS u32x2*)(lds + OFF_SP + (16 * j + c) * PITCH + (16 * w + 4 * g) * 2) = w_; }
        Dv = Dv * e1v * e2v;
        __syncthreads();
        {
            bf16x8 aq[4], aa[2];
#pragma unroll
            for (int ks = 0; ks < 4; ++ks) aq[ks] = ld_frag(qb_, PITCH, 16 * tt + c, 32 * ks + 8 * g);
#pragma unroll
            for (int j2 = 0; j2 < 2; ++j2) aa[j2] = ld_frag(lds + OFF_AM, AMP, 16 * tt + c, 32 * j2 + 8 * g);
#pragma unroll
            for (int jj = 0; jj < 4; ++jj) {
                const int j = 4 * dvh + jj; f32x4 acc = {0.f, 0.f, 0.f, 0.f};
#pragma unroll
                for (int ks = 0; ks < 4; ++ks) acc = MFMA16(ld_frag(lds + OFF_SP, PITCH, 16 * j + c, 32 * ks + 8 * g), aq[ks], acc);
#pragma unroll
                for (int j2 = 0; j2 < 2; ++j2) acc = MFMA16(tr_frag(vb_, PITCH, 32 * j2, 16 * j, lane), aa[j2], acc);
                u32x2 w_; w_.x = cvt_pk_bf16(acc[0], acc[1]); w_.y = cvt_pk_bf16(acc[2], acc[3]);
                *(u32x2*)(KIp + oplane + (size_t)ch * 4096 + 16 * jj) = w_;
            }
        }
        {
            bf16x8 ak[2];
#pragma unroll
            for (int k2 = 0; k2 < 2; ++k2) ak[k2] = tr_frag(kb_, PITCH, 32 * k2, 16 * w, lane);
#pragma unroll
            for (int j = 0; j < 8; ++j) {
#pragma unroll
                for (int k2 = 0; k2 < 2; ++k2) S[j] = MFMA16(ak[k2], tr_frag(vb_, PITCH, 32 * k2, 16 * j, lane), S[j]);
                S[j] = S[j] * e2v;
            }
            commit(p ^ 1);
        }
        __syncthreads();
    }
    float* Lg = (float*)(VBp + pl0 + (size_t)seg * SEGCH * 4096); float* Dg = (float*)(VBp + pl1 + (size_t)seg * SEGCH * 4096);
#pragma unroll
    for (int j = 0; j < 8; ++j)
#pragma unroll
        for (int r = 0; r < 4; ++r) Lg[(16 * w + 4 * g + r) * 128 + 16 * j + c] = S[j][r];
    if (c == 0) *(f32x4*)(Dg + 16 * w + 4 * g) = Dv;
}
__device__ __forceinline__ void hgrn_seg_b(LAS unsigned char* lds, int b, int h, int seg, bf16_t* QIp, const bf16_t* KIp, const bf16_t* VBp, const bf16_t* OGp, const float* E1p, const float* E2p, const float* gh) {
    using namespace hg;
    const int tid = threadIdx.x, lane = tid & 63, w = __builtin_amdgcn_readfirstlane(tid >> 6), c = lane & 15, g = lane >> 4;
    const size_t pl0 = ((size_t)(b * 16 + 2 * h)) * SEQ * 64, pl1 = pl0 + (size_t)SEQ * 64;
    const size_t eb = ((size_t)(b * BH + h)) * NCH * 128;
    const int tt = w >> 1, dvh = w & 1, ch0 = seg * SEGCH;
    f32x4 S[8];
#pragma unroll
    for (int j = 0; j < 8; ++j) S[j] = (f32x4){0.f, 0.f, 0.f, 0.f};
    for (int gp = 0; gp < seg; ++gp) {
        const float* Lg = (const float*)(VBp + pl0 + (size_t)gp * SEGCH * 4096); const float* Dg = (const float*)(VBp + pl1 + (size_t)gp * SEGCH * 4096);
        const f32x4 dv_ = *(const f32x4*)(Dg + 16 * w + 4 * g);
#pragma unroll
        for (int j = 0; j < 8; ++j)
#pragma unroll
            for (int r = 0; r < 4; ++r) S[j][r] = dv_[r] * S[j][r] + Lg[(16 * w + 4 * g + r) * 128 + 16 * j + c];
    }
    f32x4 ghv[4];
#pragma unroll
    for (int jj = 0; jj < 4; ++jj) ghv[jj] = *(const f32x4*)(gh + h * 128 + 64 * dvh + 16 * jj + 4 * g);
    const size_t oplane = (dvh ? pl1 : pl0) + (size_t)(16 * tt + c) * 64 + 4 * g;
    const size_t qrow = (size_t)(16 * tt + c) * 64 + 8 * g;
    f32x4 P = {1.f, 1.f, 1.f, 1.f};
    __syncthreads();
    for (int cc = 0; cc < SEGCH; ++cc) {
        const int ch = ch0 + cc;
        bf16x8 qf[4]; u32x2 ol[4], ogv[4];
#pragma unroll
        for (int ks = 0; ks < 4; ++ks) qf[ks] = *(const bf16x8*)(QIp + ((ks >> 1) ? pl1 : pl0) + (size_t)ch * 4096 + qrow + 32 * (ks & 1));
#pragma unroll
        for (int jj = 0; jj < 4; ++jj) { ol[jj] = *(const u32x2*)(KIp + oplane + (size_t)ch * 4096 + 16 * jj); ogv[jj] = *(const u32x2*)(OGp + oplane + (size_t)ch * 4096 + 16 * jj); }
        const f32x4 e1r = *(const f32x4*)(E1p + eb + (size_t)ch * 128 + 16 * w + 4 * g), e2r = *(const f32x4*)(E2p + eb + (size_t)ch * 128 + 16 * w + 4 * g);
        const f32x4 cv = e1r * P;
#pragma unroll
        for (int j = 0; j < 8; ++j) { const f32x4 sv = S[j] * cv; u32x2 w_; w_.x = cvt_pk_bf16(sv[0], sv[1]); w_.y = cvt_pk_bf16(sv[2], sv[3]);
            *(LAS u32x2*)(lds + OFF_SP + (16 * j + c) * PITCH + (16 * w + 4 * g) * 2) = w_; }
        P = P * e1r * e2r;
        __syncthreads();
        f32x4 o[4]; float ss = 0.f;
#pragma unroll
        for (int jj = 0; jj < 4; ++jj) {
            const int j = 4 * dvh + jj; f32x4 acc = {bflo(ol[jj].x), bfhi(ol[jj].x), bflo(ol[jj].y), bfhi(ol[jj].y)};
#pragma unroll
            for (int ks = 0; ks < 4; ++ks) acc = MFMA16(ld_frag(lds + OFF_SP, PITCH, 16 * j + c, 32 * ks + 8 * g), qf[ks], acc);
            o[jj] = acc; ss += (acc[0] * acc[0] + acc[1] * acc[1]) + (acc[2] * acc[2] + acc[3] * acc[3]);
        }
        ss += __shfl_xor(ss, 16); ss += __shfl_xor(ss, 32);
        if (g == 0) ((LAS float*)(lds + OFF_RSS))[(16 * tt + c) * 2 + dvh] = ss;
        __syncthreads();
        const LAS float* rp = (const LAS float*)(lds + OFF_RSS) + (16 * tt + c) * 2; const float rs = rsqrtf((rp[0] + rp[1]) * (1.0f / 128.0f) + EPS);
#pragma unroll
        for (int jj = 0; jj < 4; ++jj) { const f32x4 v = o[jj] * rs * ghv[jj]; u32x2 w_;
            w_.x = cvt_pk_bf16(v[0] * bflo(ogv[jj].x), v[1] * bfhi(ogv[jj].x)); w_.y = cvt_pk_bf16(v[2] * bflo(ogv[jj].y), v[3] * bfhi(ogv[jj].y));
            *(u32x2*)(QIp + oplane + (size_t)ch * 4096 + 16 * jj) = w_; }
    }
}

namespace mb {
constexpr int KP_ = 144;
constexpr int OFF_K = 0, OFF_V = 256 * KP_, OFF_KM = 2 * 256 * KP_, OFF_CNT = OFF_KM + 8192, OFF_BASE = OFF_CNT + 128, END = OFF_BASE + 128;
static_assert(END <= 160 * 1024, "moba lds");
constexpr size_t WS_PO = 264 * MiB, WS_PL = 456 * MiB, WS_LIST = 462 * MiB;
constexpr int LIST_PER_BH = 256 * 496;
static_assert(WS_PO + (size_t)64 * SEQ * 3 * 128 <= WS_PL && WS_PL + (size_t)64 * SEQ * 3 * 4 <= WS_LIST && WS_LIST + (size_t)64 * LIST_PER_BH * 2 <= 512 * MiB, "moba ws");
__device__ __forceinline__ int list_off(int n) { return 256 * (31 * n - (n * (n - 1)) / 2); }
}
__device__ __forceinline__ void mb_stage(LAS unsigned char* dst, const bf16_t* g, int tid) {
    u32x4 r[4];
#pragma unroll
    for (int k = 0; k < 4; ++k) { const int i = tid + 512 * k; r[k] = *(const u32x4*)(g + (size_t)(i >> 3) * 64 + (i & 7) * 8); }
#pragma unroll
    for (int k = 0; k < 4; ++k) { const int i = tid + 512 * k; *(LAS u32x4*)(dst + (i >> 3) * mb::KP_ + (i & 7) * 16) = r[k]; }
}
struct MbStage { u32x4 rk[4], rv[4]; };
__device__ __forceinline__ void mb_stage_issue(MbStage& st, const bf16_t* gk, const bf16_t* gv, int tid) {
#pragma unroll
    for (int k = 0; k < 4; ++k) { const int i = tid + 512 * k; const size_t o = (size_t)(i >> 3) * 64 + (i & 7) * 8; st.rk[k] = *(const u32x4*)(gk + o); st.rv[k] = *(const u32x4*)(gv + o); }
}
__device__ __forceinline__ void mb_stage_commit(const MbStage& st, LAS unsigned char* lds, int tid) {
#pragma unroll
    for (int k = 0; k < 4; ++k) { const int i = tid + 512 * k; const int o = (i >> 3) * mb::KP_ + (i & 7) * 16; *(LAS u32x4*)(lds + mb::OFF_K + o) = st.rk[k]; *(LAS u32x4*)(lds + mb::OFF_V + o) = st.rv[k]; }
}
__device__ __forceinline__ void mb_granule(const LAS unsigned char* lds, int lane, bf16x8 q0, bf16x8 q1, float mref, int qpos, int nstep, f32x4 (&o)[4], float& l) {
    using namespace mb;
    const int c = lane & 15, g = lane >> 4;
    float ls = 0.f;
#pragma unroll
    for (int dt = 0; dt < 4; ++dt) o[dt] = (f32x4){0.f, 0.f, 0.f, 0.f};
#pragma unroll
    for (int j = 0; j < 8; ++j) {
        if (j < nstep) {
            f32x4 s0 = {-mref, -mref, -mref, -mref}, s1 = s0;
            s0 = MFMA16(ld_frag(lds + OFF_K, KP_, 32 * j + c, 8 * g), q0, s0); s0 = MFMA16(ld_frag(lds + OFF_K, KP_, 32 * j + c, 32 + 8 * g), q1, s0);
            s1 = MFMA16(ld_frag(lds + OFF_K, KP_, 32 * j + 16 + c, 8 * g), q0, s1); s1 = MFMA16(ld_frag(lds + OFF_K, KP_, 32 * j + 16 + c, 32 + 8 * g), q1, s1);
#pragma unroll
            for (int r = 0; r < 4; ++r) { float p0 = __builtin_amdgcn_exp2f(s0[r]), p1 = __builtin_amdgcn_exp2f(s1[r]);
                p0 = (32 * j + 4 * g + r > qpos) ? 0.f : p0; p1 = (32 * j + 16 + 4 * g + r > qpos) ? 0.f : p1; s0[r] = p0; s1[r] = p1; ls += p0 + p1; }
            u32x4 w_; w_.x = cvt_pk_bf16(s0[0], s0[1]); w_.y = cvt_pk_bf16(s0[2], s0[3]); w_.z = cvt_pk_bf16(s1[0], s1[1]); w_.w = cvt_pk_bf16(s1[2], s1[3]);
            const bf16x8 pf = __builtin_bit_cast(bf16x8, w_);
#pragma unroll
            for (int dt = 0; dt < 4; ++dt) o[dt] = MFMA16(tr_frag_split(lds + OFF_V, KP_, 32 * j, 16 * dt, lane), pf, o[dt]);
        }
    }
    asm volatile("s_nop 15" : "+v"(o[0]), "+v"(o[1]), "+v"(o[2]), "+v"(o[3]));
    ls += __shfl_xor(ls, 16); ls += __shfl_xor(ls, 32); l = ls;
}
__device__ __forceinline__ float mb_mref(bf16x8 q0, bf16x8 q1, float kam) {
    float s = 0.f;
#pragma unroll
    for (int i = 0; i < 8; ++i) s += fabsf(bf2f((bf16_t)q0[i])) + fabsf(bf2f((bf16_t)q1[i]));
    s += __shfl_xor(s, 16); s += __shfl_xor(s, 32); return s * kam;
}
__device__ __forceinline__ void moba_gate_item(LAS unsigned char* lds, int bh, int bhl, int qb, const bf16_t* Qg, const float* kmeang, unsigned* gcnt, unsigned short* glist) {
    using namespace mb;
    int tid_ = threadIdx.x; asm volatile("" : "+v"(tid_)); const int tid = tid_;
    const size_t pbase = (size_t)bh * SEQ * 64;
    u32x4 rq[4]; float rkm[4];
#pragma unroll
    for (int k = 0; k < 4; ++k) { const int i = tid + 512 * k; rq[k] = *(const u32x4*)(Qg + pbase + (size_t)256 * qb * 64 + (size_t)(i >> 3) * 64 + (i & 7) * 8); rkm[k] = (i < qb * 64) ? kmeang[(size_t)bh * NBLK * 64 + i] : 0.f; }
    __syncthreads();
    LAS float* kms = (LAS float*)(lds + OFF_KM);
#pragma unroll
    for (int k = 0; k < 4; ++k) { const int i = tid + 512 * k; *(LAS u32x4*)(lds + OFF_K + (i >> 3) * KP_ + (i & 7) * 16) = rq[k]; kms[i] = rkm[k]; }
    if (tid < 32) ((LAS int*)(lds + OFF_CNT))[tid] = 0;
    __syncthreads();
    const int q = tid >> 1, hf = tid & 1; float qv[32];
#pragma unroll
    for (int k = 0; k < 4; ++k) { const u32x4 w_ = *(const LAS u32x4*)(lds + OFF_K + q * KP_ + hf * 64 + k * 16); f32x4 x0, x1; unpack8(w_, x0, x1);
#pragma unroll
        for (int e = 0; e < 4; ++e) { qv[8 * k + e] = x0[e]; qv[8 * k + 4 + e] = x1[e]; } }
    float v0 = -INFINITY, v1 = -INFINITY, v2 = -INFINITY; int i0 = -1, i1 = -1, i2 = -1;
    for (int n = 0; n < qb; ++n) { float gsum = 0.f; const LAS float* km = kms + n * 64 + hf * 32;
#pragma unroll
        for (int d = 0; d < 32; ++d) gsum += qv[d] * km[d];
        gsum += __shfl_xor(gsum, 1);
        if (gsum > v0) { v2 = v1; i2 = i1; v1 = v0; i1 = i0; v0 = gsum; i0 = n; } else if (gsum > v1) { v2 = v1; i2 = i1; v1 = gsum; i1 = n; } else if (gsum > v2) { v2 = gsum; i2 = n; } }
    int p0 = 0, p1 = 0, p2 = 0; LAS int* cnt = (LAS int*)(lds + OFF_CNT);
    if (hf == 0) {
        if (i0 >= 0) p0 = __hip_atomic_fetch_add(cnt + i0, 1, __ATOMIC_RELAXED, __HIP_MEMORY_SCOPE_WORKGROUP);
        if (i1 >= 0) p1 = __hip_atomic_fetch_add(cnt + i1, 1, __ATOMIC_RELAXED, __HIP_MEMORY_SCOPE_WORKGROUP);
        if (i2 >= 0) p2 = __hip_atomic_fetch_add(cnt + i2, 1, __ATOMIC_RELAXED, __HIP_MEMORY_SCOPE_WORKGROUP);
    }
    __syncthreads();
    if (tid < 32) { const int cn = cnt[tid]; ((LAS int*)(lds + OFF_BASE))[tid] = cn > 0 ? (int)atomicAdd(gcnt + bhl * 32 + tid, (unsigned)cn) : 0; }
    __syncthreads();
    if (hf == 0) {
        const LAS int* base = (const LAS int*)(lds + OFF_BASE); unsigned short* gl = glist + (size_t)bhl * LIST_PER_BH; const unsigned qg = (unsigned)(256 * qb + q);
        if (i0 >= 0) gl[list_off(i0) + base[i0] + p0] = (unsigned short)(qg);
        if (i1 >= 0) gl[list_off(i1) + base[i1] + p1] = (unsigned short)(qg | (1u << 13));
        if (i2 >= 0) gl[list_off(i2) + base[i2] + p2] = (unsigned short)(qg | (2u << 13));
    }
}
__device__ __forceinline__ void moba_part_item(LAS unsigned char* lds, int bh, int bhl, int n, int chunk, const bf16_t* Qg, const bf16_t* Kg, const bf16_t* Vg, const unsigned* kamaxg, const unsigned* gcnt, const unsigned short* glist, bf16_t* PO, float* PL) {
    using namespace mb;
    int tid_ = threadIdx.x; asm volatile("" : "+v"(tid_)); const int tid = tid_, lane = tid & 63, w = __builtin_amdgcn_readfirstlane(tid >> 6), c = lane & 15, g = lane >> 4;
    const int cnt = (int)gcnt[bhl * 32 + n], e0 = 512 * chunk;
    if (e0 >= cnt) return;
    const size_t pbase = (size_t)bh * SEQ * 64;
    MbStage st; mb_stage_issue(st, Kg + pbase + (size_t)256 * n * 64, Vg + pbase + (size_t)256 * n * 64, tid);
    const float kam = __uint_as_float(kamaxg[bh]); const unsigned short* gl = glist + (size_t)bhl * LIST_PER_BH + list_off(n);
    unsigned ent[4]; bool valid[4]; bf16x8 q0[4], q1[4];
#pragma unroll
    for (int k = 0; k < 4; ++k) { const int e = e0 + 16 * (w + 8 * k) + c; valid[k] = e < cnt; ent[k] = gl[valid[k] ? e : e0]; }
#pragma unroll
    for (int k = 0; k < 4; ++k) { const bf16_t* qr = Qg + pbase + (size_t)(ent[k] & 8191) * 64; q0[k] = *(const bf16x8*)(qr + 8 * g); q1[k] = *(const bf16x8*)(qr + 32 + 8 * g); }
    __syncthreads();
    mb_stage_commit(st, lds, tid);
    __syncthreads();
    if (e0 + 16 * w >= cnt) return;
    float mref[4], ls[4]; f32x4 o[4][4];
#pragma unroll
    for (int k = 0; k < 4; ++k) { mref[k] = valid[k] ? mb_mref(q0[k], q1[k], kam) : INFINITY; ls[k] = 0.f;
#pragma unroll
        for (int dt = 0; dt < 4; ++dt) o[k][dt] = (f32x4){0.f, 0.f, 0.f, 0.f}; }
#pragma unroll 1
    for (int j = 0; j < 8; ++j) {
        const bf16x8 ka0 = ld_frag(lds + OFF_K, KP_, 32 * j + c, 8 * g), ka1 = ld_frag(lds + OFF_K, KP_, 32 * j + c, 32 + 8 * g);
        const bf16x8 kb0 = ld_frag(lds + OFF_K, KP_, 32 * j + 16 + c, 8 * g), kb1 = ld_frag(lds + OFF_K, KP_, 32 * j + 16 + c, 32 + 8 * g);
        bf16x8 pf[4];
#pragma unroll
        for (int k = 0; k < 4; ++k) {
            f32x4 s0 = {0.f, 0.f, 0.f, 0.f}, s1 = {0.f, 0.f, 0.f, 0.f};
            s0 = MFMA16(ka0, q0[k], s0); s0 = MFMA16(ka1, q1[k], s0); s1 = MFMA16(kb0, q0[k], s1); s1 = MFMA16(kb1, q1[k], s1);
#pragma unroll
            for (int r = 0; r < 4; ++r) { s0[r] = __builtin_amdgcn_exp2f(s0[r] - mref[k]); s1[r] = __builtin_amdgcn_exp2f(s1[r] - mref[k]); ls[k] += s0[r] + s1[r]; }
            u32x4 w_; w_.x = cvt_pk_bf16(s0[0], s0[1]); w_.y = cvt_pk_bf16(s0[2], s0[3]); w_.z = cvt_pk_bf16(s1[0], s1[1]); w_.w = cvt_pk_bf16(s1[2], s1[3]);
            pf[k] = __builtin_bit_cast(bf16x8, w_); __builtin_amdgcn_sched_barrier(0);
        }
#pragma unroll
        for (int dt = 0; dt < 4; ++dt) { const bf16x8 vf = tr_frag_split(lds + OFF_V, KP_, 32 * j, 16 * dt, lane);
#pragma unroll
            for (int k = 0; k < 4; ++k) o[k][dt] = MFMA16(vf, pf[k], o[k][dt]); }
    }
#pragma unroll
    for (int k = 0; k < 4; ++k) {
        float l = ls[k]; l += __shfl_xor(l, 16); l += __shfl_xor(l, 32);
        if (valid[k]) { const int q = ent[k] & 8191, j = ent[k] >> 13; const size_t slot = ((size_t)bhl * SEQ + q) * 3 + j; bf16_t* po = PO + slot * 64 + 4 * g;
#pragma unroll
            for (int dt = 0; dt < 4; ++dt) { u32x2 w_; w_.x = cvt_pk_bf16(o[k][dt][0], o[k][dt][1]); w_.y = cvt_pk_bf16(o[k][dt][2], o[k][dt][3]); *(u32x2*)(po + 16 * dt) = w_; }
            if (g == 0) PL[slot] = l; }
    }
}
__device__ __forceinline__ void moba_part_phase(LAS unsigned char* lds, const LAS int* pfx, int nitems, int mbi, int nmb, const bf16_t* Qg, const bf16_t* Kg, const bf16_t* Vg, const unsigned* kamaxg, const unsigned* gcnt, const unsigned short* glist, bf16_t* PO, float* PL) {
    using namespace mb;
    int tid_ = threadIdx.x; asm volatile("" : "+v"(tid_)); const int tid = tid_, lane = tid & 63, w = __builtin_amdgcn_readfirstlane(tid >> 6), c = lane & 15, g = lane >> 4;
    MbStage st; unsigned ent[4]; bool valid[4]; int bh = 0, bhl = 0, cnt = 0, e0 = 0; bool have = false;
    auto fetch = [&](int r) {
        const int k = r * nmb + ((r & 1) ? nmb - 1 - mbi : mbi);
        have = (r * nmb < nitems) && (k < nitems);
        if (!have) return;
        int lo_ = 0, hi_ = 2047;
        while (lo_ < hi_) { const int mid = (lo_ + hi_) >> 1; if (pfx[mid] > k) hi_ = mid; else lo_ = mid + 1; }
        const int n = lo_ >> 6; bhl = lo_ & 63; const int chunk = k - (lo_ ? pfx[lo_ - 1] : 0); bh = bhl;
        cnt = (int)gcnt[bhl * 32 + n]; e0 = 512 * chunk;
        const size_t pbase = (size_t)bh * SEQ * 64;
        mb_stage_issue(st, Kg + pbase + (size_t)256 * n * 64, Vg + pbase + (size_t)256 * n * 64, tid);
        const unsigned short* gl = glist + (size_t)bhl * LIST_PER_BH + list_off(n);
#pragma unroll
        for (int k4 = 0; k4 < 4; ++k4) { const int e = e0 + 16 * (w + 8 * k4) + c; valid[k4] = e < cnt; ent[k4] = gl[valid[k4] ? e : e0]; }
    };
    fetch(0);
    for (int r = 0; have; ++r) {
        const int cbh = bh, cbhl = bhl, ccnt = cnt, ce0 = e0; unsigned cent[4]; bool cval[4]; bf16x8 q0[4], q1[4];
        const size_t pbase = (size_t)cbh * SEQ * 64;
#pragma unroll
        for (int k = 0; k < 4; ++k) { cent[k] = ent[k]; cval[k] = valid[k]; const bf16_t* qr = Qg + pbase + (size_t)(cent[k] & 8191) * 64; q0[k] = *(const bf16x8*)(qr + 8 * g); q1[k] = *(const bf16x8*)(qr + 32 + 8 * g); }
        const float kam = __uint_as_float(kamaxg[cbh]);
        __syncthreads();
        mb_stage_commit(st, lds, tid);
        __syncthreads();
        fetch(r + 1);
        if (ce0 + 16 * w < ccnt) {
            float nmr[4], ls[4]; f32x4 o[4][4];
#pragma unroll
            for (int k = 0; k < 4; ++k) { nmr[k] = cval[k] ? -mb_mref(q0[k], q1[k], kam) : -INFINITY; ls[k] = 0.f;
#pragma unroll
                for (int dt = 0; dt < 4; ++dt) o[k][dt] = (f32x4){0.f, 0.f, 0.f, 0.f}; }
#pragma unroll 1
            for (int j = 0; j < 8; ++j) {
                const bf16x8 ka0 = ld_frag(lds + OFF_K, KP_, 32 * j + c, 8 * g), ka1 = ld_frag(lds + OFF_K, KP_, 32 * j + c, 32 + 8 * g);
                const bf16x8 kb0 = ld_frag(lds + OFF_K, KP_, 32 * j + 16 + c, 8 * g), kb1 = ld_frag(lds + OFF_K, KP_, 32 * j + 16 + c, 32 + 8 * g);
                bf16x8 pf[4];
#pragma unroll
                for (int k = 0; k < 4; ++k) {
                    f32x4 s0 = {nmr[k], nmr[k], nmr[k], nmr[k]}, s1 = s0;
                    s0 = MFMA16(ka0, q0[k], s0); s0 = MFMA16(ka1, q1[k], s0); s1 = MFMA16(kb0, q0[k], s1); s1 = MFMA16(kb1, q1[k], s1);
#pragma unroll
                    for (int rr = 0; rr < 4; ++rr) { s0[rr] = __builtin_amdgcn_exp2f(s0[rr]); s1[rr] = __builtin_amdgcn_exp2f(s1[rr]); ls[k] += s0[rr] + s1[rr]; }
                    u32x4 w_; w_.x = cvt_pk_bf16(s0[0], s0[1]); w_.y = cvt_pk_bf16(s0[2], s0[3]); w_.z = cvt_pk_bf16(s1[0], s1[1]); w_.w = cvt_pk_bf16(s1[2], s1[3]);
                    pf[k] = __builtin_bit_cast(bf16x8, w_); __builtin_amdgcn_sched_barrier(0);
                }
#pragma unroll
                for (int dt = 0; dt < 4; ++dt) { const bf16x8 vf = tr_frag_split(lds + OFF_V, KP_, 32 * j, 16 * dt, lane);
#pragma unroll
                    for (int k = 0; k < 4; ++k) o[k][dt] = MFMA16(vf, pf[k], o[k][dt]); }
            }
#pragma unroll
            for (int k = 0; k < 4; ++k) {
                float l = ls[k]; l += __shfl_xor(l, 16); l += __shfl_xor(l, 32);
                if (cval[k]) { const int q = cent[k] & 8191, j = cent[k] >> 13; const size_t slot = ((size_t)cbhl * SEQ + q) * 3 + j; bf16_t* po = PO + slot * 64 + 4 * g;
#pragma unroll
                    for (int dt = 0; dt < 4; ++dt) { u32x2 w_; w_.x = cvt_pk_bf16(o[k][dt][0], o[k][dt][1]); w_.y = cvt_pk_bf16(o[k][dt][2], o[k][dt][3]); *(u32x2*)(po + 16 * dt) = w_; }
                    if (g == 0) PL[slot] = l; }
            }
        }
    }
}
__device__ __forceinline__ void moba_comb_item(LAS unsigned char* lds, int bh, int bhl, int qb, bf16_t* Qg, const bf16_t* Kg, const bf16_t* Vg, const unsigned* kamaxg, const bf16_t* PO, const float* PL) {
    using namespace mb;
    int tid_ = threadIdx.x; asm volatile("" : "+v"(tid_)); const int tid = tid_, lane = tid & 63, w = __builtin_amdgcn_readfirstlane(tid >> 6), c = lane & 15, g = lane >> 4;
    const size_t pbase = (size_t)bh * SEQ * 64;
    MbStage st; mb_stage_issue(st, Kg + pbase + (size_t)256 * qb * 64, Vg + pbase + (size_t)256 * qb * 64, tid);
    const float kam = __uint_as_float(kamaxg[bh]); const int nsel = qb < 3 ? qb : 3;
    bf16x8 q0[2], q1[2];
#pragma unroll
    for (int k = 0; k < 2; ++k) { const int gq = k ? 15 - w : w; const bf16_t* qr = Qg + pbase + (size_t)(256 * qb + 16 * gq + c) * 64; q0[k] = *(const bf16x8*)(qr + 8 * g); q1[k] = *(const bf16x8*)(qr + 32 + 8 * g); }
    __syncthreads();
    mb_stage_commit(st, lds, tid);
    __syncthreads();
#pragma unroll 1
    for (int k = 0; k < 2; ++k) {
        const int gq = k ? 15 - w : w, ql = 16 * gq + c, q = 256 * qb + ql;
        const bf16x8 qa = k ? q0[1] : q0[0], qb_ = k ? q1[1] : q1[0];
        const size_t slot = ((size_t)bhl * SEQ + q) * 3;
        u32x2 pp[3][4]; float pl[3];
#pragma unroll
        for (int j = 0; j < 3; ++j) { const bool on = j < nsel; pl[j] = on ? PL[slot + j] : 0.f; const bf16_t* po = PO + (slot + (on ? j : 0)) * 64 + 4 * g;
#pragma unroll
            for (int dt = 0; dt < 4; ++dt) pp[j][dt] = on ? *(const u32x2*)(po + 16 * dt) : (u32x2){0u, 0u}; }
        const float mref = mb_mref(qa, qb_, kam);
        f32x4 o[4]; float l; mb_granule(lds, lane, qa, qb_, mref, ql, (gq >> 1) + 1, o, l);
#pragma unroll
        for (int j = 0; j < 3; ++j) { l += pl[j];
#pragma unroll
            for (int dt = 0; dt < 4; ++dt) { o[dt][0] += bflo(pp[j][dt].x); o[dt][1] += bfhi(pp[j][dt].x); o[dt][2] += bflo(pp[j][dt].y); o[dt][3] += bfhi(pp[j][dt].y); } }
        const float rl = 1.0f / l; bf16_t* qr = Qg + pbase + (size_t)q * 64;
#pragma unroll
        for (int dt = 0; dt < 4; ++dt) { u32x2 w_; w_.x = cvt_pk_bf16(o[dt][0] * rl, o[dt][1] * rl); w_.y = cvt_pk_bf16(o[dt][2] * rl, o[dt][3] * rl); *(u32x2*)(qr + 16 * dt + 4 * g) = w_; }
    }
}

namespace xa {
constexpr int P = 528;
constexpr int OFF_K = 0, OFF_V = 128 * P, END = 2 * 128 * P;
static_assert(END <= 160 * 1024, "xattn lds");
}
__device__ __forceinline__ void xattn_item(LAS unsigned char* lds, int b, int hx, int tile, const bf16_t* QXg, const bf16_t* KXg, const bf16_t* VXg, bf16_t* OXg) {
    using namespace xa;
    const int tid = threadIdx.x, lane = tid & 63, w = __builtin_amdgcn_readfirstlane(tid >> 6), c = lane & 15, g = lane >> 4;
    const size_t tok = (size_t)b * SEQ + 128 * tile + 16 * w + c;
    bf16x8 qf[8];
#pragma unroll
    for (int ks = 0; ks < 8; ++ks) qf[ks] = *(const bf16x8*)(QXg + tok * D + hx * 256 + 32 * ks + 8 * g);
    f32x4 o[16];
#pragma unroll
    for (int dt = 0; dt < 16; ++dt) o[dt] = (f32x4){0.f, 0.f, 0.f, 0.f};
    float m = -INFINITY, l = 0.f;
    const bf16_t* kb = KXg + (size_t)(b * 4 + hx) * 256 * 256; const bf16_t* vb = VXg + (size_t)(b * 4 + hx) * 256 * 256;
    for (int hb = 0; hb < 2; ++hb) {
        __syncthreads();
#pragma unroll
        for (int k = 0; k < 8; ++k) { const int i = tid + 512 * k, row = i >> 5, pc = i & 31;
            *(LAS u32x4*)(lds + OFF_K + row * P + pc * 16) = *(const u32x4*)(kb + (size_t)(128 * hb + row) * 256 + pc * 8);
            *(LAS u32x4*)(lds + OFF_V + row * P + pc * 16) = *(const u32x4*)(vb + (size_t)(128 * hb + row) * 256 + pc * 8); }
        __syncthreads();
        f32x4 s[8]; float mx = -INFINITY;
#pragma unroll
        for (int t = 0; t < 8; ++t) { f32x4 acc = {0.f, 0.f, 0.f, 0.f};
#pragma unroll
            for (int ks = 0; ks < 8; ++ks) acc = MFMA16(ld_frag(lds + OFF_K, P, 16 * t + c, 32 * ks + 8 * g), qf[ks], acc);
            s[t] = acc; mx = fmaxf(mx, fmaxf(fmaxf(acc[0], acc[1]), fmaxf(acc[2], acc[3]))); }
        mx = fmaxf(mx, __shfl_xor(mx, 16)); mx = fmaxf(mx, __shfl_xor(mx, 32));
        const float mn = fmaxf(m, mx), alpha = __builtin_amdgcn_exp2f(m - mn); m = mn;
        float ls = 0.f;
#pragma unroll
        for (int t = 0; t < 8; ++t)
#pragma unroll
            for (int r = 0; r < 4; ++r) { const float p = __builtin_amdgcn_exp2f(s[t][r] - mn); s[t][r] = p; ls += p; }
        ls += __shfl_xor(ls, 16); ls += __shfl_xor(ls, 32);
        l = l * alpha + ls;
#pragma unroll
        for (int dt = 0; dt < 16; ++dt) o[dt] = o[dt] * alpha;
#pragma unroll
        for (int j = 0; j < 4; ++j) {
            u32x4 w_; w_.x = cvt_pk_bf16(s[2 * j][0], s[2 * j][1]); w_.y = cvt_pk_bf16(s[2 * j][2], s[2 * j][3]); w_.z = cvt_pk_bf16(s[2 * j + 1][0], s[2 * j + 1][1]); w_.w = cvt_pk_bf16(s[2 * j + 1][2], s[2 * j + 1][3]);
            const bf16x8 pf = __builtin_bit_cast(bf16x8, w_);
#pragma unroll
            for (int dt = 0; dt < 16; ++dt) o[dt] = MFMA16(tr_frag_split(lds + OFF_V, P, 32 * j, 16 * dt, lane), pf, o[dt]);
        }
    }
    const float rl = 1.0f / l;
#pragma unroll
    for (int dt = 0; dt < 16; ++dt) { u32x2 w_; w_.x = cvt_pk_bf16(o[dt][0] * rl, o[dt][1] * rl); w_.y = cvt_pk_bf16(o[dt][2] * rl, o[dt][3] * rl); *(u32x2*)(OXg + tok * D + hx * 256 + 16 * dt + 4 * g) = w_; }
}

struct Args {
    const float* x; const float* mem; const int* pos; const float* g_mix; const float* w_in; const float* lbl; const float* g_hgrn; const float* w_bra; const float* w_brh; const float* w_out;
    const float* g_x; const float* g_mem; const float* wq; const float* wkv; const float* wo; const float* g_ffn; const float* w_ffi; const float* w_ffo; const float* g_fin;
    float* out; unsigned char* ws; int ph_lo, ph_hi;
};

template <class MapFn>
__device__ __forceinline__ void wt_item(const float* W, int ldw, const float* gain, bf16_t* WT, int ldwt, int koff, int nblk, int item, LAS float* scr, int lane, MapFn colmap) {
    const int kb = item / nblk, nb = item % nblk, k0 = 64 * kb, n0 = 32 * nb;
    const int col = colmap(n0 + (lane & 31));
    float wv[32];
#pragma unroll
    for (int i = 0; i < 32; ++i) wv[i] = W[(size_t)(k0 + 2 * i + (lane >> 5)) * ldw + col];
    if (gain) {
#pragma unroll
        for (int i = 0; i < 32; ++i) wv[i] *= gain[k0 + 2 * i + (lane >> 5)]; }
#pragma unroll
    for (int i = 0; i < 32; ++i) scr[(2 * i + (lane >> 5)) * 33 + (lane & 31)] = wv[i];
    asm volatile("s_waitcnt lgkmcnt(0)" ::: "memory");
    const int c = lane & 7;
#pragma unroll
    for (int j = 0; j < 4; ++j) { const int n = (lane >> 3) + 8 * j; const LAS float* s = scr + (8 * c) * 33 + n;
        u32x4 o; o.x = cvt_pk_bf16(s[0 * 33], s[1 * 33]); o.y = cvt_pk_bf16(s[2 * 33], s[3 * 33]); o.z = cvt_pk_bf16(s[4 * 33], s[5 * 33]); o.w = cvt_pk_bf16(s[6 * 33], s[7 * 33]);
        *(u32x4*)(WT + (size_t)(n0 + n) * ldwt + koff + k0 + 8 * c) = o; }
    asm volatile("s_waitcnt lgkmcnt(0)" ::: "memory");
}
__device__ __forceinline__ int zmap(int n) {
    const int tile = n >> 8, p = n & 255, bj = p >> 7, wc = (p >> 5) & 3, nn = (p >> 4) & 1, fq = (p >> 2) & 3, j = p & 3;
    if (tile < 8) return 256 * tile + 64 * (2 * bj + (wc >> 1)) + 32 * nn + 16 * (wc & 1) + 4 * fq + j;
    if (tile < 12) return 2048 + 256 * (tile - 8) + perm8(p);
    if (tile < 20) return (bj ? 4096 : 3072) + 128 * (tile - 12) + (perm8(p) & 127);
    if (tile < 24) return 5120 + 256 * (tile - 20) + perm8(p);
    return 6144 + 256 * (tile - 24) + perm8(p);
}
__device__ __forceinline__ void norm_row_bf16(const float* xrow, const float* g, bf16_t* orow, int lane) {
    f32x4 v[4]; float s = 0.f;
#pragma unroll
    for (int j = 0; j < 4; ++j) { v[j] = ((const f32x4*)xrow)[lane + 64 * j]; s += (v[j][0] * v[j][0] + v[j][1] * v[j][1]) + (v[j][2] * v[j][2] + v[j][3] * v[j][3]); }
    const float rstd = rsqrtf(wave_sum(s) * (1.0f / D) + EPS);
#pragma unroll
    for (int j = 0; j < 4; ++j) { const f32x4 gg = ((const f32x4*)g)[lane + 64 * j]; u32x2 w; w.x = cvt_pk_bf16(v[j][0] * rstd * gg[0], v[j][1] * rstd * gg[1]); w.y = cvt_pk_bf16(v[j][2] * rstd * gg[2], v[j][3] * rstd * gg[3]);
        ((u32x2*)orow)[lane + 64 * j] = w; }
}
__device__ __forceinline__ void sincos_acc(float ang, float& sn, float& cs) {
    const double a = (double)ang; const double q = __builtin_rint(a * 0.6366197723675814);
    const double t = __builtin_fma(-q, 1.5707963267948966, a) - q * 6.123233995736766e-17;
    const double t2 = t * t;
    double sp = -2.5052108385441720e-08; sp = sp * t2 + 2.7557319223985893e-06; sp = sp * t2 - 1.9841269841269841e-04; sp = sp * t2 + 8.3333333333333332e-03; sp = sp * t2 - 1.6666666666666666e-01; sp = sp * t2 * t + t;
    double cp = 2.0876756987868099e-09; cp = cp * t2 - 2.7557319223985888e-07; cp = cp * t2 + 2.4801587301587302e-05; cp = cp * t2 - 1.3888888888888889e-03; cp = cp * t2 + 4.1666666666666664e-02; cp = cp * t2 - 0.5; cp = cp * t2 + 1.0;
    const int qi = ((int)q) & 3;
    const double s_ = (qi & 1) ? cp : sp, c_ = (qi & 1) ? sp : cp;
    sn = (float)((qi & 2) ? -s_ : s_); cs = (float)(((qi == 1) || (qi == 2)) ? -c_ : c_);
}

constexpr int LDS_BYTES = 160 * 1024;
__global__ void __launch_bounds__(512, 2) mega_fwd(Args a) {
    extern __shared__ __attribute__((aligned(16))) unsigned char lds_raw[];
    LAS unsigned char* lds = (LAS unsigned char*)lds_raw;
    const int tid = threadIdx.x, lane = tid & 63, wave = __builtin_amdgcn_readfirstlane(tid >> 6);
    const int G = gridDim.x, bx = blockIdx.x;
    const int vcu = (G % 8 == 0) ? (bx % 8) * (G / 8) + bx / 8 : bx;
    const int gw = vcu * 8 + wave, NGW = G * 8;
#define kmean ((float*)(a.ws + CTL_KMEAN))
#define kamax ((unsigned*)(a.ws + CTL_KAMAX))
#define ssq1 ((float*)(a.ws + CTL_SSQ1))
#define ssq2 ((float*)(a.ws + CTL_SSQ2))
#define ssq3 ((float*)(a.ws + CTL_SSQ3))
#define WZ ((bf16_t*)(a.ws + WS_WZ))
#define WG ((bf16_t*)(a.ws + WS_WG))
#define WBR ((bf16_t*)(a.ws + WS_WBR))
#define WOUT ((bf16_t*)(a.ws + WS_WOUT))
#define WQ ((bf16_t*)(a.ws + WS_WQ))
#define WKV ((bf16_t*)(a.ws + WS_WKV))
#define WO ((bf16_t*)(a.ws + WS_WO))
#define WFI ((bf16_t*)(a.ws + WS_WFI))
#define WFO ((bf16_t*)(a.ws + WS_WFO))
#define RC ((float*)(a.ws + WS_RC))
#define RS ((float*)(a.ws + WS_RS))
#define MEMN ((bf16_t*)(a.ws + WS_MEMN))
#define KX ((bf16_t*)(a.ws + WS_KX))
#define VX ((bf16_t*)(a.ws + WS_VX))
#define E1 ((float*)(a.ws + WS_E1))
#define E2 ((float*)(a.ws + WS_E2))
#define XN ((bf16_t*)(a.ws + WS_XN))
#define HB XN
#define QP ((bf16_t*)(a.ws + WS_Q))
#define QX QP
#define QI ((bf16_t*)(a.ws + WS_QI))
#define OX QI
#define KI ((bf16_t*)(a.ws + WS_KI))
#define RAT KI
#define VB ((bf16_t*)(a.ws + WS_VB))
#define SGB VB
#define OG ((bf16_t*)(a.ws + WS_OG))
#define MG OG
#define ACT ((bf16_t*)(a.ws + WS_ACT))
#define KP ((bf16_t*)a.out)
#define VP ((bf16_t*)((unsigned char*)a.out + 64 * MiB))
#define H (a.out)
    cg::grid_group grid = cg::this_grid();
    const int lo = a.ph_lo, hi = a.ph_hi;
#ifndef PH_MASK
#define PH_MASK 0xfff
#endif
#define IN(k) (((PH_MASK >> (k)) & 1) && lo <= (k) && (k) < hi)
#define XBAR(word, count) do { asm volatile("s_waitcnt vmcnt(0)" ::: "memory"); __syncthreads(); \
        if (tid == 0) { unsigned* bw_ = (unsigned*)(a.ws + WS_CTL) + 64 * (word); __builtin_amdgcn_fence(__ATOMIC_RELEASE, "agent"); asm volatile("s_waitcnt vmcnt(0)" ::: "memory"); \
            __hip_atomic_fetch_add(bw_, 1u, __ATOMIC_RELAXED, __HIP_MEMORY_SCOPE_AGENT); \
            while (__hip_atomic_load(bw_, __ATOMIC_RELAXED, __HIP_MEMORY_SCOPE_AGENT) < (unsigned)(count)) __builtin_amdgcn_s_sleep(2); \
            __builtin_amdgcn_fence(__ATOMIC_ACQUIRE, "agent"); asm volatile("s_waitcnt vmcnt(0)" ::: "memory"); } \
        __syncthreads(); } while (0)
#define SEAM(k) do { if (IN(k) && IN((k) + 1)) { if (a.ph_lo < 0) grid.sync(); else XBAR(100 + (k), G); } } while (0)
#ifndef DUP_MASK
#define DUP_MASK 0
#endif
#define REPS(k) for (int rep_ = 0; rep_ < (((DUP_MASK >> (k)) & 1) ? 2 : 1); ++rep_)

    if (IN(0)) {
        LAS float* scr = (LAS float*)(lds + wave * 16384);
        constexpr int I_Z = 16 * (ZN / 32), I_G = 16 * 64, I_BR = 16 * 32, I_SQ = 16 * 32, I_KV = 16 * 64, I_FI = 16 * 176, I_FO = 44 * 32;
        constexpr int NITEMS = I_Z + I_G + 2 * I_BR + 3 * I_SQ + I_KV + I_FI + I_FO;
        for (int it = gw; it < NITEMS; it += NGW) {
            int r = it;
            if (r < I_Z) { wt_item(a.w_in, 9216, nullptr, WZ, 1024, 0, ZN / 32, r, scr, lane, [](int n) { return zmap(n); }); continue; } r -= I_Z;
            if (r < I_G) { wt_item(a.w_in, 9216, nullptr, WG, 1024, 0, 64, r, scr, lane, [](int n) { const int p = n & 255; return ((p >> 7) ? 8192 : 7168) + 128 * (n >> 8) + (perm8(p) & 127); }); continue; } r -= I_G;
            if (r < I_BR) { wt_item(a.w_bra, 1024, nullptr, WBR, 2048, 0, 32, r, scr, lane, [](int n) { return (n & ~255) + perm8(n & 255); }); continue; } r -= I_BR;
            if (r < I_BR) { wt_item(a.w_brh, 1024, nullptr, WBR, 2048, 1024, 32, r, scr, lane, [](int n) { return (n & ~255) + perm8(n & 255); }); continue; } r -= I_BR;
            if (r < I_SQ) { wt_item(a.w_out, 1024, nullptr, WOUT, 1024, 0, 32, r, scr, lane, [](int n) { return n; }); continue; } r -= I_SQ;
            if (r < I_SQ) { wt_item(a.wq, 1024, a.g_x, WQ, 1024, 0, 32, r, scr, lane, [](int n) { return (n & ~255) + perm8(n & 255); }); continue; } r -= I_SQ;
            if (r < I_SQ) { wt_item(a.wo, 1024, nullptr, WO, 1024, 0, 32, r, scr, lane, [](int n) { return n; }); continue; } r -= I_SQ;
            if (r < I_KV) { wt_item(a.wkv, 2048, nullptr, WKV, 1024, 0, 64, r, scr, lane, [](int n) { return (n & ~255) + perm8(n & 255); }); continue; } r -= I_KV;
            if (r < I_FI) { wt_item(a.w_ffi, 2 * FFN, a.g_ffn, WFI, 1024, 0, 176, r, scr, lane, [](int n) { const int p = n & 255; return ((p >> 7) ? FFN : 0) + 128 * (n >> 8) + (perm8(p) & 127); }); continue; } r -= I_FI;
            wt_item(a.w_ffo, 1024, nullptr, WFO, FFN, 0, 32, r, scr, lane, [](int n) { return n; });
        }
        for (int m = gw; m < T; m += 2 * NGW) {
            const int m2 = m + NGW; f32x4 v0[4], v1[4]; float s0 = 0.f, s1 = 0.f;
#pragma unroll
            for (int j = 0; j < 4; ++j) { v0[j] = ((const f32x4*)(a.x + (size_t)m * D))[lane + 64 * j]; v1[j] = ((const f32x4*)(a.x + (size_t)m2 * D))[lane + 64 * j]; }
#pragma unroll
            for (int j = 0; j < 4; ++j) { s0 += (v0[j][0] * v0[j][0] + v0[j][1] * v0[j][1]) + (v0[j][2] * v0[j][2] + v0[j][3] * v0[j][3]); s1 += (v1[j][0] * v1[j][0] + v1[j][1] * v1[j][1]) + (v1[j][2] * v1[j][2] + v1[j][3] * v1[j][3]); }
            const float r0 = rsqrtf(wave_sum(s0) * (1.0f / D) + EPS), r1 = rsqrtf(wave_sum(s1) * (1.0f / D) + EPS);
#pragma unroll
            for (int j = 0; j < 4; ++j) { const f32x4 gg = ((const f32x4*)a.g_mix)[lane + 64 * j]; const f32x4 a0 = v0[j] * r0 * gg, a1 = v1[j] * r1 * gg; u32x2 w0, w1;
                w0.x = cvt_pk_bf16(a0[0], a0[1]); w0.y = cvt_pk_bf16(a0[2], a0[3]); w1.x = cvt_pk_bf16(a1[0], a1[1]); w1.y = cvt_pk_bf16(a1[2], a1[3]);
                ((u32x2*)(XN + (size_t)m * D))[lane + 64 * j] = w0; ((u32x2*)(XN + (size_t)m2 * D))[lane + 64 * j] = w1; }
        }
        for (int m = gw; m < NB * NMEM; m += NGW) norm_row_bf16(a.mem + (size_t)m * D, a.g_mem, MEMN + (size_t)m * D, lane);
        for (int i = bx * 512 + tid; i < T * 32; i += G * 512) {
            const int tok = i >> 5, f = i & 31;
            const float inv = powf(10000.0f, -(float)(2 * f) * (1.0f / 64.0f));
            const float ang = (float)a.pos[tok] * inv;
            float sn, cs; sincos_acc(ang, sn, cs); RC[i] = cs; RS[i] = sn;
        }
    }
    SEAM(0);
    if (IN(1)) {

        const EpiZ Z{QP, KP, VP, QI, KI, VB, OG, E1, E2, RC, RS, kmean, kamax, a.lbl};
#define ZSEC(EPI, einit, tile0, ntile) { pg8::Gemm g{pg8::a_rowmajor(XN, D), WZ + (size_t)(tile0) * 256 * D, T, (ntile) * 256, D}; pg8::StaticOrder S; S.init(T, (ntile) * 256, G, bx); \
            const EPI E einit; pg8::gemm_phase<EPI, true>(lds, g, S, E); }
        ZSEC(EpiRope<false>, {Z}, 0, 4)
        ZSEC(EpiRope<true>, {Z}, 4, 4)
        ZSEC(EpiPlane<false>, ({Z, VP}), 8, 4)
        ZSEC(EpiQF, {Z}, 12, 8)
        ZSEC(EpiPlane<false>, ({Z, VB}), 20, 4)
        ZSEC(EpiPlane<true>, ({Z, OG}), 24, 4)
    #if (DUP_MASK >> 1) & 1
        ZSEC(EpiRope<false>, {Z}, 0, 4)
        ZSEC(EpiRope<true>, {Z}, 4, 4)
        ZSEC(EpiPlane<false>, ({Z, VP}), 8, 4)
        ZSEC(EpiQF, {Z}, 12, 8)
        ZSEC(EpiPlane<false>, ({Z, VB}), 20, 4)
        ZSEC(EpiPlane<true>, ({Z, OG}), 24, 4)
    #endif
#undef ZSEC
    }
    SEAM(1);
    if (IN(2)) {
        for (int it = bx; it < NB * BH * hg::NSEG; it += G) hgrn_seg_a(lds, it / (BH * hg::NSEG), (it / hg::NSEG) % BH, it % hg::NSEG, QI, KI, VB, E1, E2);
        XBAR(120, G);
        for (int it = bx; it < NB * BH * hg::NSEG; it += G) hgrn_seg_b(lds, it / (BH * hg::NSEG), (it / hg::NSEG) % BH, it % hg::NSEG, QI, KI, VB, OG, E1, E2, a.g_hgrn);
        {
            unsigned* ctl = (unsigned*)(a.ws + WS_CTL);
            unsigned* gcnt = ctl + 4096;
            bf16_t* PO = (bf16_t*)(a.ws + mb::WS_PO); float* PL = (float*)(a.ws + mb::WS_PL); unsigned short* GL = (unsigned short*)(a.ws + mb::WS_LIST);
            const int nmb = G, mbi = bx;
#define MB_QUEUE(total, ...) do { for (int r_ = 0;; ++r_) { const int k = r_ * nmb + ((r_ & 1) ? nmb - 1 - mbi : mbi); if (r_ * nmb >= (total)) break; if (k < (total)) { __VA_ARGS__ } } } while (0)
            if (bx < 32) { __syncthreads(); pg8::Gemm g{pg8::a_rowmajor(MEMN, D), WKV, NB * NMEM, 2 * D, D}; pg8::StaticOrder S; S.init(NB * NMEM, 2 * D, 32, bx);
                EpiKV E{KX, VX};
                pg8::gemm_phase<EpiKV, true>(lds, g, S, E); }
            { const int n1 = G - 32, head = 3 * n1;
              if (bx >= 32) for (int r_ = 0; r_ < 3; ++r_) { const int k = r_ * n1 + ((r_ & 1) ? n1 - 1 - (bx - 32) : bx - 32);
                  moba_gate_item(lds, k & 63, k & 63, 31 - (k >> 6), QP, kmean, gcnt, GL); }
              for (int r_ = 0; head + r_ * G < 64 * 31; ++r_) { const int k = head + r_ * G + ((r_ & 1) ? G - 1 - bx : bx);
                  if (k < 64 * 31) moba_gate_item(lds, k & 63, k & 63, 31 - (k >> 6), QP, kmean, gcnt, GL); } }
            XBAR(121, G);
            LAS int* pfx = (LAS int*)(lds + LDS_BYTES - 12288);
            { __syncthreads();
              int v4[4], v = 0;
#pragma unroll
              for (int q4 = 0; q4 < 4; ++q4) { const int i = 4 * tid + q4; v4[q4] = (int)((gcnt[(i & 63) * 32 + (i >> 6)] + 511u) >> 9); v += v4[q4]; }
              const int mine = v;
#pragma unroll
              for (int o = 1; o < 64; o <<= 1) { const int t_ = __shfl_up(v, o); if (lane >= o) v += t_; }
              LAS int* wtot = pfx + 2048;
              if (lane == 63) wtot[wave] = v;
              __syncthreads();
              int add = v - mine;
#pragma unroll
              for (int w_ = 0; w_ < 8; ++w_) add += (w_ < wave) ? wtot[w_] : 0;
#pragma unroll
              for (int q4 = 0; q4 < 4; ++q4) { add += v4[q4]; pfx[4 * tid + q4] = add; }
              __syncthreads(); }
            const int nitems = pfx[2047];
            moba_part_phase(lds, pfx, nitems, mbi, nmb, QP, KP, VP, kamax, gcnt, GL, PO, PL);
            XBAR(122, G);
            MB_QUEUE(64 * 32, {
                const int bh = k & 63, qb = 31 - (k >> 6);
                moba_comb_item(lds, bh, bh, qb, QP, KP, VP, kamax, PO, PL); });
#undef MB_QUEUE
        }
    }
    SEAM(2);
    if (IN(3)) {
        pg8::Gemm g{pg8::a_rowmajor(XN, D), WG, T, 2 * D, D}; pg8::PairOrder S; S.base.init(T, D, G, bx);
        EpiGate E{RAT, SGB};
        pg8::gemm_phase<EpiGate, true, pg8::PairOrder>(lds, g, S, E);
        asm volatile("s_waitcnt vmcnt(0)" ::: "memory"); __syncthreads();
    }
    if (IN(4)) {
        {
        pg8::AView av; av.b0 = (const char*)QP; av.b1 = (const char*)QI - 16 * MiB; av.tsplit = 16; av.bstride = 16 * MiB; av.tstride = 256 * 64 * 2; av.kstride = 1 * MiB; av.lda = 64;
        pg8::Gemm g{av, WBR, T, D, 2 * D}; pg8::StaticOrder S; S.init(T, D, G, bx);
        EpiMerged E{RAT, SGB, MG};
        pg8::gemm_phase<EpiMerged, true>(lds, g, S, E);
            }
#if (DUP_MASK >> 4) & 1
        {
        pg8::AView av; av.b0 = (const char*)QP; av.b1 = (const char*)QI - 16 * MiB; av.tsplit = 16; av.bstride = 16 * MiB; av.tstride = 256 * 64 * 2; av.kstride = 1 * MiB; av.lda = 64;
        pg8::Gemm g{av, WBR, T, D, 2 * D}; pg8::StaticOrder S; S.init(T, D, G, bx);
        EpiMerged E{RAT, SGB, MG};
        pg8::gemm_phase<EpiMerged, true>(lds, g, S, E);
            }
#endif
    }
    SEAM(4);
    if (IN(5)) {
        pg8::Gemm g{pg8::a_rowmajor(MG, D), WOUT, T, D, D}; pg8::StaticOrder S; S.init(T, D, G, bx);
        EpiRes<false> E{a.x, HB, ssq1};
        pg8::gemm_phase<EpiRes<false>, true>(lds, g, S, E);
    }
    SEAM(5);
    if (IN(6)) {
        {
        pg8::Gemm g{pg8::a_rowmajor(HB, D), WQ, T, D, D}; pg8::StaticOrder S; S.init(T, D, G, bx);
        EpiScaleRow E{ssq1, QX, XSCALE};
        pg8::gemm_phase<EpiScaleRow, true>(lds, g, S, E);
#if STAGE_XATTN
        asm volatile("s_waitcnt vmcnt(0)" ::: "memory"); __syncthreads();
        { pg8::Unit u; for (int i = 0; S.next(i, u); ++i) { xattn_item(lds, u.pm >> 5, u.pn, 2 * (u.pm & 31), QX, KX, VX, OX); xattn_item(lds, u.pm >> 5, u.pn, 2 * (u.pm & 31) + 1, QX, KX, VX, OX); } }
#endif
            }
#if (DUP_MASK >> 6) & 1
        {
        pg8::Gemm g{pg8::a_rowmajor(HB, D), WQ, T, D, D}; pg8::StaticOrder S; S.init(T, D, G, bx);
        EpiScaleRow E{ssq1, QX, XSCALE};
        pg8::gemm_phase<EpiScaleRow, true>(lds, g, S, E);
#if STAGE_XATTN
        asm volatile("s_waitcnt vmcnt(0)" ::: "memory"); __syncthreads();
        { pg8::Unit u; for (int i = 0; S.next(i, u); ++i) { xattn_item(lds, u.pm >> 5, u.pn, 2 * (u.pm & 31), QX, KX, VX, OX); xattn_item(lds, u.pm >> 5, u.pn, 2 * (u.pm & 31) + 1, QX, KX, VX, OX); } }
#endif
            }
#endif
    }
#if !STAGE_XATTN
    SEAM(6);
#endif
    if (IN(7)) {
#if STAGE_XATTN
#else
        LAS float* qsh = (LAS float*)(lds + wave * 2048); LAS float* psh = qsh + 256;
        for (int it = gw; it < T * XH; it += NGW) {
            const int tok = it >> 2, hx = it & 3, b = tok >> 13;
            { const u32x2 w = *(const u32x2*)(QX + (size_t)tok * D + hx * 256 + 4 * lane); qsh[4 * lane] = bflo(w.x); qsh[4 * lane + 1] = bfhi(w.x); qsh[4 * lane + 2] = bflo(w.y); qsh[4 * lane + 3] = bfhi(w.y); }
            asm volatile("s_waitcnt lgkmcnt(0)" ::: "memory");
            const bf16_t* kb = KX + (size_t)(b * 4 + hx) * 256 * 256; const bf16_t* vb = VX + (size_t)(b * 4 + hx) * 256 * 256;
            float sc[4]; float mx = -INFINITY;
#pragma unroll
            for (int i = 0; i < 4; ++i) { const u32x4* kr = (const u32x4*)(kb + (size_t)(lane + 64 * i) * 256); float s_ = 0.f;
#pragma unroll 2
                for (int c = 0; c < 32; ++c) { const u32x4 w = kr[c]; f32x4 x0, x1; unpack8(w, x0, x1);
#pragma unroll
                    for (int e = 0; e < 4; ++e) s_ += x0[e] * qsh[8 * c + e] + x1[e] * qsh[8 * c + 4 + e]; }
                sc[i] = s_; mx = fmaxf(mx, s_); }
            mx = wave_max(mx); float lsum = 0.f;
#pragma unroll
            for (int i = 0; i < 4; ++i) { const float p = exp2f(sc[i] - mx); psh[lane + 64 * i] = p; lsum += p; }
            lsum = wave_sum(lsum);
            asm volatile("s_waitcnt lgkmcnt(0)" ::: "memory");
            f32x4 ov = {0.f, 0.f, 0.f, 0.f};
#pragma unroll 4
            for (int m = 0; m < 256; ++m) { const u32x2 w = *(const u32x2*)(vb + (size_t)m * 256 + 4 * lane); const float p = psh[m]; ov[0] += p * bflo(w.x); ov[1] += p * bfhi(w.x); ov[2] += p * bflo(w.y); ov[3] += p * bfhi(w.y); }
            const float rl = 1.0f / lsum; u32x2 w; w.x = cvt_pk_bf16(ov[0] * rl, ov[1] * rl); w.y = cvt_pk_bf16(ov[2] * rl, ov[3] * rl);
            *(u32x2*)(OX + (size_t)tok * D + hx * 256 + 4 * lane) = w;
        }
#endif
    }
    SEAM(7);
    if (IN(8)) {
        pg8::Gemm g{pg8::a_rowmajor(OX, D), WO, T, D, D}; pg8::StaticOrder S; S.init(T, D, G, bx);
        EpiRes<true> E{HB, HB, ssq2};
        pg8::gemm_phase<EpiRes<true>, true>(lds, g, S, E);
    }
    SEAM(8);
    if (IN(9)) {
        pg8::Gemm g{pg8::a_rowmajor(HB, D), WFI, T, 2 * FFN, D}; pg8::StaticOrder S; S.init(T, 2 * FFN, G, bx);
        EpiSwiglu E{ssq2, ACT};
        pg8::gemm_phase<EpiSwiglu, true>(lds, g, S, E);
    }
    SEAM(9);
    if (IN(10)) {
        pg8::Gemm g{pg8::a_rowmajor(ACT, FFN), WFO, T, D, FFN}; pg8::StaticOrder S; S.init(T, D, G, bx);
        EpiRes<true> E{HB, HB, ssq3};
        pg8::gemm_phase<EpiRes<true>, true>(lds, g, S, E);
    }
    SEAM(10);
    if (IN(11)) {
        for (int m = gw; m < T; m += NGW) {
            const float rstd = rsqrtf(ssq3[m] * (1.0f / D) + EPS); const u32x2* hrow = (const u32x2*)(HB + (size_t)m * D); f32x4* row = (f32x4*)(a.out + (size_t)m * D);
#pragma unroll
            for (int j = 0; j < 4; ++j) { const f32x4 gg = ((const f32x4*)a.g_fin)[lane + 64 * j]; const u32x2 w = hrow[lane + 64 * j];
                row[lane + 64 * j] = (f32x4){bflo(w.x), bfhi(w.x), bflo(w.y), bfhi(w.y)} * rstd * gg; }
        }
    }
#undef IN
#undef SEAM
}
#undef kmean
#undef kamax
#undef ssq1
#undef ssq2
#undef ssq3
#undef WZ
#undef WG
#undef WBR
#undef WOUT
#undef WQ
#undef WKV
#undef WO
#undef WFI
#undef WFO
#undef RC
#undef RS
#undef MEMN
#undef KX
#undef VX
#undef E1
#undef E2
#undef XN
#undef HB
#undef QP
#undef QX
#undef QI
#undef OX
#undef KI
#undef RAT
#undef VB
#undef SGB
#undef OG
#undef MG
#undef ACT
#undef KP
#undef VP
#undef H

constexpr int N_PHASES = 12;
extern "C" void kernel_launch(void* const* d_in, const int* in_sizes, int n_in, void* d_out, int out_size, void* d_ws, size_t ws_size, hipStream_t stream) {
    static int grid = 0;
    if (grid == 0) {
        if (n_in != 19 || in_sizes[0] != T * D || out_size != T * D || ws_size < WS_END) { fprintf(stderr, "kernel_launch: unexpected shapes (n_in %d, in0 %d, out %d, ws %zu)\n", n_in, n_in > 0 ? in_sizes[0] : -1, out_size, ws_size); grid = -1; return; }
        int dev = 0, cus = 0, per_cu = 0;
        hipGetDevice(&dev); hipDeviceGetAttribute(&cus, hipDeviceAttributeMultiprocessorCount, dev);
        hipFuncSetAttribute((const void*)mega_fwd, hipFuncAttributeMaxDynamicSharedMemorySize, LDS_BYTES);
        if (hipOccupancyMaxActiveBlocksPerMultiprocessor(&per_cu, (const void*)mega_fwd, 512, LDS_BYTES) != hipSuccess || per_cu < 1) { fprintf(stderr, "kernel_launch: occupancy query says %d blocks/CU\n", per_cu); per_cu = 1; }
        (void)hipGetLastError();
        grid = cus;
    }
    if (grid < 0) return;
    hipMemsetAsync((char*)d_ws + WS_CTL, 0, CTL_ZERO_BYTES, stream);
    Args a{};
    a.x = (const float*)d_in[0]; a.mem = (const float*)d_in[1]; a.pos = (const int*)d_in[2]; a.g_mix = (const float*)d_in[3]; a.w_in = (const float*)d_in[4]; a.lbl = (const float*)d_in[5];
    a.g_hgrn = (const float*)d_in[6]; a.w_bra = (const float*)d_in[7]; a.w_brh = (const float*)d_in[8]; a.w_out = (const float*)d_in[9]; a.g_x = (const float*)d_in[10]; a.g_mem = (const float*)d_in[11];
    a.wq = (const float*)d_in[12]; a.wkv = (const float*)d_in[13]; a.wo = (const float*)d_in[14]; a.g_ffn = (const float*)d_in[15]; a.w_ffi = (const float*)d_in[16]; a.w_ffo = (const float*)d_in[17]; a.g_fin = (const float*)d_in[18];
    a.out = (float*)d_out; a.ws = (unsigned char*)d_ws;
#if MK_N_LAUNCHES == 1
    a.ph_lo = 0; a.ph_hi = N_PHASES;
    void* args[] = {&a};
    hipError_t e = hipLaunchCooperativeKernel((const void*)mega_fwd, dim3(grid), dim3(512), args, LDS_BYTES, stream);
    if (e != hipSuccess) fprintf(stderr, "cooperative launch failed: %s (grid %d)\n", hipGetErrorString(e), grid);
#else
    for (int p = 0; p < N_PHASES; ++p) { a.ph_lo = p; a.ph_hi = p + 1; hipLaunchKernelGGL(mega_fwd, dim3(grid), dim3(512), LDS_BYTES, stream, a); }
#endif
}
```

```cpp
#include <hip/hip_runtime.h>
#include <hip/hip_cooperative_groups.h>
#include <cstdio>
#include <cstdint>
namespace cg = cooperative_groups;

#ifndef MK_N_LAUNCHES
#define MK_N_LAUNCHES 1
#endif

#ifndef STAGE_HGRN
#define STAGE_HGRN 1
#endif
#ifndef STAGE_MOBA
#define STAGE_MOBA 1
#endif
#ifndef STAGE_XATTN
#define STAGE_XATTN 1
#endif
#define LAS __attribute__((address_space(3)))
typedef unsigned short bf16_t;
typedef short bf16x8 __attribute__((ext_vector_type(8)));
typedef float f32x4 __attribute__((ext_vector_type(4)));
typedef float f32x2 __attribute__((ext_vector_type(2)));
typedef unsigned u32x4 __attribute__((ext_vector_type(4)));
typedef unsigned u32x2 __attribute__((ext_vector_type(2)));

constexpr int NB = 4, SEQ = 8192, T = NB * SEQ, D = 1024;
constexpr int AH = 16, AHD = 64, NBLK = 32;
constexpr int BH = 8, BDK = 128, BDV = 128, NCH = SEQ / 64;
constexpr int XH = 4, XHD = 256, NMEM = 256;
constexpr int FFN = 2816;
constexpr int ZN = 7168;
constexpr float EPS = 1e-6f;
constexpr float LOG2E = 1.4426950408889634f;
constexpr float QSCALE = 0.125f * LOG2E;
constexpr float XSCALE = 0.0625f * LOG2E;
constexpr float DKS = 0.08838834764831845f;

constexpr size_t MiB = 1u << 20;
constexpr size_t WS_CTL = 0, CTL_ZERO_BYTES = 2 * MiB;
constexpr size_t CTL_KMEAN = 64 * 1024;
constexpr size_t CTL_KAMAX = CTL_KMEAN + 512 * 1024;
constexpr size_t CTL_SSQ1 = 1 * MiB, CTL_SSQ2 = CTL_SSQ1 + 128 * 1024, CTL_SSQ3 = CTL_SSQ2 + 128 * 1024;
constexpr size_t WS_WZ = 4 * MiB, WS_WG = 18 * MiB, WS_WBR = 22 * MiB, WS_WOUT = 26 * MiB, WS_WQ = 28 * MiB, WS_WKV = 30 * MiB, WS_WO = 34 * MiB, WS_WFI = 36 * MiB, WS_WFO = 47 * MiB;
constexpr size_t WS_RC = 53 * MiB, WS_RS = 57 * MiB, WS_MEMN = 61 * MiB, WS_KX = 63 * MiB, WS_VX = 65 * MiB, WS_E1 = 67 * MiB, WS_E2 = 69 * MiB;
constexpr size_t WS_XN = 72 * MiB;
constexpr size_t WS_Q = 136 * MiB;
constexpr size_t WS_QI = 200 * MiB;
constexpr size_t WS_KI = 264 * MiB;
constexpr size_t WS_VB = 328 * MiB;
constexpr size_t WS_OG = 392 * MiB;
constexpr size_t WS_ACT = 264 * MiB;
constexpr size_t WS_END = 512 * MiB;

typedef __bf16 bf16x2_t __attribute__((ext_vector_type(2)));
__device__ __forceinline__ unsigned cvt_pk_bf16(float lo, float hi) { const f32x2 v = {lo, hi}; const bf16x2_t b = __builtin_convertvector(v, bf16x2_t); return __builtin_bit_cast(unsigned, b); }
__device__ __forceinline__ float bf2f(bf16_t h) { return __uint_as_float(((unsigned)h) << 16); }
__device__ __forceinline__ float bflo(unsigned w) { return __uint_as_float(w << 16); }
__device__ __forceinline__ float bfhi(unsigned w) { return __uint_as_float(w & 0xffff0000u); }
__device__ __forceinline__ bf16_t f2bf(float f) { return (bf16_t)(cvt_pk_bf16(f, 0.f) & 0xffffu); }
__device__ __forceinline__ float sigmoidf_(float x) { return __builtin_amdgcn_rcpf(1.0f + __expf(-x)); }
__device__ __forceinline__ float wave_sum(float v) {
#pragma unroll
    for (int o = 1; o < 64; o <<= 1) v += __shfl_xor(v, o);
    return v;
}
__device__ __forceinline__ float wave_max(float v) {
#pragma unroll
    for (int o = 1; o < 64; o <<= 1) v = fmaxf(v, __shfl_xor(v, o));
    return v;
}
__device__ __forceinline__ u32x4 pack8(const f32x4& a, const f32x4& b) { u32x4 w; w.x = cvt_pk_bf16(a[0], a[1]); w.y = cvt_pk_bf16(a[2], a[3]); w.z = cvt_pk_bf16(b[0], b[1]); w.w = cvt_pk_bf16(b[2], b[3]); return w; }
__device__ __forceinline__ void unpack8(const u32x4& w, f32x4& a, f32x4& b) { a = (f32x4){bflo(w.x), bfhi(w.x), bflo(w.y), bfhi(w.y)}; b = (f32x4){bflo(w.z), bfhi(w.z), bflo(w.w), bfhi(w.w)}; }

namespace pg8 {
constexpr int BM = 256, BK = 64, HALF = 128, HTB = HALF * BK * 2, STAGE_BYTES = 8 * HTB, NXCD = 8, WGM = 8;
__host__ __device__ __forceinline__ int lds_byte(int r, int c) { const int st = (r >> 4) * 2 + (c >> 5), rr = r & 15, cc = c & 31, ob = rr * 64 + cc * 2; return st * 1024 + (ob ^ (((ob >> 9) & 1) << 5)); }
__host__ __device__ __forceinline__ void stage_rc(int b, int& R, int& C) { const int st = b / 1024, sb = b % 1024, swz = sb ^ (((sb >> 9) & 1) << 5); R = (st >> 1) * 16 + swz / 64; C = (st & 1) * 32 + (swz % 64) / 2; }
struct Unit { int pm, pn; };
struct AView {
    const char* b0; const char* b1; int tsplit; long bstride, tstride, kstride; int lda;
    __device__ __forceinline__ const char* ptr(int pm, int t) const { return (t < tsplit ? b0 : b1) + (long)(pm >> 5) * bstride + (long)(pm & 31) * tstride + (long)t * kstride; }
};
__device__ __forceinline__ AView a_rowmajor(const void* A, int lda) { AView v; v.b0 = (const char*)A; v.b1 = (const char*)A; v.tsplit = 1 << 30; v.tstride = (long)256 * lda * 2; v.bstride = 32 * v.tstride; v.kstride = 128; v.lda = lda; return v; }
struct Gemm { AView A; const bf16_t* Bt; int M, N, K; };
struct StaticOrder {
    int nM, nN, nwg, G, c;
    __device__ void init(int M, int N, int G_, int c_) { nM = M / BM; nN = N / BM; nwg = nM * nN; G = G_; c = c_; }
    __device__ bool next(int i, Unit& u) const {
        const long L = (long)i * G + c; if (L >= nwg) return false;
        int wgid = (int)L; { const int q = nwg / NXCD, r = nwg % NXCD, xcd = wgid % NXCD, off = wgid / NXCD; wgid = (xcd < r ? xcd * (q + 1) : r * (q + 1) + (xcd - r) * q) + off; }
        const int nig = WGM * nN, gid = wgid / nig, fm = gid * WGM, gsz = (nM - fm) < WGM ? (nM - fm) : WGM;
        u.pm = fm + ((wgid % nig) % gsz); u.pn = (wgid % nig) / gsz; return true;
    }
};
struct PairOrder { StaticOrder base;
    __device__ bool next(int i, Unit& u) const { Unit v; if (!base.next(i >> 1, v)) return false; u.pm = v.pm; u.pn = 2 * v.pn + (i & 1); return true; } };
template <class Epi, bool ALIGN_EPI, class Sched = StaticOrder>
__device__ __forceinline__ void gemm_phase(LAS unsigned char* lds, const Gemm g, const Sched& S, const Epi& E) {
    const int tid = threadIdx.x, wid = __builtin_amdgcn_readfirstlane(tid >> 6), lane = tid & 63, wr = wid >> 2, wc = wid & 3, fr = lane & 15, fq = lane >> 4;
    const int K = g.K, nt = K / BK;
    unsigned voffA[2], voffB[2];
#pragma unroll
    for (int i = 0; i < 2; ++i) { int R, C; stage_rc(tid * 16 + i * 8192, R, C); voffA[i] = (unsigned)(R * g.A.lda + C) * 2u; voffB[i] = (unsigned)(R * K + C) * 2u; }
    const size_t hstepA = (size_t)HALF * g.A.lda * 2, hstepB = (size_t)HALF * K * 2, tstepB = 2 * hstepB, kstep = 128;
    const unsigned ldsw = (unsigned)wid * 1024u;
    const int aoff = lds_byte(wr * 64 + fr, fq * 8), boff = lds_byte(wc * 32 + fr, fq * 8);
#define PG8_SA(b, h) (((b) * 2 + (h)) * HTB)
#define PG8_SB(b, h) ((4 + (b) * 2 + (h)) * HTB)
#define PG8_STAGE(bufoff, gbase, voff) do { _Pragma("unroll") for (int _i = 0; _i < 2; ++_i) \
        __builtin_amdgcn_global_load_lds((const unsigned*)((const char*)(gbase) + (voff)[_i]), (LAS unsigned*)(lds + (bufoff) + ldsw + _i * 8192), 16, 0, 0); } while (0)
#define PG8_LDA(dst, b, h) do { _Pragma("unroll") for (int m = 0; m < 4; ++m) _Pragma("unroll") for (int k = 0; k < 2; ++k) dst[m][k] = *(const LAS bf16x8*)(lds + PG8_SA(b, h) + aoff + m * 2048 + k * 1024); } while (0)
#define PG8_LDB(dst, b, h) do { _Pragma("unroll") for (int n = 0; n < 2; ++n) _Pragma("unroll") for (int k = 0; k < 2; ++k) dst[n][k] = *(const LAS bf16x8*)(lds + PG8_SB(b, h) + boff + n * 2048 + k * 1024); } while (0)
#define PG8_MMA(ai, bj, At, Bt) do { __builtin_amdgcn_s_setprio(1); _Pragma("unroll") for (int m = 0; m < 4; ++m) _Pragma("unroll") for (int n = 0; n < 2; ++n) _Pragma("unroll") for (int k = 0; k < 2; ++k) \
        acc[ai][bj][m][n] = __builtin_amdgcn_mfma_f32_16x16x32_bf16(Bt[n][k], At[m][k], acc[ai][bj][m][n], 0, 0, 0); __builtin_amdgcn_s_setprio(0); } while (0)
#define PG8_WAIT_V(n) asm volatile("s_waitcnt vmcnt(" #n ")" ::: "memory")
#define PG8_WAIT_L(n) asm volatile("s_waitcnt lgkmcnt(" #n ")" ::: "memory")
#define PG8_BAR __builtin_amdgcn_s_barrier()
#define PG8_SCHED __builtin_amdgcn_sched_barrier(0)
    Unit cur, nxt; int ui = 0;
    if (!S.next(0, cur)) return;
    f32x4 acc[2][2][4][2];
#pragma unroll
    for (int a = 0; a < 2; ++a)
#pragma unroll
        for (int b = 0; b < 2; ++b)
#pragma unroll
            for (int m = 0; m < 4; ++m)
#pragma unroll
                for (int n = 0; n < 2; ++n) acc[a][b][m][n] = (f32x4){0.f, 0.f, 0.f, 0.f};
    bf16x8 At[4][2], B0[2][2], B1[2][2];
    const char* cB = (const char*)g.Bt + (size_t)cur.pn * tstepB;
    {
        const char* cA = g.A.ptr(cur.pm, 0); const char* cA1 = g.A.ptr(cur.pm, 1);
        PG8_STAGE(PG8_SB(0, 0), cB, voffB); PG8_STAGE(PG8_SB(0, 1), cB + hstepB, voffB); PG8_STAGE(PG8_SA(0, 0), cA, voffA); PG8_STAGE(PG8_SA(0, 1), cA + hstepA, voffA);
        if (wr == 1) PG8_BAR;
        PG8_WAIT_V(2); PG8_BAR;
        PG8_STAGE(PG8_SB(1, 0), cB + kstep, voffB); PG8_STAGE(PG8_SA(1, 0), cA1, voffA); PG8_STAGE(PG8_SB(1, 1), cB + hstepB + kstep, voffB);
        PG8_WAIT_V(6); PG8_BAR;
    }
    for (;;) {
        const bool has_next = S.next(ui + 1, nxt);
        const int npm = has_next ? nxt.pm : cur.pm;
        const char* nB = has_next ? (const char*)g.Bt + (size_t)nxt.pn * tstepB : cB;
        for (int t = 0; t < nt; t += 2) {
            const bool last = (t == nt - 2);
            if constexpr (Epi::MID) { if (t == (nt >> 1)) E.mid(acc, cur, wr, wc, fr, fq); }
            const char* a1 = g.A.ptr(cur.pm, t + 1);
            const char* a2 = last ? g.A.ptr(npm, 0) : g.A.ptr(cur.pm, t + 2);
            const char* a3 = last ? g.A.ptr(npm, 1) : g.A.ptr(cur.pm, t + 3);
            const char* b2 = last ? nB : cB + (size_t)(t + 2) * kstep;
            const char* b3 = b2 + kstep;
            PG8_LDB(B0, 0, 0); PG8_LDB(B1, 0, 1); PG8_SCHED; PG8_LDA(At, 0, 0); PG8_STAGE(PG8_SA(1, 1), a1 + hstepA, voffA);
            PG8_WAIT_V(8); PG8_WAIT_L(0); PG8_BAR; PG8_MMA(0, 0, At, B0); PG8_MMA(0, 1, At, B1); PG8_BAR; PG8_SCHED;
            PG8_LDA(At, 0, 1); PG8_STAGE(PG8_SB(0, 0), b2, voffB); PG8_STAGE(PG8_SB(0, 1), b2 + hstepB, voffB); PG8_STAGE(PG8_SA(0, 0), a2, voffA);
            PG8_WAIT_V(8); PG8_WAIT_L(0); PG8_BAR; PG8_MMA(1, 0, At, B0); PG8_MMA(1, 1, At, B1); PG8_BAR; PG8_SCHED;
            PG8_LDB(B0, 1, 0); PG8_LDB(B1, 1, 1); PG8_SCHED; PG8_LDA(At, 1, 0); PG8_STAGE(PG8_SA(0, 1), a2 + hstepA, voffA);
            PG8_WAIT_V(8); PG8_WAIT_L(0); PG8_BAR; PG8_MMA(0, 0, At, B0); PG8_MMA(0, 1, At, B1); PG8_BAR; PG8_SCHED;
            PG8_LDA(At, 1, 1); PG8_STAGE(PG8_SB(1, 0), b3, voffB); PG8_STAGE(PG8_SB(1, 1), b3 + hstepB, voffB); PG8_STAGE(PG8_SA(1, 0), a3, voffA);
            PG8_WAIT_V(8); PG8_WAIT_L(0); PG8_BAR; PG8_MMA(1, 0, At, B0); PG8_MMA(1, 1, At, B1); PG8_BAR; PG8_SCHED;
        }
        if constexpr (ALIGN_EPI) { if (wr == 0) PG8_BAR; }
        E(acc, cur, wr, wc, fr, fq);
        if (!has_next) break;
#pragma unroll
        for (int a = 0; a < 2; ++a)
#pragma unroll
            for (int b = 0; b < 2; ++b)
#pragma unroll
                for (int m = 0; m < 4; ++m)
#pragma unroll
                    for (int n = 0; n < 2; ++n) acc[a][b][m][n] = (f32x4){0.f, 0.f, 0.f, 0.f};
        cur = nxt; cB = nB; ++ui;
        if constexpr (ALIGN_EPI) { if (wr == 1) PG8_BAR; }
    }
    PG8_WAIT_V(0);
    if constexpr (!ALIGN_EPI) { if (wr == 0) PG8_BAR; }
    PG8_BAR;
#undef PG8_SA
#undef PG8_SB
#undef PG8_STAGE
#undef PG8_LDA
#undef PG8_LDB
#undef PG8_MMA
#undef PG8_WAIT_V
#undef PG8_WAIT_L
#undef PG8_BAR
#undef PG8_SCHED
}
}
typedef f32x4 Acc[2][2][4][2];

__host__ __device__ __forceinline__ int perm8(int p) { return (p & ~31) | (((p >> 2) & 3) << 3) | (((p >> 4) & 1) << 2) | (p & 3); }

struct EpiZ {
    static constexpr bool MID = false;
    bf16_t *Q, *Kp, *Vp, *QI, *KI, *VB, *OG; float *E1, *E2; const float *rc, *rs; float* kmean; unsigned* kamax; const float* lbl;
    __device__ __forceinline__ void mid(Acc&, const pg8::Unit&, int, int, int, int) const {}
    template <bool ISK> __device__ __forceinline__ void rope_sec(bf16_t* dst, const Acc& acc, const pg8::Unit& u, int wr, int wc, int fr, int fq) const {
        const int pn = u.pn, b = u.pm >> 5, s0 = (u.pm & 31) * 256;
        const int dlo = 16 * (wc & 1) + 4 * fq;
#pragma unroll
        for (int bj = 0; bj < 2; ++bj) {
            const int plane = b * 16 + 4 * (pn & 3) + 2 * bj + (wc >> 1);
            f32x4 slo = {0.f, 0.f, 0.f, 0.f}, shi = {0.f, 0.f, 0.f, 0.f}; float amax = 0.f;
#pragma unroll
            for (int ai = 0; ai < 2; ++ai)
#pragma unroll
                for (int m = 0; m < 4; ++m) {
                    const int s = s0 + 128 * ai + 64 * wr + 16 * m + fr; const size_t tok = (size_t)b * SEQ + s;
                    const f32x4 c4 = *(const f32x4*)(rc + tok * 32 + dlo), s4 = *(const f32x4*)(rs + tok * 32 + dlo);
                    const f32x4 lo = acc[ai][bj][m][0], hi = acc[ai][bj][m][1];
                    f32x4 olo = lo * c4 - hi * s4, ohi = hi * c4 + lo * s4;
                    if (!ISK) { olo = olo * QSCALE; ohi = ohi * QSCALE; }
                    else { slo += olo; shi += ohi;
#pragma unroll
                        for (int j = 0; j < 4; ++j) amax = fmaxf(amax, fmaxf(fabsf(olo[j]), fabsf(ohi[j]))); }
                    bf16_t* p = dst + ((size_t)plane * SEQ + s) * 64 + dlo;
                    u32x2 w0, w1; w0.x = cvt_pk_bf16(olo[0], olo[1]); w0.y = cvt_pk_bf16(olo[2], olo[3]); w1.x = cvt_pk_bf16(ohi[0], ohi[1]); w1.y = cvt_pk_bf16(ohi[2], ohi[3]);
                    *(u32x2*)p = w0; *(u32x2*)(p + 32) = w1;
                }
            if (ISK) {
#pragma unroll
                for (int j = 0; j < 4; ++j) {
#pragma unroll
                    for (int o = 1; o < 16; o <<= 1) { slo[j] += __shfl_xor(slo[j], o); shi[j] += __shfl_xor(shi[j], o); } }
                amax = wave_max(amax);
                if (fr == 0) { float* km = kmean + ((size_t)plane * NBLK + (u.pm & 31)) * 64 + dlo;
#pragma unroll
                    for (int j = 0; j < 4; ++j) { atomicAdd(km + j, slo[j]); atomicAdd(km + 32 + j, shi[j]); } }
                if ((threadIdx.x & 63) == 0) atomicMax(kamax + plane, __float_as_uint(amax));
            }
        }
    }
    template <bool ACT> __device__ __forceinline__ void plane_sec(bf16_t* dst, int pbase, const Acc& acc, const pg8::Unit& u, int wr, int wc, int fr, int fq) const {
        const int b = u.pm >> 5, s0 = (u.pm & 31) * 256, dc0 = 32 * (wc & 1) + 8 * fq;
#pragma unroll
        for (int bj = 0; bj < 2; ++bj) {
            const int plane = b * 16 + pbase + 2 * bj + (wc >> 1);
#pragma unroll
            for (int ai = 0; ai < 2; ++ai)
#pragma unroll
                for (int m = 0; m < 4; ++m) {
                    const int s = s0 + 128 * ai + 64 * wr + 16 * m + fr;
                    f32x4 v0 = acc[ai][bj][m][0], v1 = acc[ai][bj][m][1];
                    if (ACT) {
#pragma unroll
                        for (int j = 0; j < 4; ++j) { v0[j] = v0[j] * sigmoidf_(v0[j]); v1[j] = v1[j] * sigmoidf_(v1[j]); } }
                    *(u32x4*)(dst + ((size_t)plane * SEQ + s) * 64 + dc0) = pack8(v0, v1);
                }
        }
    }
    __device__ __forceinline__ void qf_sec(const Acc& acc, const pg8::Unit& u, int wr, int wc, int fr, int fq) const {
        const int b = u.pm >> 5, s0 = (u.pm & 31) * 256;
        {
            const int h = u.pn, hp = b * 16 + 2 * h + (wc >> 1);
#pragma unroll
            for (int nn = 0; nn < 2; ++nn) {
                const int dc0 = 32 * (wc & 1) + 8 * fq + 4 * nn, lcol = h * 128 + 32 * wc + 8 * fq + 4 * nn;
                float lb[4];
#pragma unroll
                for (int i = 0; i < 4; ++i) { const float l0 = lbl[lcol + i], l1 = lbl[1024 + lcol + i]; lb[i] = 1.0f / (1.0f + __expf(l1 - l0)); }
#pragma unroll
                for (int ai = 0; ai < 2; ++ai) {
                    float bcs[4][4], kk[4][4];
#pragma unroll
                    for (int m = 0; m < 4; ++m)
#pragma unroll
                        for (int i = 0; i < 4; ++i) {
                            const float zf = acc[ai][1][m][nn][i];
                            const float e = __expf(-zf), sg = __builtin_amdgcn_rcpf(1.0f + e);
                            kk[m][i] = (1.0f - lb[i]) * (e * sg);
                            float v = __logf(lb[i] + (1.0f - lb[i]) * sg);
#pragma unroll
                            for (int o = 1; o < 16; o <<= 1) { const float t = __shfl_up(v, o, 16); if (fr >= o) v += t; }
                            bcs[m][i] = v;
                        }
                    float bmid[4], blast[4];
#pragma unroll
                    for (int i = 0; i < 4; ++i) {
                        float base = 0.f;
#pragma unroll
                        for (int m = 0; m < 4; ++m) { const float tot = __shfl(bcs[m][i], 15, 16); bcs[m][i] += base; base += tot; }
                        bmid[i] = __shfl(bcs[1][i], 15, 16); blast[i] = __shfl(bcs[3][i], 15, 16);
                    }
#pragma unroll
                    for (int m = 0; m < 4; ++m) {
                        const int s = s0 + 128 * ai + 64 * wr + 16 * m + fr;
                        f32x4 qv, kv;
#pragma unroll
                        for (int i = 0; i < 4; ++i) {
                            const float zq = acc[ai][0][m][nn][i];
                            const float ex = __expf(bcs[m][i] - bmid[i]);
                            qv[i] = zq * sigmoidf_(zq) * DKS * ex;
                            kv[i] = kk[m][i] * __builtin_amdgcn_rcpf(ex);
                        }
                        const size_t off = ((size_t)hp * SEQ + s) * 64 + dc0;
                        u32x2 wq_, wk_; wq_.x = cvt_pk_bf16(qv[0], qv[1]); wq_.y = cvt_pk_bf16(qv[2], qv[3]); wk_.x = cvt_pk_bf16(kv[0], kv[1]); wk_.y = cvt_pk_bf16(kv[2], kv[3]);
                        *(u32x2*)(QI + off) = wq_; *(u32x2*)(KI + off) = wk_;
                    }
                    if (fr == 15) {
                        const int chunk = (s0 + 128 * ai + 64 * wr) >> 6;
                        const size_t eo = (((size_t)(b * BH + h)) * NCH + chunk) * 128 + 32 * wc + 8 * fq + 4 * nn;
                        f32x4 a0, c0;
#pragma unroll
                        for (int i = 0; i < 4; ++i) { a0[i] = __expf(bmid[i]); c0[i] = __expf(blast[i] - bmid[i]); }
                        *(f32x4*)(E1 + eo) = a0; *(f32x4*)(E2 + eo) = c0;
                    }
                }
            }
        }
    }
};
template <bool ISK> struct EpiRope { static constexpr bool MID = false; EpiZ z;
    __device__ __forceinline__ void mid(Acc&, const pg8::Unit&, int, int, int, int) const {}
    __device__ __forceinline__ void operator()(const Acc& acc, const pg8::Unit& u, int wr, int wc, int fr, int fq) const { z.template rope_sec<ISK>(ISK ? z.Kp : z.Q, acc, u, wr, wc, fr, fq); } };
template <bool ACT> struct EpiPlane { static constexpr bool MID = false; EpiZ z; bf16_t* dst;
    __device__ __forceinline__ void mid(Acc&, const pg8::Unit&, int, int, int, int) const {}
    __device__ __forceinline__ void operator()(const Acc& acc, const pg8::Unit& u, int wr, int wc, int fr, int fq) const { z.template plane_sec<ACT>(dst, 4 * u.pn, acc, u, wr, wc, fr, fq); } };
struct EpiQF { static constexpr bool MID = false; EpiZ z;
    __device__ __forceinline__ void mid(Acc&, const pg8::Unit&, int, int, int, int) const {}
    __device__ __forceinline__ void operator()(const Acc& acc, const pg8::Unit& u, int wr, int wc, int fr, int fq) const { z.qf_sec(acc, u, wr, wc, fr, fq); } };
struct EpiKV {
    static constexpr bool MID = false;
    bf16_t *KX, *VX;
    __device__ __forceinline__ void mid(Acc&, const pg8::Unit&, int, int, int, int) const {}
    __device__ __forceinline__ void operator()(const Acc& acc, const pg8::Unit& u, int wr, int wc, int fr, int fq) const {
        bf16_t* dst = (u.pn < 4 ? KX : VX) + (size_t)(u.pm * 4 + (u.pn & 3)) * 256 * 256;
#pragma unroll
        for (int ai = 0; ai < 2; ++ai)
#pragma unroll
            for (int m = 0; m < 4; ++m) { const int r = 128 * ai + 64 * wr + 16 * m + fr;
#pragma unroll
                for (int bj = 0; bj < 2; ++bj) *(u32x4*)(dst + (size_t)r * 256 + 128 * bj + 32 * wc + 8 * fq) = pack8(acc[ai][bj][m][0], acc[ai][bj][m][1]); }
    }
};
struct EpiGate {
    static constexpr bool MID = false;
    bf16_t *RAT, *SGB;
    __device__ __forceinline__ void mid(Acc&, const pg8::Unit&, int, int, int, int) const {}
    __device__ __forceinline__ void operator()(const Acc& acc, const pg8::Unit& u, int wr, int wc, int fr, int fq) const {
        const int c0 = 128 * u.pn + 32 * wc + 8 * fq;
#pragma unroll
        for (int ai = 0; ai < 2; ++ai)
#pragma unroll
            for (int m = 0; m < 4; ++m) { const size_t r = (size_t)u.pm * 256 + 128 * ai + 64 * wr + 16 * m + fr;
                f32x4 ra[2], sb[2];
#pragma unroll
                for (int n = 0; n < 2; ++n)
#pragma unroll
                    for (int j = 0; j < 4; ++j) { const float ea = __expf(-acc[ai][0][m][n][j]), eb = __expf(-acc[ai][1][m][n][j]); sb[n][j] = __builtin_amdgcn_rcpf(1.0f + eb); ra[n][j] = (1.0f + eb) * __builtin_amdgcn_rcpf(1.0f + ea); }
                *(u32x4*)(RAT + r * D + c0) = pack8(ra[0], ra[1]); *(u32x4*)(SGB + r * D + c0) = pack8(sb[0], sb[1]); }
    }
};
struct EpiMerged {
    static constexpr bool MID = true;
    const bf16_t *RAT, *SGB; bf16_t* MG;
    __device__ __forceinline__ void mid(Acc& acc, const pg8::Unit& u, int wr, int wc, int fr, int fq) const {
        const int c0 = 256 * u.pn + 32 * wc + 8 * fq;
#pragma unroll
        for (int ai = 0; ai < 2; ++ai)
#pragma unroll
            for (int m = 0; m < 4; ++m) { const size_t r = (size_t)u.pm * 256 + 128 * ai + 64 * wr + 16 * m + fr;
#pragma unroll
                for (int bj = 0; bj < 2; ++bj) { const u32x4 wa = *(const u32x4*)(RAT + r * D + c0 + 128 * bj);
                    f32x4 a0, a1; unpack8(wa, a0, a1); acc[ai][bj][m][0] *= a0; acc[ai][bj][m][1] *= a1; }
                asm volatile("" ::: "memory"); }
    }
    __device__ __forceinline__ void operator()(const Acc& acc, const pg8::Unit& u, int wr, int wc, int fr, int fq) const {
        const int c0 = 256 * u.pn + 32 * wc + 8 * fq;
#pragma unroll
        for (int ai = 0; ai < 2; ++ai)
#pragma unroll
            for (int m = 0; m < 4; ++m) { const size_t r = (size_t)u.pm * 256 + 128 * ai + 64 * wr + 16 * m + fr;
#pragma unroll
                for (int bj = 0; bj < 2; ++bj) { const u32x4 wb = *(const u32x4*)(SGB + r * D + c0 + 128 * bj); f32x4 b0, b1; unpack8(wb, b0, b1);
                    *(u32x4*)(MG + r * D + c0 + 128 * bj) = pack8(acc[ai][bj][m][0] * b0, acc[ai][bj][m][1] * b1); } }
    }
};
template <bool RBF> struct EpiRes {
    static constexpr bool MID = false;
    const void* R; bf16_t* Hb; float* ssq;
    __device__ __forceinline__ void mid(Acc&, const pg8::Unit&, int, int, int, int) const {}
    __device__ __forceinline__ void operator()(const Acc& acc, const pg8::Unit& u, int wr, int wc, int fr, int fq) const {
        const int c0 = 256 * u.pn + 32 * wc + 4 * fq;
#pragma unroll
        for (int ai = 0; ai < 2; ++ai)
#pragma unroll
            for (int m = 0; m < 4; ++m) { const size_t r = (size_t)u.pm * 256 + 128 * ai + 64 * wr + 16 * m + fr; float ss = 0.f;
#pragma unroll
                for (int bj = 0; bj < 2; ++bj)
#pragma unroll
                    for (int n = 0; n < 2; ++n) { const size_t off = r * D + c0 + 128 * bj + 16 * n; f32x4 h = acc[ai][bj][m][n];
                        if (RBF) { const u32x2 w = *(const u32x2*)((const bf16_t*)R + off); h[0] += bflo(w.x); h[1] += bfhi(w.x); h[2] += bflo(w.y); h[3] += bfhi(w.y); }
                        else h += *(const f32x4*)((const float*)R + off);
                        ss += (h[0] * h[0] + h[1] * h[1]) + (h[2] * h[2] + h[3] * h[3]);
                        u32x2 w; w.x = cvt_pk_bf16(h[0], h[1]); w.y = cvt_pk_bf16(h[2], h[3]); *(u32x2*)(Hb + off) = w; }
                ss += __shfl_xor(ss, 16); ss += __shfl_xor(ss, 32);
                if (fq == 0) atomicAdd(ssq + r, ss); }
    }
};
struct EpiScaleRow {
    static constexpr bool MID = false;
    const float* ssq; bf16_t* O; float scale;
    __device__ __forceinline__ void mid(Acc&, const pg8::Unit&, int, int, int, int) const {}
    __device__ __forceinline__ void operator()(const Acc& acc, const pg8::Unit& u, int wr, int wc, int fr, int fq) const {
        const int c0 = 256 * u.pn + 32 * wc + 8 * fq;
#pragma unroll
        for (int ai = 0; ai < 2; ++ai)
#pragma unroll
            for (int m = 0; m < 4; ++m) { const size_t r = (size_t)u.pm * 256 + 128 * ai + 64 * wr + 16 * m + fr; const float rs = rsqrtf(ssq[r] * (1.0f / D) + EPS) * scale;
#pragma unroll
                for (int bj = 0; bj < 2; ++bj) *(u32x4*)(O + r * D + c0 + 128 * bj) = pack8(acc[ai][bj][m][0] * rs, acc[ai][bj][m][1] * rs); }
    }
};
struct EpiSwiglu {
    static constexpr bool MID = false;
    const float* ssq; bf16_t* ACT;
    __device__ __forceinline__ void mid(Acc&, const pg8::Unit&, int, int, int, int) const {}
    __device__ __forceinline__ void operator()(const Acc& acc, const pg8::Unit& u, int wr, int wc, int fr, int fq) const {
        const int c0 = 128 * u.pn + 32 * wc + 8 * fq;
#pragma unroll
        for (int ai = 0; ai < 2; ++ai)
#pragma unroll
            for (int m = 0; m < 4; ++m) { const size_t r = (size_t)u.pm * 256 + 128 * ai + 64 * wr + 16 * m + fr; const float rs = rsqrtf(ssq[r] * (1.0f / D) + EPS);
                f32x4 o[2];
#pragma unroll
                for (int n = 0; n < 2; ++n)
#pragma unroll
                    for (int j = 0; j < 4; ++j) { const float gv = acc[ai][0][m][n][j] * rs, uv = acc[ai][1][m][n][j] * rs; o[n][j] = gv * sigmoidf_(gv) * uv; }
                *(u32x4*)(ACT + r * FFN + c0) = pack8(o[0], o[1]); }
    }
};

typedef short s16x4 __attribute__((ext_vector_type(4)));
typedef short v4i16_t __attribute__((ext_vector_type(4)));
__device__ __forceinline__ s16x4 tr_read(const LAS unsigned char* p) { return __builtin_bit_cast(s16x4, __builtin_amdgcn_ds_read_tr16_b64_v4i16((LAS v4i16_t*)p)); }
__device__ __forceinline__ bf16x8 mk8(s16x4 lo, s16x4 hi) { return (bf16x8){lo[0], lo[1], lo[2], lo[3], hi[0], hi[1], hi[2], hi[3]}; }
__device__ __forceinline__ bf16x8 tr_frag(const LAS unsigned char* base, int pitch, int r0, int c0, int lane) {
    const int g = lane >> 4, i = lane & 15; const LAS unsigned char* p = base + (r0 + 8 * g + (i >> 2)) * pitch + (c0 + 4 * (i & 3)) * 2;
    return mk8(tr_read(p), tr_read(p + 4 * pitch));
}
__device__ __forceinline__ bf16x8 tr_frag_split(const LAS unsigned char* base, int pitch, int r0, int c0, int lane) {
    const int g = lane >> 4, i = lane & 15; const LAS unsigned char* p = base + (r0 + 4 * g + (i >> 2)) * pitch + (c0 + 4 * (i & 3)) * 2;
    return mk8(tr_read(p), tr_read(p + 16 * pitch));
}
__device__ __forceinline__ bf16x8 ld_frag(const LAS unsigned char* base, int pitch, int row, int col) { return *(const LAS bf16x8*)(base + row * pitch + col * 2); }
#define MFMA16(A, B, C) __builtin_amdgcn_mfma_f32_16x16x32_bf16((A), (B), (C), 0, 0, 0)
#define LDS_FADD(p, v) ((void)__hip_atomic_fetch_add((LAS float*)(p), (v), __ATOMIC_RELAXED, __HIP_MEMORY_SCOPE_WORKGROUP))

namespace hg {
constexpr int PITCH = 272;
constexpr int TILE = 64 * PITCH, HBUF = 3 * TILE;
constexpr int OFF_SP = 2 * HBUF, OFF_AM = OFF_SP + 128 * PITCH, AMP = 144, OFF_RSS = OFF_AM + 64 * AMP, OFF_E = OFF_RSS + 512, END = OFF_E + 2 * 1024;
static_assert(END <= 160 * 1024, "hgrn lds");
}
__device__ __forceinline__ void hgrn_item(LAS unsigned char* lds, int b, int h, const bf16_t* QIp, bf16_t* OUTp, size_t omask, const bf16_t* KIp, const bf16_t* VBp, const bf16_t* OGp, const float* E1p, const float* E2p, const float* gh) {
    using namespace hg;
    const int tid = threadIdx.x, lane = tid & 63, w = __builtin_amdgcn_readfirstlane(tid >> 6), c = lane & 15, g = lane >> 4;
    const size_t pl0 = ((size_t)(b * 16 + 2 * h)) * SEQ * 64, pl1 = pl0 + (size_t)SEQ * 64;
    const size_t eb = ((size_t)(b * BH + h)) * NCH * 128;
    const int tt = w >> 1, dvh = w & 1;
    f32x4 S[8];
#pragma unroll
    for (int j = 0; j < 8; ++j) S[j] = (f32x4){0.f, 0.f, 0.f, 0.f};
    f32x4 ghv[4];
#pragma unroll
    for (int jj = 0; jj < 4; ++jj) ghv[jj] = *(const f32x4*)(gh + h * 128 + 64 * dvh + 16 * jj + 4 * g);
    const size_t oplane = (dvh ? pl1 : pl0) + (size_t)(16 * tt + c) * 64 + 4 * g;
    u32x4 pq[2], pk[2], pv[2]; float pe = 0.f;
    auto issue = [&](int ch) {
#pragma unroll
        for (int k = 0; k < 2; ++k) { const int i = tid + 512 * k, row = i >> 4, pc = i & 15; const size_t src = (pc < 8 ? pl0 : pl1) + ((size_t)(64 * ch + row)) * 64 + (pc & 7) * 8;
            pq[k] = *(const u32x4*)(QIp + src); pk[k] = *(const u32x4*)(KIp + src); pv[k] = *(const u32x4*)(VBp + src); }
        if (tid < 256) pe = (tid < 128 ? E1p : E2p)[eb + (size_t)ch * 128 + (tid & 127)];
    };
    auto commit = [&](int p) {
        LAS unsigned char* bufp = lds + p * HBUF;
#pragma unroll
        for (int k = 0; k < 2; ++k) { const int i = tid + 512 * k, row = i >> 4, pc = i & 15; const int o = row * PITCH + pc * 16;
            *(LAS u32x4*)(bufp + o) = pq[k]; *(LAS u32x4*)(bufp + TILE + o) = pk[k]; *(LAS u32x4*)(bufp + 2 * TILE + o) = pv[k]; }
        if (tid < 256) ((LAS float*)(lds + OFF_E + p * 1024))[tid] = pe;
    };
    __syncthreads();
    issue(0); commit(0);
    __syncthreads();
    for (int ch = 0; ch < NCH; ++ch) {
        const int p = ch & 1;
        const LAS unsigned char* qb_ = lds + p * HBUF; const LAS unsigned char* kb_ = qb_ + TILE; const LAS unsigned char* vb_ = qb_ + 2 * TILE;
        const LAS float* e1s = (const LAS float*)(lds + OFF_E + p * 1024); const LAS float* e2s = e1s + 128;
        u32x2 ogv[4];
#pragma unroll
        for (int jj = 0; jj < 4; ++jj) ogv[jj] = *(const u32x2*)(OGp + oplane + (size_t)ch * 4096 + 16 * jj);
        issue(ch + 1 < NCH ? ch + 1 : ch);
#pragma unroll
        for (int s2 = 0; s2 < 2; ++s2) {
            const int si = 2 * (w & 1) + s2; f32x4 acc = {0.f, 0.f, 0.f, 0.f};
#pragma unroll
            for (int ks = 0; ks < 4; ++ks) acc = MFMA16(ld_frag(kb_, PITCH, 16 * si + c, 32 * ks + 8 * g), ld_frag(qb_, PITCH, 16 * tt + c, 32 * ks + 8 * g), acc);
#pragma unroll
            for (int r = 0; r < 4; ++r) acc[r] = (16 * si + 4 * g + r > 16 * tt + c) ? 0.f : acc[r];
            u32x2 w_; w_.x = cvt_pk_bf16(acc[0], acc[1]); w_.y = cvt_pk_bf16(acc[2], acc[3]);
            *(LAS u32x2*)(lds + OFF_AM + (16 * tt + c) * AMP + (16 * si + 4 * g) * 2) = w_;
        }
        {
            const f32x4 e1v = *(const LAS f32x4*)(e1s + 16 * w + 4 * g);
#pragma unroll
            for (int j = 0; j < 8; ++j) { S[j] = S[j] * e1v; u32x2 w_; w_.x = cvt_pk_bf16(S[j][0], S[j][1]); w_.y = cvt_pk_bf16(S[j][2], S[j][3]);
                *(LAS u32x2*)(lds + OFF_SP + (16 * j + c) * PITCH + (16 * w + 4 * g) * 2) = w_; }
        }
        __syncthreads();
        f32x4 o[4];
        {
            bf16x8 aq[4], aa[2];
#pragma unroll
            for (int ks = 0; ks < 4; ++ks) aq[ks] = ld_frag(qb_, PITCH, 16 * tt + c, 32 * ks + 8 * g);
#pragma unroll
            for (int j2 = 0; j2 < 2; ++j2) aa[j2] = ld_frag(lds + OFF_AM, AMP, 16 * tt + c, 32 * j2 + 8 * g);
            float ss = 0.f;
#pragma unroll
            for (int jj = 0; jj < 4; ++jj) {
                const int j = 4 * dvh + jj; f32x4 acc = {0.f, 0.f, 0.f, 0.f};
#pragma unroll
                for (int ks = 0; ks < 4; ++ks) acc = MFMA16(ld_frag(lds + OFF_SP, PITCH, 16 * j + c, 32 * ks + 8 * g), aq[ks], acc);
#pragma unroll
                for (int j2 = 0; j2 < 2; ++j2) acc = MFMA16(tr_frag(vb_, PITCH, 32 * j2, 16 * j, lane), aa[j2], acc);
                o[jj] = acc; ss += (acc[0] * acc[0] + acc[1] * acc[1]) + (acc[2] * acc[2] + acc[3] * acc[3]);
            }
            ss += __shfl_xor(ss, 16); ss += __shfl_xor(ss, 32);
            if (g == 0) ((LAS float*)(lds + OFF_RSS))[(16 * tt + c) * 2 + dvh] = ss;
        }
        __syncthreads();
        {
            const LAS float* rp = (const LAS float*)(lds + OFF_RSS) + (16 * tt + c) * 2; const float rs = rsqrtf((rp[0] + rp[1]) * (1.0f / 128.0f) + EPS);
#pragma unroll
            for (int jj = 0; jj < 4; ++jj) { const f32x4 v = o[jj] * rs * ghv[jj]; u32x2 w_;
                w_.x = cvt_pk_bf16(v[0] * bflo(ogv[jj].x), v[1] * bfhi(ogv[jj].x)); w_.y = cvt_pk_bf16(v[2] * bflo(ogv[jj].y), v[3] * bfhi(ogv[jj].y));
                *(u32x2*)(OUTp + ((oplane + (size_t)ch * 4096 + 16 * jj) & omask)) = w_; }
            bf16x8 ak[2];
#pragma unroll
            for (int k2 = 0; k2 < 2; ++k2) ak[k2] = tr_frag(kb_, PITCH, 32 * k2, 16 * w, lane);
            const f32x4 e2v = *(const LAS f32x4*)(e2s + 16 * w + 4 * g);
#pragma unroll
            for (int j = 0; j < 8; ++j) {
#pragma unroll
                for (int k2 = 0; k2 < 2; ++k2) S[j] = MFMA16(ak[k2], tr_frag(vb_, PITCH, 32 * k2, 16 * j, lane), S[j]);
                S[j] = S[j] * e2v;
            }
            commit(p ^ 1);
        }
        __syncthreads();
    }
}

namespace hg {
constexpr int NSEG = 8, SEGCH = NCH / NSEG;
}
__device__ __forceinline__ void hgrn_seg_a(LAS unsigned char* lds, int b, int h, int seg, const bf16_t* QIp, bf16_t* KIp, bf16_t* VBp, const float* E1p, const float* E2p) {
    using namespace hg;
    const int tid = threadIdx.x, lane = tid & 63, w = __builtin_amdgcn_readfirstlane(tid >> 6), c = lane & 15, g = lane >> 4;
    const size_t pl0 = ((size_t)(b * 16 + 2 * h)) * SEQ * 64, pl1 = pl0 + (size_t)SEQ * 64;
    const size_t eb = ((size_t)(b * BH + h)) * NCH * 128;
    const int tt = w >> 1, dvh = w & 1, ch0 = seg * SEGCH;
    f32x4 S[8];
#pragma unroll
    for (int j = 0; j < 8; ++j) S[j] = (f32x4){0.f, 0.f, 0.f, 0.f};
    f32x4 Dv = {1.f, 1.f, 1.f, 1.f};
    const size_t oplane = (dvh ? pl1 : pl0) + (size_t)(16 * tt + c) * 64 + 4 * g;
    u32x4 pq[2], pk[2], pv[2]; float pe = 0.f;
    auto issue = [&](int ch) {
#pragma unroll
        for (int k = 0; k < 2; ++k) { const int i = tid + 512 * k, row = i >> 4, pc = i & 15; const size_t src = (pc < 8 ? pl0 : pl1) + ((size_t)(64 * ch + row)) * 64 + (pc & 7) * 8;
            pq[k] = *(const u32x4*)(QIp + src); pk[k] = *(const u32x4*)(KIp + src); pv[k] = *(const u32x4*)(VBp + src); }
        if (tid < 256) pe = (tid < 128 ? E1p : E2p)[eb + (size_t)ch * 128 + (tid & 127)];
    };
    auto commit = [&](int p) {
        LAS unsigned char* bufp = lds + p * HBUF;
#pragma unroll
        for (int k = 0; k < 2; ++k) { const int i = tid + 512 * k, row = i >> 4, pc = i & 15; const int o = row * PITCH + pc * 16;
            *(LAS u32x4*)(bufp + o) = pq[k]; *(LAS u32x4*)(bufp + TILE + o) = pk[k]; *(LAS u32x4*)(bufp + 2 * TILE + o) = pv[k]; }
        if (tid < 256) ((LAS float*)(lds + OFF_E + p * 1024))[tid] = pe;
    };
    __syncthreads();
    issue(ch0); commit(0);
    __syncthreads();
    for (int cc = 0; cc < SEGCH; ++cc) {
        const int ch = ch0 + cc, p = cc & 1;
        const LAS unsigned char* qb_ = lds + p * HBUF; const LAS unsigned char* kb_ = qb_ + TILE; const LAS unsigned char* vb_ = qb_ + 2 * TILE;
        const LAS float* e1s = (const LAS float*)(lds + OFF_E + p * 1024); const LAS float* e2s = e1s + 128;
        issue(cc + 1 < SEGCH ? ch + 1 : ch);
#pragma unroll
        for (int s2 = 0; s2 < 2; ++s2) {
            const int si = 2 * (w & 1) + s2; f32x4 acc = {0.f, 0.f, 0.f, 0.f};
#pragma unroll
            for (int ks = 0; ks < 4; ++ks) acc = MFMA16(ld_frag(kb_, PITCH, 16 * si + c, 32 * ks + 8 * g), ld_frag(qb_, PITCH, 16 * tt + c, 32 * ks + 8 * g), acc);
#pragma unroll
            for (int r = 0; r < 4; ++r) acc[r] = (16 * si + 4 * g + r > 16 * tt + c) ? 0.f : acc[r];
            u32x2 w_; w_.x = cvt_pk_bf16(acc[0], acc[1]); w_.y = cvt_pk_bf16(acc[2], acc[3]);
            *(LAS u32x2*)(lds + OFF_AM + (16 * tt + c) * AMP + (16 * si + 4 * g) * 2) = w_;
        }
        const f32x4 e1v = *(const LAS f32x4*)(e1s + 16 * w + 4 * g), e2v = *(const LAS f32x4*)(e2s + 16 * w + 4 * g);
#pragma unroll
        for (int j = 0; j < 8; ++j) { S[j] = S[j] * e1v; u32x2 w_; w_.x = cvt_pk_bf16(S[j][0], S[j][1]); w_.y = cvt_pk_bf16(S[j][2], S[j][3]);
            *(LAS u32x2*)(lds + OFF_SP + (16 * j + c) * PITCH + (16 * w + 4 * g) * 2) = w_; }
        Dv = Dv * e1v * e2v;
        __syncthreads();
        {
            bf16x8 aq[4], aa[2];
#pragma unroll
            for (int ks = 0; ks < 4; ++ks) aq[ks] = ld_frag(qb_, PITCH, 16 * tt + c, 32 * ks + 8 * g);
#pragma unroll
            for (int j2 = 0; j2 < 2; ++j2) aa[j2] = ld_frag(lds + OFF_AM, AMP, 16 * tt + c, 32 * j2 + 8 * g);
#pragma unroll
            for (int jj = 0; jj < 4; ++jj) {
                const int j = 4 * dvh + jj; f32x4 acc = {0.f, 0.f, 0.f, 0.f};
#pragma unroll
                for (int ks = 0; ks < 4; ++ks) acc = MFMA16(ld_frag(lds + OFF_SP, PITCH, 16 * j + c, 32 * ks + 8 * g), aq[ks], acc);
#pragma unroll
                for (int j2 = 0; j2 < 2; ++j2) acc = MFMA16(tr_frag(vb_, PITCH, 32 * j2, 16 * j, lane), aa[j2], acc);
                u32x2 w_; w_.x = cvt_pk_bf16(acc[0], acc[1]); w_.y = cvt_pk_bf16(acc[2], acc[3]);
                *(u32x2*)(KIp + oplane + (size_t)ch * 4096 + 16 * jj) = w_;
            }
        }
        {
            bf16x8 ak[2];
#pragma unroll
            for (int k2 = 0; k2 < 2; ++k2) ak[k2] = tr_frag(kb_, PITCH, 32 * k2, 16 * w, lane);
#pragma unroll
            for (int j = 0; j < 8; ++j) {
#pragma unroll
                for (int k2 = 0; k2 < 2; ++k2) S[j] = MFMA16(ak[k2], tr_frag(vb_, PITCH, 32 * k2, 16 * j, lane), S[j]);
                S[j] = S[j] * e2v;
            }
            commit(p ^ 1);
        }
        __syncthreads();
    }
    float* Lg = (float*)(VBp + pl0 + (size_t)seg * SEGCH * 4096); float* Dg = (float*)(VBp + pl1 + (size_t)seg * SEGCH * 4096);
#pragma unroll
    for (int j = 0; j < 8; ++j)
#pragma unroll
        for (int r = 0; r < 4; ++r) Lg[(16 * w + 4 * g + r) * 128 + 16 * j + c] = S[j][r];
    if (c == 0) *(f32x4*)(Dg + 16 * w + 4 * g) = Dv;
}
__device__ __forceinline__ void hgrn_seg_b(LAS unsigned char* lds, int b, int h, int seg, bf16_t* QIp, const bf16_t* KIp, const bf16_t* VBp, const bf16_t* OGp, const float* E1p, const float* E2p, const float* gh) {
    using namespace hg;
    const int tid = threadIdx.x, lane = tid & 63, w = __builtin_amdgcn_readfirstlane(tid >> 6), c = lane & 15, g = lane >> 4;
    const size_t pl0 = ((size_t)(b * 16 + 2 * h)) * SEQ * 64, pl1 = pl0 + (size_t)SEQ * 64;
    const size_t eb = ((size_t)(b * BH + h)) * NCH * 128;
    const int tt = w >> 1, dvh = w & 1, ch0 = seg * SEGCH;
    f32x4 S[8];
#pragma unroll
    for (int j = 0; j < 8; ++j) S[j] = (f32x4){0.f, 0.f, 0.f, 0.f};
    for (int gp = 0; gp < seg; ++gp) {
        const float* Lg = (const float*)(VBp + pl0 + (size_t)gp * SEGCH * 4096); const float* Dg = (const float*)(VBp + pl1 + (size_t)gp * SEGCH * 4096);
        const f32x4 dv_ = *(const f32x4*)(Dg + 16 * w + 4 * g);
#pragma unroll
        for (int j = 0; j < 8; ++j)
#pragma unroll
            for (int r = 0; r < 4; ++r) S[j][r] = dv_[r] * S[j][r] + Lg[(16 * w + 4 * g + r) * 128 + 16 * j + c];
    }
    f32x4 ghv[4];
#pragma unroll
    for (int jj = 0; jj < 4; ++jj) ghv[jj] = *(const f32x4*)(gh + h * 128 + 64 * dvh + 16 * jj + 4 * g);
    const size_t oplane = (dvh ? pl1 : pl0) + (size_t)(16 * tt + c) * 64 + 4 * g;
    const size_t qrow = (size_t)(16 * tt + c) * 64 + 8 * g;
    f32x4 P = {1.f, 1.f, 1.f, 1.f};
    __syncthreads();
    for (int cc = 0; cc < SEGCH; ++cc) {
        const int ch = ch0 + cc;
        bf16x8 qf[4]; u32x2 ol[4], ogv[4];
#pragma unroll
        for (int ks = 0; ks < 4; ++ks) qf[ks] = *(const bf16x8*)(QIp + ((ks >> 1) ? pl1 : pl0) + (size_t)ch * 4096 + qrow + 32 * (ks & 1));
#pragma unroll
        for (int jj = 0; jj < 4; ++jj) { ol[jj] = *(const u32x2*)(KIp + oplane + (size_t)ch * 4096 + 16 * jj); ogv[jj] = *(const u32x2*)(OGp + oplane + (size_t)ch * 4096 + 16 * jj); }
        const f32x4 e1r = *(const f32x4*)(E1p + eb + (size_t)ch * 128 + 16 * w + 4 * g), e2r = *(const f32x4*)(E2p + eb + (size_t)ch * 128 + 16 * w + 4 * g);
        const f32x4 cv = e1r * P;
#pragma unroll
        for (int j = 0; j < 8; ++j) { const f32x4 sv = S[j] * cv; u32x2 w_; w_.x = cvt_pk_bf16(sv[0], sv[1]); w_.y = cvt_pk_bf16(sv[2], sv[3]);
            *(LAS u32x2*)(lds + OFF_SP + (16 * j + c) * PITCH + (16 * w + 4 * g) * 2) = w_; }
        P = P * e1r * e2r;
        __syncthreads();
        f32x4 o[4]; float ss = 0.f;
#pragma unroll
        for (int jj = 0; jj < 4; ++jj) {
            const int j = 4 * dvh + jj; f32x4 acc = {bflo(ol[jj].x), bfhi(ol[jj].x), bflo(ol[jj].y), bfhi(ol[jj].y)};
#pragma unroll
            for (int ks = 0; ks < 4; ++ks) acc = MFMA16(ld_frag(lds + OFF_SP, PITCH, 16 * j + c, 32 * ks + 8 * g), qf[ks], acc);
            o[jj] = acc; ss += (acc[0] * acc[0] + acc[1] * acc[1]) + (acc[2] * acc[2] + acc[3] * acc[3]);
        }
        ss += __shfl_xor(ss, 16); ss += __shfl_xor(ss, 32);
        if (g == 0) ((LAS float*)(lds + OFF_RSS))[(16 * tt + c) * 2 + dvh] = ss;
        __syncthreads();
        const LAS float* rp = (const LAS float*)(lds + OFF_RSS) + (16 * tt + c) * 2; const float rs = rsqrtf((rp[0] + rp[1]) * (1.0f / 128.0f) + EPS);
#pragma unroll
        for (int jj = 0; jj < 4; ++jj) { const f32x4 v = o[jj] * rs * ghv[jj]; u32x2 w_;
            w_.x = cvt_pk_bf16(v[0] * bflo(ogv[jj].x), v[1] * bfhi(ogv[jj].x)); w_.y = cvt_pk_bf16(v[2] * bflo(ogv[jj].y), v[3] * bfhi(ogv[jj].y));
            *(u32x2*)(QIp + oplane + (size_t)ch * 4096 + 16 * jj) = w_; }
    }
}

namespace mb {
constexpr int KP_ = 144;
constexpr int OFF_K = 0, OFF_V = 256 * KP_, OFF_KM = 2 * 256 * KP_, OFF_CNT = OFF_KM + 8192, OFF_BASE = OFF_CNT + 128, END = OFF_BASE + 128;
static_assert(END <= 160 * 1024, "moba lds");
constexpr size_t WS_PO = 264 * MiB, WS_PL = 456 * MiB, WS_LIST = 462 * MiB;
constexpr int LIST_PER_BH = 256 * 496;
static_assert(WS_PO + (size_t)64 * SEQ * 3 * 128 <= WS_PL && WS_PL + (size_t)64 * SEQ * 3 * 4 <= WS_LIST && WS_LIST + (size_t)64 * LIST_PER_BH * 2 <= 512 * MiB, "moba ws");
__device__ __forceinline__ int list_off(int n) { return 256 * (31 * n - (n * (n - 1)) / 2); }
}
__device__ __forceinline__ void mb_stage(LAS unsigned char* dst, const bf16_t* g, int tid) {
    u32x4 r[4];
#pragma unroll
    for (int k = 0; k < 4; ++k) { const int i = tid + 512 * k; r[k] = *(const u32x4*)(g + (size_t)(i >> 3) * 64 + (i & 7) * 8); }
#pragma unroll
    for (int k = 0; k < 4; ++k) { const int i = tid + 512 * k; *(LAS u32x4*)(dst + (i >> 3) * mb::KP_ + (i & 7) * 16) = r[k]; }
}
struct MbStage { u32x4 rk[4], rv[4]; };
__device__ __forceinline__ void mb_stage_issue(MbStage& st, const bf16_t* gk, const bf16_t* gv, int tid) {
#pragma unroll
    for (int k = 0; k < 4; ++k) { const int i = tid + 512 * k; const size_t o = (size_t)(i >> 3) * 64 + (i & 7) * 8; st.rk[k] = *(const u32x4*)(gk + o); st.rv[k] = *(const u32x4*)(gv + o); }
}
__device__ __forceinline__ void mb_stage_commit(const MbStage& st, LAS unsigned char* lds, int tid) {
#pragma unroll
    for (int k = 0; k < 4; ++k) { const int i = tid + 512 * k; const int o = (i >> 3) * mb::KP_ + (i & 7) * 16; *(LAS u32x4*)(lds + mb::OFF_K + o) = st.rk[k]; *(LAS u32x4*)(lds + mb::OFF_V + o) = st.rv[k]; }
}
__device__ __forceinline__ void mb_granule(const LAS unsigned char* lds, int lane, bf16x8 q0, bf16x8 q1, float mref, int qpos, int nstep, f32x4 (&o)[4], float& l) {
    using namespace mb;
    const int c = lane & 15, g = lane >> 4;
    float ls = 0.f;
#pragma unroll
    for (int dt = 0; dt < 4; ++dt) o[dt] = (f32x4){0.f, 0.f, 0.f, 0.f};
#pragma unroll
    for (int j = 0; j < 8; ++j) {
        if (j < nstep) {
            f32x4 s0 = {-mref, -mref, -mref, -mref}, s1 = s0;
            s0 = MFMA16(ld_frag(lds + OFF_K, KP_, 32 * j + c, 8 * g), q0, s0); s0 = MFMA16(ld_frag(lds + OFF_K, KP_, 32 * j + c, 32 + 8 * g), q1, s0);
            s1 = MFMA16(ld_frag(lds + OFF_K, KP_, 32 * j + 16 + c, 8 * g), q0, s1); s1 = MFMA16(ld_frag(lds + OFF_K, KP_, 32 * j + 16 + c, 32 + 8 * g), q1, s1);
#pragma unroll
            for (int r = 0; r < 4; ++r) { float p0 = __builtin_amdgcn_exp2f(s0[r]), p1 = __builtin_amdgcn_exp2f(s1[r]);
                p0 = (32 * j + 4 * g + r > qpos) ? 0.f : p0; p1 = (32 * j + 16 + 4 * g + r > qpos) ? 0.f : p1; s0[r] = p0; s1[r] = p1; ls += p0 + p1; }
            u32x4 w_; w_.x = cvt_pk_bf16(s0[0], s0[1]); w_.y = cvt_pk_bf16(s0[2], s0[3]); w_.z = cvt_pk_bf16(s1[0], s1[1]); w_.w = cvt_pk_bf16(s1[2], s1[3]);
            const bf16x8 pf = __builtin_bit_cast(bf16x8, w_);
#pragma unroll
            for (int dt = 0; dt < 4; ++dt) o[dt] = MFMA16(tr_frag_split(lds + OFF_V, KP_, 32 * j, 16 * dt, lane), pf, o[dt]);
        }
    }
    asm volatile("s_nop 15" : "+v"(o[0]), "+v"(o[1]), "+v"(o[2]), "+v"(o[3]));
    ls += __shfl_xor(ls, 16); ls += __shfl_xor(ls, 32); l = ls;
}
__device__ __forceinline__ float mb_mref(bf16x8 q0, bf16x8 q1, float kam) {
    float s = 0.f;
#pragma unroll
    for (int i = 0; i < 8; ++i) s += fabsf(bf2f((bf16_t)q0[i])) + fabsf(bf2f((bf16_t)q1[i]));
    s += __shfl_xor(s, 16); s += __shfl_xor(s, 32); return s * kam;
}
__device__ __forceinline__ void moba_gate_item(LAS unsigned char* lds, int bh, int bhl, int qb, const bf16_t* Qg, const float* kmeang, unsigned* gcnt, unsigned short* glist) {
    using namespace mb;
    int tid_ = threadIdx.x; asm volatile("" : "+v"(tid_)); const int tid = tid_;
    const size_t pbase = (size_t)bh * SEQ * 64;
    u32x4 rq[4]; float rkm[4];
#pragma unroll
    for (int k = 0; k < 4; ++k) { const int i = tid + 512 * k; rq[k] = *(const u32x4*)(Qg + pbase + (size_t)256 * qb * 64 + (size_t)(i >> 3) * 64 + (i & 7) * 8); rkm[k] = (i < qb * 64) ? kmeang[(size_t)bh * NBLK * 64 + i] : 0.f; }
    __syncthreads();
    LAS float* kms = (LAS float*)(lds + OFF_KM);
#pragma unroll
    for (int k = 0; k < 4; ++k) { const int i = tid + 512 * k; *(LAS u32x4*)(lds + OFF_K + (i >> 3) * KP_ + (i & 7) * 16) = rq[k]; kms[i] = rkm[k]; }
    if (tid < 32) ((LAS int*)(lds + OFF_CNT))[tid] = 0;
    __syncthreads();
    const int q = tid >> 1, hf = tid & 1; float qv[32];
#pragma unroll
    for (int k = 0; k < 4; ++k) { const u32x4 w_ = *(const LAS u32x4*)(lds + OFF_K + q * KP_ + hf * 64 + k * 16); f32x4 x0, x1; unpack8(w_, x0, x1);
#pragma unroll
        for (int e = 0; e < 4; ++e) { qv[8 * k + e] = x0[e]; qv[8 * k + 4 + e] = x1[e]; } }
    float v0 = -INFINITY, v1 = -INFINITY, v2 = -INFINITY; int i0 = -1, i1 = -1, i2 = -1;
    for (int n = 0; n < qb; ++n) { float gsum = 0.f; const LAS float* km = kms + n * 64 + hf * 32;
#pragma unroll
        for (int d = 0; d < 32; ++d) gsum += qv[d] * km[d];
        gsum += __shfl_xor(gsum, 1);
        if (gsum > v0) { v2 = v1; i2 = i1; v1 = v0; i1 = i0; v0 = gsum; i0 = n; } else if (gsum > v1) { v2 = v1; i2 = i1; v1 = gsum; i1 = n; } else if (gsum > v2) { v2 = gsum; i2 = n; } }
    int p0 = 0, p1 = 0, p2 = 0; LAS int* cnt = (LAS int*)(lds + OFF_CNT);
    if (hf == 0) {
        if (i0 >= 0) p0 = __hip_atomic_fetch_add(cnt + i0, 1, __ATOMIC_RELAXED, __HIP_MEMORY_SCOPE_WORKGROUP);
        if (i1 >= 0) p1 = __hip_atomic_fetch_add(cnt + i1, 1, __ATOMIC_RELAXED, __HIP_MEMORY_SCOPE_WORKGROUP);
        if (i2 >= 0) p2 = __hip_atomic_fetch_add(cnt + i2, 1, __ATOMIC_RELAXED, __HIP_MEMORY_SCOPE_WORKGROUP);
    }
    __syncthreads();
    if (tid < 32) { const int cn = cnt[tid]; ((LAS int*)(lds + OFF_BASE))[tid] = cn > 0 ? (int)atomicAdd(gcnt + bhl * 32 + tid, (unsigned)cn) : 0; }
    __syncthreads();
    if (hf == 0) {
        const LAS int* base = (const LAS int*)(lds + OFF_BASE); unsigned short* gl = glist + (size_t)bhl * LIST_PER_BH; const unsigned qg = (unsigned)(256 * qb + q);
        if (i0 >= 0) gl[list_off(i0) + base[i0] + p0] = (unsigned short)(qg);
        if (i1 >= 0) gl[list_off(i1) + base[i1] + p1] = (unsigned short)(qg | (1u << 13));
        if (i2 >= 0) gl[list_off(i2) + base[i2] + p2] = (unsigned short)(qg | (2u << 13));
    }
}
__device__ __forceinline__ void moba_part_item(LAS unsigned char* lds, int bh, int bhl, int n, int chunk, const bf16_t* Qg, const bf16_t* Kg, const bf16_t* Vg, const unsigned* kamaxg, const unsigned* gcnt, const unsigned short* glist, bf16_t* PO, float* PL) {
    using namespace mb;
    int tid_ = threadIdx.x; asm volatile("" : "+v"(tid_)); const int tid = tid_, lane = tid & 63, w = __builtin_amdgcn_readfirstlane(tid >> 6), c = lane & 15, g = lane >> 4;
    const int cnt = (int)gcnt[bhl * 32 + n], e0 = 512 * chunk;
    if (e0 >= cnt) return;
    const size_t pbase = (size_t)bh * SEQ * 64;
    MbStage st; mb_stage_issue(st, Kg + pbase + (size_t)256 * n * 64, Vg + pbase + (size_t)256 * n * 64, tid);
    const float kam = __uint_as_float(kamaxg[bh]); const unsigned short* gl = glist + (size_t)bhl * LIST_PER_BH + list_off(n);
    unsigned ent[4]; bool valid[4]; bf16x8 q0[4], q1[4];
#pragma unroll
    for (int k = 0; k < 4; ++k) { const int e = e0 + 16 * (w + 8 * k) + c; valid[k] = e < cnt; ent[k] = gl[valid[k] ? e : e0]; }
#pragma unroll
    for (int k = 0; k < 4; ++k) { const bf16_t* qr = Qg + pbase + (size_t)(ent[k] & 8191) * 64; q0[k] = *(const bf16x8*)(qr + 8 * g); q1[k] = *(const bf16x8*)(qr + 32 + 8 * g); }
    __syncthreads();
    mb_stage_commit(st, lds, tid);
    __syncthreads();
    if (e0 + 16 * w >= cnt) return;
    float mref[4], ls[4]; f32x4 o[4][4];
#pragma unroll
    for (int k = 0; k < 4; ++k) { mref[k] = valid[k] ? mb_mref(q0[k], q1[k], kam) : INFINITY; ls[k] = 0.f;
#pragma unroll
        for (int dt = 0; dt < 4; ++dt) o[k][dt] = (f32x4){0.f, 0.f, 0.f, 0.f}; }
#pragma unroll 1
    for (int j = 0; j < 8; ++j) {
        const bf16x8 ka0 = ld_frag(lds + OFF_K, KP_, 32 * j + c, 8 * g), ka1 = ld_frag(lds + OFF_K, KP_, 32 * j + c, 32 + 8 * g);
        const bf16x8 kb0 = ld_frag(lds + OFF_K, KP_, 32 * j + 16 + c, 8 * g), kb1 = ld_frag(lds + OFF_K, KP_, 32 * j + 16 + c, 32 + 8 * g);
        bf16x8 pf[4];
#pragma unroll
        for (int k = 0; k < 4; ++k) {
            f32x4 s0 = {0.f, 0.f, 0.f, 0.f}, s1 = {0.f, 0.f, 0.f, 0.f};
            s0 = MFMA16(ka0, q0[k], s0); s0 = MFMA16(ka1, q1[k], s0); s1 = MFMA16(kb0, q0[k], s1); s1 = MFMA16(kb1, q1[k], s1);
#pragma unroll
            for (int r = 0; r < 4; ++r) { s0[r] = __builtin_amdgcn_exp2f(s0[r] - mref[k]); s1[r] = __builtin_amdgcn_exp2f(s1[r] - mref[k]); ls[k] += s0[r] + s1[r]; }
            u32x4 w_; w_.x = cvt_pk_bf16(s0[0], s0[1]); w_.y = cvt_pk_bf16(s0[2], s0[3]); w_.z = cvt_pk_bf16(s1[0], s1[1]); w_.w = cvt_pk_bf16(s1[2], s1[3]);
            pf[k] = __builtin_bit_cast(bf16x8, w_); __builtin_amdgcn_sched_barrier(0);
        }
#pragma unroll
        for (int dt = 0; dt < 4; ++dt) { const bf16x8 vf = tr_frag_split(lds + OFF_V, KP_, 32 * j, 16 * dt, lane);
#pragma unroll
            for (int k = 0; k < 4; ++k) o[k][dt] = MFMA16(vf, pf[k], o[k][dt]); }
    }
#pragma unroll
    for (int k = 0; k < 4; ++k) {
        float l = ls[k]; l += __shfl_xor(l, 16); l += __shfl_xor(l, 32);
        if (valid[k]) { const int q = ent[k] & 8191, j = ent[k] >> 13; const size_t slot = ((size_t)bhl * SEQ + q) * 3 + j; bf16_t* po = PO + slot * 64 + 4 * g;
#pragma unroll
            for (int dt = 0; dt < 4; ++dt) { u32x2 w_; w_.x = cvt_pk_bf16(o[k][dt][0], o[k][dt][1]); w_.y = cvt_pk_bf16(o[k][dt][2], o[k][dt][3]); *(u32x2*)(po + 16 * dt) = w_; }
            if (g == 0) PL[slot] = l; }
    }
}
__device__ __forceinline__ void moba_part_phase(LAS unsigned char* lds, const LAS int* pfx, int nitems, int mbi, int nmb, const bf16_t* Qg, const bf16_t* Kg, const bf16_t* Vg, const unsigned* kamaxg, const unsigned* gcnt, const unsigned short* glist, bf16_t* PO, float* PL) {
    using namespace mb;
    int tid_ = threadIdx.x; asm volatile("" : "+v"(tid_)); const int tid = tid_, lane = tid & 63, w = __builtin_amdgcn_readfirstlane(tid >> 6), c = lane & 15, g = lane >> 4;
    MbStage st; unsigned ent[4]; bool valid[4]; int bh = 0, bhl = 0, cnt = 0, e0 = 0; bool have = false;
    auto fetch = [&](int r) {
        const int k = r * nmb + ((r & 1) ? nmb - 1 - mbi : mbi);
        have = (r * nmb < nitems) && (k < nitems);
        if (!have) return;
        int lo_ = 0, hi_ = 2047;
        while (lo_ < hi_) { const int mid = (lo_ + hi_) >> 1; if (pfx[mid] > k) hi_ = mid; else lo_ = mid + 1; }
        const int n = lo_ >> 6; bhl = lo_ & 63; const int chunk = k - (lo_ ? pfx[lo_ - 1] : 0); bh = bhl;
        cnt = (int)gcnt[bhl * 32 + n]; e0 = 512 * chunk;
        const size_t pbase = (size_t)bh * SEQ * 64;
        mb_stage_issue(st, Kg + pbase + (size_t)256 * n * 64, Vg + pbase + (size_t)256 * n * 64, tid);
        const unsigned short* gl = glist + (size_t)bhl * LIST_PER_BH + list_off(n);
#pragma unroll
        for (int k4 = 0; k4 < 4; ++k4) { const int e = e0 + 16 * (w + 8 * k4) + c; valid[k4] = e < cnt; ent[k4] = gl[valid[k4] ? e : e0]; }
    };
    fetch(0);
    for (int r = 0; have; ++r) {
        const int cbh = bh, cbhl = bhl, ccnt = cnt, ce0 = e0; unsigned cent[4]; bool cval[4]; bf16x8 q0[4], q1[4];
        const size_t pbase = (size_t)cbh * SEQ * 64;
#pragma unroll
        for (int k = 0; k < 4; ++k) { cent[k] = ent[k]; cval[k] = valid[k]; const bf16_t* qr = Qg + pbase + (size_t)(cent[k] & 8191) * 64; q0[k] = *(const bf16x8*)(qr + 8 * g); q1[k] = *(const bf16x8*)(qr + 32 + 8 * g); }
        const float kam = __uint_as_float(kamaxg[cbh]);
        __syncthreads();
        mb_stage_commit(st, lds, tid);
        __syncthreads();
        fetch(r + 1);
        if (ce0 + 16 * w < ccnt) {
            float nmr[4], ls[4]; f32x4 o[4][4];
#pragma unroll
            for (int k = 0; k < 4; ++k) { nmr[k] = cval[k] ? -mb_mref(q0[k], q1[k], kam) : -INFINITY; ls[k] = 0.f;
#pragma unroll
                for (int dt = 0; dt < 4; ++dt) o[k][dt] = (f32x4){0.f, 0.f, 0.f, 0.f}; }
#pragma unroll 1
            for (int j = 0; j < 8; ++j) {
                const bf16x8 ka0 = ld_frag(lds + OFF_K, KP_, 32 * j + c, 8 * g), ka1 = ld_frag(lds + OFF_K, KP_, 32 * j + c, 32 + 8 * g);
                const bf16x8 kb0 = ld_frag(lds + OFF_K, KP_, 32 * j + 16 + c, 8 * g), kb1 = ld_frag(lds + OFF_K, KP_, 32 * j + 16 + c, 32 + 8 * g);
                bf16x8 pf[4];
#pragma unroll
                for (int k = 0; k < 4; ++k) {
                    f32x4 s0 = {nmr[k], nmr[k], nmr[k], nmr[k]}, s1 = s0;
                    s0 = MFMA16(ka0, q0[k], s0); s0 = MFMA16(ka1, q1[k], s0); s1 = MFMA16(kb0, q0[k], s1); s1 = MFMA16(kb1, q1[k], s1);
#pragma unroll
                    for (int rr = 0; rr < 4; ++rr) { s0[rr] = __builtin_amdgcn_exp2f(s0[rr]); s1[rr] = __builtin_amdgcn_exp2f(s1[rr]); ls[k] += s0[rr] + s1[rr]; }
                    u32x4 w_; w_.x = cvt_pk_bf16(s0[0], s0[1]); w_.y = cvt_pk_bf16(s0[2], s0[3]); w_.z = cvt_pk_bf16(s1[0], s1[1]); w_.w = cvt_pk_bf16(s1[2], s1[3]);
                    pf[k] = __builtin_bit_cast(bf16x8, w_); __builtin_amdgcn_sched_barrier(0);
                }
#pragma unroll
                for (int dt = 0; dt < 4; ++dt) { const bf16x8 vf = tr_frag_split(lds + OFF_V, KP_, 32 * j, 16 * dt, lane);
#pragma unroll
                    for (int k = 0; k < 4; ++k) o[k][dt] = MFMA16(vf, pf[k], o[k][dt]); }
            }
#pragma unroll
            for (int k = 0; k < 4; ++k) {
                float l = ls[k]; l += __shfl_xor(l, 16); l += __shfl_xor(l, 32);
                if (cval[k]) { const int q = cent[k] & 8191, j = cent[k] >> 13; const size_t slot = ((size_t)cbhl * SEQ + q) * 3 + j; bf16_t* po = PO + slot * 64 + 4 * g;
#pragma unroll
                    for (int dt = 0; dt < 4; ++dt) { u32x2 w_; w_.x = cvt_pk_bf16(o[k][dt][0], o[k][dt][1]); w_.y = cvt_pk_bf16(o[k][dt][2], o[k][dt][3]); *(u32x2*)(po + 16 * dt) = w_; }
                    if (g == 0) PL[slot] = l; }
            }
        }
    }
}
__device__ __forceinline__ void moba_comb_item(LAS unsigned char* lds, int bh, int bhl, int qb, bf16_t* Qg, const bf16_t* Kg, const bf16_t* Vg, const unsigned* kamaxg, const bf16_t* PO, const float* PL) {
    using namespace mb;
    int tid_ = threadIdx.x; asm volatile("" : "+v"(tid_)); const int tid = tid_, lane = tid & 63, w = __builtin_amdgcn_readfirstlane(tid >> 6), c = lane & 15, g = lane >> 4;
    const size_t pbase = (size_t)bh * SEQ * 64;
    MbStage st; mb_stage_issue(st, Kg + pbase + (size_t)256 * qb * 64, Vg + pbase + (size_t)256 * qb * 64, tid);
    const float kam = __uint_as_float(kamaxg[bh]); const int nsel = qb < 3 ? qb : 3;
    bf16x8 q0[2], q1[2];
#pragma unroll
    for (int k = 0; k < 2; ++k) { const int gq = k ? 15 - w : w; const bf16_t* qr = Qg + pbase + (size_t)(256 * qb + 16 * gq + c) * 64; q0[k] = *(const bf16x8*)(qr + 8 * g); q1[k] = *(const bf16x8*)(qr + 32 + 8 * g); }
    __syncthreads();
    mb_stage_commit(st, lds, tid);
    __syncthreads();
#pragma unroll 1
    for (int k = 0; k < 2; ++k) {
        const int gq = k ? 15 - w : w, ql = 16 * gq + c, q = 256 * qb + ql;
        const bf16x8 qa = k ? q0[1] : q0[0], qb_ = k ? q1[1] : q1[0];
        const size_t slot = ((size_t)bhl * SEQ + q) * 3;
        u32x2 pp[3][4]; float pl[3];
#pragma unroll
        for (int j = 0; j < 3; ++j) { const bool on = j < nsel; pl[j] = on ? PL[slot + j] : 0.f; const bf16_t* po = PO + (slot + (on ? j : 0)) * 64 + 4 * g;
#pragma unroll
            for (int dt = 0; dt < 4; ++dt) pp[j][dt] = on ? *(const u32x2*)(po + 16 * dt) : (u32x2){0u, 0u}; }
        const float mref = mb_mref(qa, qb_, kam);
        f32x4 o[4]; float l; mb_granule(lds, lane, qa, qb_, mref, ql, (gq >> 1) + 1, o, l);
#pragma unroll
        for (int j = 0; j < 3; ++j) { l += pl[j];
#pragma unroll
            for (int dt = 0; dt < 4; ++dt) { o[dt][0] += bflo(pp[j][dt].x); o[dt][1] += bfhi(pp[j][dt].x); o[dt][2] += bflo(pp[j][dt].y); o[dt][3] += bfhi(pp[j][dt].y); } }
        const float rl = 1.0f / l; bf16_t* qr = Qg + pbase + (size_t)q * 64;
#pragma unroll
        for (int dt = 0; dt < 4; ++dt) { u32x2 w_; w_.x = cvt_pk_bf16(o[dt][0] * rl, o[dt][1] * rl); w_.y = cvt_pk_bf16(o[dt][2] * rl, o[dt][3] * rl); *(u32x2*)(qr + 16 * dt + 4 * g) = w_; }
    }
}

namespace xa {
constexpr int P = 528;
constexpr int END = 256 * P;
static_assert(END <= 160 * 1024, "xattn lds");
}
__device__ __forceinline__ void xattn_unit(LAS unsigned char* lds, int b, int hx, int tok0, const bf16_t* QXg, const bf16_t* KXg, const bf16_t* VXg, bf16_t* OXg) {
    using namespace xa;
    int tid_ = threadIdx.x; asm volatile("" : "+v"(tid_));
    const int tid = tid_, lane = tid & 63, w = __builtin_amdgcn_readfirstlane(tid >> 6), c = lane & 15, g = lane >> 4;
    const bf16_t* kb = KXg + (size_t)(b * 4 + hx) * 256 * 256; const bf16_t* vb = VXg + (size_t)(b * 4 + hx) * 256 * 256;
    auto stage = [&](const bf16_t* src) {
#pragma unroll
        for (int h2 = 0; h2 < 2; ++h2) { u32x4 rr[8]; int tid = tid_; asm volatile("" : "+v"(tid));
#pragma unroll
            for (int k = 0; k < 8; ++k) { const int i = tid + 512 * (8 * h2 + k); rr[k] = *(const u32x4*)(src + (size_t)(i >> 5) * 256 + (i & 31) * 8); }
#pragma unroll
            for (int k = 0; k < 8; ++k) { const int i = tid + 512 * (8 * h2 + k); *(LAS u32x4*)(lds + (i >> 5) * P + (i & 31) * 16) = rr[k]; } }
    };
    __syncthreads();
    stage(kb);
    __syncthreads();
    bf16x8 pf[2][8]; float rl[2], fa[2];
#pragma unroll
    for (int t2 = 0; t2 < 2; ++t2) {
        const size_t tok = (size_t)tok0 + 128 * t2 + 16 * w + c;
        bf16x8 qf[8];
#pragma unroll
        for (int ks = 0; ks < 8; ++ks) qf[ks] = *(const bf16x8*)(QXg + tok * D + hx * 256 + 32 * ks + 8 * g);
        float mh[2], lh[2];
#pragma unroll
        for (int hf = 0; hf < 2; ++hf) {
            f32x4 sc[8]; float mx = -INFINITY;
#pragma unroll
            for (int t = 0; t < 8; ++t) { f32x4 acc = {0.f, 0.f, 0.f, 0.f};
#pragma unroll
                for (int ks = 0; ks < 8; ++ks) acc = MFMA16(ld_frag(lds, P, 128 * hf + 16 * t + c, 32 * ks + 8 * g), qf[ks], acc);
                sc[t] = acc; mx = fmaxf(mx, fmaxf(fmaxf(acc[0], acc[1]), fmaxf(acc[2], acc[3]))); __builtin_amdgcn_sched_barrier(0); }
            mx = fmaxf(mx, __shfl_xor(mx, 16)); mx = fmaxf(mx, __shfl_xor(mx, 32));
            if (hf == 1) mx = fmaxf(mx, mh[0]);
            float ls = 0.f;
#pragma unroll
            for (int t = 0; t < 8; ++t)
#pragma unroll
                for (int r = 0; r < 4; ++r) { const float p = __builtin_amdgcn_exp2f(sc[t][r] - mx); sc[t][r] = p; ls += p; }
            ls += __shfl_xor(ls, 16); ls += __shfl_xor(ls, 32); mh[hf] = mx; lh[hf] = ls;
#pragma unroll
            for (int j = 0; j < 4; ++j) { u32x4 w_; w_.x = cvt_pk_bf16(sc[2 * j][0], sc[2 * j][1]); w_.y = cvt_pk_bf16(sc[2 * j][2], sc[2 * j][3]); w_.z = cvt_pk_bf16(sc[2 * j + 1][0], sc[2 * j + 1][1]); w_.w = cvt_pk_bf16(sc[2 * j + 1][2], sc[2 * j + 1][3]);
                pf[t2][4 * hf + j] = __builtin_bit_cast(bf16x8, w_); }
            __builtin_amdgcn_sched_barrier(0);
        }
        fa[t2] = __builtin_amdgcn_exp2f(mh[0] - mh[1]);
        rl[t2] = __builtin_amdgcn_rcpf(fa[t2] * lh[0] + lh[1]);
    }
    __syncthreads();
    stage(vb);
    __syncthreads();
#pragma unroll
    for (int t2 = 0; t2 < 2; ++t2) {
        const size_t tok = (size_t)tok0 + 128 * t2 + 16 * w + c;
        f32x4 o[16];
#pragma unroll
        for (int dt = 0; dt < 16; ++dt) o[dt] = (f32x4){0.f, 0.f, 0.f, 0.f};
#pragma unroll
        for (int j = 0; j < 8; ++j) {
            if (j == 4) {
#pragma unroll
                for (int dt = 0; dt < 16; ++dt) o[dt] = o[dt] * fa[t2]; }
#pragma unroll
            for (int dt = 0; dt < 16; ++dt) { o[dt] = MFMA16(tr_frag_split(lds, P, 32 * j, 16 * dt, lane), pf[t2][j], o[dt]); if ((dt & 3) == 3) __builtin_amdgcn_sched_barrier(0); }
        }
#pragma unroll
        for (int dt = 0; dt < 16; ++dt) { u32x2 w_; w_.x = cvt_pk_bf16(o[dt][0] * rl[t2], o[dt][1] * rl[t2]); w_.y = cvt_pk_bf16(o[dt][2] * rl[t2], o[dt][3] * rl[t2]); *(u32x2*)(OXg + tok * D + hx * 256 + 16 * dt + 4 * g) = w_; }
    }
}

struct Args {
    const float* x; const float* mem; const int* pos; const float* g_mix; const float* w_in; const float* lbl; const float* g_hgrn; const float* w_bra; const float* w_brh; const float* w_out;
    const float* g_x; const float* g_mem; const float* wq; const float* wkv; const float* wo; const float* g_ffn; const float* w_ffi; const float* w_ffo; const float* g_fin;
    float* out; unsigned char* ws; int ph_lo, ph_hi;
};

template <class MapFn>
__device__ __forceinline__ void wt_item(const float* W, int ldw, const float* gain, bf16_t* WT, int ldwt, int koff, int nblk, int item, LAS float* scr, int lane, MapFn colmap) {
    const int kb = item / nblk, nb = item % nblk, k0 = 64 * kb, n0 = 32 * nb;
    const int col = colmap(n0 + (lane & 31));
    float wv[32];
#pragma unroll
    for (int i = 0; i < 32; ++i) wv[i] = W[(size_t)(k0 + 2 * i + (lane >> 5)) * ldw + col];
    if (gain) {
#pragma unroll
        for (int i = 0; i < 32; ++i) wv[i] *= gain[k0 + 2 * i + (lane >> 5)]; }
#pragma unroll
    for (int i = 0; i < 32; ++i) scr[(2 * i + (lane >> 5)) * 33 + (lane & 31)] = wv[i];
    asm volatile("s_waitcnt lgkmcnt(0)" ::: "memory");
    const int c = lane & 7;
#pragma unroll
    for (int j = 0; j < 4; ++j) { const int n = (lane >> 3) + 8 * j; const LAS float* s = scr + (8 * c) * 33 + n;
        u32x4 o; o.x = cvt_pk_bf16(s[0 * 33], s[1 * 33]); o.y = cvt_pk_bf16(s[2 * 33], s[3 * 33]); o.z = cvt_pk_bf16(s[4 * 33], s[5 * 33]); o.w = cvt_pk_bf16(s[6 * 33], s[7 * 33]);
        *(u32x4*)(WT + (size_t)(n0 + n) * ldwt + koff + k0 + 8 * c) = o; }
    asm volatile("s_waitcnt lgkmcnt(0)" ::: "memory");
}
__device__ __forceinline__ int zmap(int n) {
    const int tile = n >> 8, p = n & 255, bj = p >> 7, wc = (p >> 5) & 3, nn = (p >> 4) & 1, fq = (p >> 2) & 3, j = p & 3;
    if (tile < 8) return 256 * tile + 64 * (2 * bj + (wc >> 1)) + 32 * nn + 16 * (wc & 1) + 4 * fq + j;
    if (tile < 12) return 2048 + 256 * (tile - 8) + perm8(p);
    if (tile < 20) return (bj ? 4096 : 3072) + 128 * (tile - 12) + (perm8(p) & 127);
    if (tile < 24) return 5120 + 256 * (tile - 20) + perm8(p);
    return 6144 + 256 * (tile - 24) + perm8(p);
}
__device__ __forceinline__ void norm_row_bf16(const float* xrow, const float* g, bf16_t* orow, int lane) {
    f32x4 v[4]; float s = 0.f;
#pragma unroll
    for (int j = 0; j < 4; ++j) { v[j] = ((const f32x4*)xrow)[lane + 64 * j]; s += (v[j][0] * v[j][0] + v[j][1] * v[j][1]) + (v[j][2] * v[j][2] + v[j][3] * v[j][3]); }
    const float rstd = rsqrtf(wave_sum(s) * (1.0f / D) + EPS);
#pragma unroll
    for (int j = 0; j < 4; ++j) { const f32x4 gg = ((const f32x4*)g)[lane + 64 * j]; u32x2 w; w.x = cvt_pk_bf16(v[j][0] * rstd * gg[0], v[j][1] * rstd * gg[1]); w.y = cvt_pk_bf16(v[j][2] * rstd * gg[2], v[j][3] * rstd * gg[3]);
        ((u32x2*)orow)[lane + 64 * j] = w; }
}
__device__ __forceinline__ void sincos_acc(float ang, float& sn, float& cs) {
    const double a = (double)ang; const double q = __builtin_rint(a * 0.6366197723675814);
    const double t = __builtin_fma(-q, 1.5707963267948966, a) - q * 6.123233995736766e-17;
    const double t2 = t * t;
    double sp = -2.5052108385441720e-08; sp = sp * t2 + 2.7557319223985893e-06; sp = sp * t2 - 1.9841269841269841e-04; sp = sp * t2 + 8.3333333333333332e-03; sp = sp * t2 - 1.6666666666666666e-01; sp = sp * t2 * t + t;
    double cp = 2.0876756987868099e-09; cp = cp * t2 - 2.7557319223985888e-07; cp = cp * t2 + 2.4801587301587302e-05; cp = cp * t2 - 1.3888888888888889e-03; cp = cp * t2 + 4.1666666666666664e-02; cp = cp * t2 - 0.5; cp = cp * t2 + 1.0;
    const int qi = ((int)q) & 3;
    const double s_ = (qi & 1) ? cp : sp, c_ = (qi & 1) ? sp : cp;
    sn = (float)((qi & 2) ? -s_ : s_); cs = (float)(((qi == 1) || (qi == 2)) ? -c_ : c_);
}

constexpr int LDS_BYTES = 160 * 1024;
__global__ void __launch_bounds__(512, 2) mega_fwd(Args a) {
    extern __shared__ __attribute__((aligned(16))) unsigned char lds_raw[];
    LAS unsigned char* lds = (LAS unsigned char*)lds_raw;
    const int tid = threadIdx.x, lane = tid & 63, wave = __builtin_amdgcn_readfirstlane(tid >> 6);
    const int G = gridDim.x, bx = blockIdx.x;
    const int vcu = (G % 8 == 0) ? (bx % 8) * (G / 8) + bx / 8 : bx;
    const int gw = vcu * 8 + wave, NGW = G * 8;
#define kmean ((float*)(a.ws + CTL_KMEAN))
#define kamax ((unsigned*)(a.ws + CTL_KAMAX))
#define ssq1 ((float*)(a.ws + CTL_SSQ1))
#define ssq2 ((float*)(a.ws + CTL_SSQ2))
#define ssq3 ((float*)(a.ws + CTL_SSQ3))
#define WZ ((bf16_t*)(a.ws + WS_WZ))
#define WG ((bf16_t*)(a.ws + WS_WG))
#define WBR ((bf16_t*)(a.ws + WS_WBR))
#define WOUT ((bf16_t*)(a.ws + WS_WOUT))
#define WQ ((bf16_t*)(a.ws + WS_WQ))
#define WKV ((bf16_t*)(a.ws + WS_WKV))
#define WO ((bf16_t*)(a.ws + WS_WO))
#define WFI ((bf16_t*)(a.ws + WS_WFI))
#define WFO ((bf16_t*)(a.ws + WS_WFO))
#define RC ((float*)(a.ws + WS_RC))
#define RS ((float*)(a.ws + WS_RS))
#define MEMN ((bf16_t*)(a.ws + WS_MEMN))
#define KX ((bf16_t*)(a.ws + WS_KX))
#define VX ((bf16_t*)(a.ws + WS_VX))
#define E1 ((float*)(a.ws + WS_E1))
#define E2 ((float*)(a.ws + WS_E2))
#define XN ((bf16_t*)(a.ws + WS_XN))
#define HB XN
#define QP ((bf16_t*)(a.ws + WS_Q))
#define QX QP
#define QI ((bf16_t*)(a.ws + WS_QI))
#define OX QI
#define KI ((bf16_t*)(a.ws + WS_KI))
#define RAT KI
#define VB ((bf16_t*)(a.ws + WS_VB))
#define SGB VB
#define OG ((bf16_t*)(a.ws + WS_OG))
#define MG OG
#define ACT ((bf16_t*)(a.ws + WS_ACT))
#define KP ((bf16_t*)a.out)
#define VP ((bf16_t*)((unsigned char*)a.out + 64 * MiB))
#define H (a.out)
    cg::grid_group grid = cg::this_grid();
    const int lo = a.ph_lo, hi = a.ph_hi;
#ifndef PH_MASK
#define PH_MASK 0xfff
#endif
#define IN(k) (((PH_MASK >> (k)) & 1) && lo <= (k) && (k) < hi)
#define XBAR(word, count) do { asm volatile("s_waitcnt vmcnt(0)" ::: "memory"); __syncthreads(); \
        if (tid == 0) { unsigned* bw_ = (unsigned*)(a.ws + WS_CTL) + 64 * (word); __builtin_amdgcn_fence(__ATOMIC_RELEASE, "agent"); asm volatile("s_waitcnt vmcnt(0)" ::: "memory"); \
            __hip_atomic_fetch_add(bw_, 1u, __ATOMIC_RELAXED, __HIP_MEMORY_SCOPE_AGENT); \
            while (__hip_atomic_load(bw_, __ATOMIC_RELAXED, __HIP_MEMORY_SCOPE_AGENT) < (unsigned)(count)) __builtin_amdgcn_s_sleep(2); \
            __builtin_amdgcn_fence(__ATOMIC_ACQUIRE, "agent"); asm volatile("s_waitcnt vmcnt(0)" ::: "memory"); } \
        __syncthreads(); } while (0)
#define SEAM(k) do { if (IN(k) && IN((k) + 1)) { if (a.ph_lo < 0) grid.sync(); else XBAR(100 + (k), G); } } while (0)
#ifndef DUP_MASK
#define DUP_MASK 0
#endif
#define REPS(k) for (int rep_ = 0; rep_ < (((DUP_MASK >> (k)) & 1) ? 2 : 1); ++rep_)

    if (IN(0)) {
        LAS float* scr = (LAS float*)(lds + wave * 16384);
        constexpr int I_Z = 16 * (ZN / 32), I_G = 16 * 64, I_BR = 16 * 32, I_SQ = 16 * 32, I_KV = 16 * 64, I_FI = 16 * 176, I_FO = 44 * 32;
        constexpr int NITEMS = I_Z + I_G + 2 * I_BR + 3 * I_SQ + I_KV + I_FI + I_FO;
        for (int it = gw; it < NITEMS; it += NGW) {
            int r = it;
            if (r < I_Z) { wt_item(a.w_in, 9216, nullptr, WZ, 1024, 0, ZN / 32, r, scr, lane, [](int n) { return zmap(n); }); continue; } r -= I_Z;
            if (r < I_G) { wt_item(a.w_in, 9216, nullptr, WG, 1024, 0, 64, r, scr, lane, [](int n) { const int p = n & 255; return ((p >> 7) ? 8192 : 7168) + 128 * (n >> 8) + (perm8(p) & 127); }); continue; } r -= I_G;
            if (r < I_BR) { wt_item(a.w_bra, 1024, nullptr, WBR, 2048, 0, 32, r, scr, lane, [](int n) { return (n & ~255) + perm8(n & 255); }); continue; } r -= I_BR;
            if (r < I_BR) { wt_item(a.w_brh, 1024, nullptr, WBR, 2048, 1024, 32, r, scr, lane, [](int n) { return (n & ~255) + perm8(n & 255); }); continue; } r -= I_BR;
            if (r < I_SQ) { wt_item(a.w_out, 1024, nullptr, WOUT, 1024, 0, 32, r, scr, lane, [](int n) { return n; }); continue; } r -= I_SQ;
            if (r < I_SQ) { wt_item(a.wq, 1024, a.g_x, WQ, 1024, 0, 32, r, scr, lane, [](int n) { return (n & ~255) + perm8(n & 255); }); continue; } r -= I_SQ;
            if (r < I_SQ) { wt_item(a.wo, 1024, nullptr, WO, 1024, 0, 32, r, scr, lane, [](int n) { return n; }); continue; } r -= I_SQ;
            if (r < I_KV) { wt_item(a.wkv, 2048, nullptr, WKV, 1024, 0, 64, r, scr, lane, [](int n) { return (n & ~255) + perm8(n & 255); }); continue; } r -= I_KV;
            if (r < I_FI) { wt_item(a.w_ffi, 2 * FFN, a.g_ffn, WFI, 1024, 0, 176, r, scr, lane, [](int n) { const int p = n & 255; return ((p >> 7) ? FFN : 0) + 128 * (n >> 8) + (perm8(p) & 127); }); continue; } r -= I_FI;
            wt_item(a.w_ffo, 1024, nullptr, WFO, FFN, 0, 32, r, scr, lane, [](int n) { return n; });
        }
        for (int m = gw; m < T; m += 2 * NGW) {
            const int m2 = m + NGW; f32x4 v0[4], v1[4]; float s0 = 0.f, s1 = 0.f;
#pragma unroll
            for (int j = 0; j < 4; ++j) { v0[j] = ((const f32x4*)(a.x + (size_t)m * D))[lane + 64 * j]; v1[j] = ((const f32x4*)(a.x + (size_t)m2 * D))[lane + 64 * j]; }
#pragma unroll
            for (int j = 0; j < 4; ++j) { s0 += (v0[j][0] * v0[j][0] + v0[j][1] * v0[j][1]) + (v0[j][2] * v0[j][2] + v0[j][3] * v0[j][3]); s1 += (v1[j][0] * v1[j][0] + v1[j][1] * v1[j][1]) + (v1[j][2] * v1[j][2] + v1[j][3] * v1[j][3]); }
            const float r0 = rsqrtf(wave_sum(s0) * (1.0f / D) + EPS), r1 = rsqrtf(wave_sum(s1) * (1.0f / D) + EPS);
#pragma unroll
            for (int j = 0; j < 4; ++j) { const f32x4 gg = ((const f32x4*)a.g_mix)[lane + 64 * j]; const f32x4 a0 = v0[j] * r0 * gg, a1 = v1[j] * r1 * gg; u32x2 w0, w1;
                w0.x = cvt_pk_bf16(a0[0], a0[1]); w0.y = cvt_pk_bf16(a0[2], a0[3]); w1.x = cvt_pk_bf16(a1[0], a1[1]); w1.y = cvt_pk_bf16(a1[2], a1[3]);
                ((u32x2*)(XN + (size_t)m * D))[lane + 64 * j] = w0; ((u32x2*)(XN + (size_t)m2 * D))[lane + 64 * j] = w1; }
        }
        for (int m = gw; m < NB * NMEM; m += NGW) norm_row_bf16(a.mem + (size_t)m * D, a.g_mem, MEMN + (size_t)m * D, lane);
        for (int i = bx * 512 + tid; i < T * 32; i += G * 512) {
            const int tok = i >> 5, f = i & 31;
            const float inv = powf(10000.0f, -(float)(2 * f) * (1.0f / 64.0f));
            const float ang = (float)a.pos[tok] * inv;
            float sn, cs; sincos_acc(ang, sn, cs); RC[i] = cs; RS[i] = sn;
        }
    }
    SEAM(0);
    if (IN(1)) {

        const EpiZ Z{QP, KP, VP, QI, KI, VB, OG, E1, E2, RC, RS, kmean, kamax, a.lbl};
#define ZSEC(EPI, einit, tile0, ntile) { pg8::Gemm g{pg8::a_rowmajor(XN, D), WZ + (size_t)(tile0) * 256 * D, T, (ntile) * 256, D}; pg8::StaticOrder S; S.init(T, (ntile) * 256, G, bx); \
            const EPI E einit; pg8::gemm_phase<EPI, true>(lds, g, S, E); }
        ZSEC(EpiRope<false>, {Z}, 0, 4)
        ZSEC(EpiRope<true>, {Z}, 4, 4)
        ZSEC(EpiPlane<false>, ({Z, VP}), 8, 4)
        ZSEC(EpiQF, {Z}, 12, 8)
        ZSEC(EpiPlane<false>, ({Z, VB}), 20, 4)
        ZSEC(EpiPlane<true>, ({Z, OG}), 24, 4)
    #if (DUP_MASK >> 1) & 1
        ZSEC(EpiRope<false>, {Z}, 0, 4)
        ZSEC(EpiRope<true>, {Z}, 4, 4)
        ZSEC(EpiPlane<false>, ({Z, VP}), 8, 4)
        ZSEC(EpiQF, {Z}, 12, 8)
        ZSEC(EpiPlane<false>, ({Z, VB}), 20, 4)
        ZSEC(EpiPlane<true>, ({Z, OG}), 24, 4)
    #endif
#undef ZSEC
    }
    SEAM(1);
    if (IN(2)) {
        for (int it = bx; it < NB * BH * hg::NSEG; it += G) hgrn_seg_a(lds, it / (BH * hg::NSEG), (it / hg::NSEG) % BH, it % hg::NSEG, QI, KI, VB, E1, E2);
        XBAR(120, G);
        for (int it = bx; it < NB * BH * hg::NSEG; it += G) hgrn_seg_b(lds, it / (BH * hg::NSEG), (it / hg::NSEG) % BH, it % hg::NSEG, QI, KI, VB, OG, E1, E2, a.g_hgrn);
        {
            unsigned* ctl = (unsigned*)(a.ws + WS_CTL);
            unsigned* gcnt = ctl + 4096;
            bf16_t* PO = (bf16_t*)(a.ws + mb::WS_PO); float* PL = (float*)(a.ws + mb::WS_PL); unsigned short* GL = (unsigned short*)(a.ws + mb::WS_LIST);
            const int nmb = G, mbi = bx;
#define MB_QUEUE(total, ...) do { for (int r_ = 0;; ++r_) { const int k = r_ * nmb + ((r_ & 1) ? nmb - 1 - mbi : mbi); if (r_ * nmb >= (total)) break; if (k < (total)) { __VA_ARGS__ } } } while (0)
            if (bx < 32) { __syncthreads(); pg8::Gemm g{pg8::a_rowmajor(MEMN, D), WKV, NB * NMEM, 2 * D, D}; pg8::StaticOrder S; S.init(NB * NMEM, 2 * D, 32, bx);
                EpiKV E{KX, VX};
                pg8::gemm_phase<EpiKV, true>(lds, g, S, E); }
            { const int n1 = G - 32, head = 3 * n1;
              if (bx >= 32) for (int r_ = 0; r_ < 3; ++r_) { const int k = r_ * n1 + ((r_ & 1) ? n1 - 1 - (bx - 32) : bx - 32);
                  moba_gate_item(lds, k & 63, k & 63, 31 - (k >> 6), QP, kmean, gcnt, GL); }
              for (int r_ = 0; head + r_ * G < 64 * 31; ++r_) { const int k = head + r_ * G + ((r_ & 1) ? G - 1 - bx : bx);
                  if (k < 64 * 31) moba_gate_item(lds, k & 63, k & 63, 31 - (k >> 6), QP, kmean, gcnt, GL); } }
            XBAR(121, G);
            LAS int* pfx = (LAS int*)(lds + LDS_BYTES - 12288);
            { __syncthreads();
              int v4[4], v = 0;
#pragma unroll
              for (int q4 = 0; q4 < 4; ++q4) { const int i = 4 * tid + q4; v4[q4] = (int)((gcnt[(i & 63) * 32 + (i >> 6)] + 511u) >> 9); v += v4[q4]; }
              const int mine = v;
#pragma unroll
              for (int o = 1; o < 64; o <<= 1) { const int t_ = __shfl_up(v, o); if (lane >= o) v += t_; }
              LAS int* wtot = pfx + 2048;
              if (lane == 63) wtot[wave] = v;
              __syncthreads();
              int add = v - mine;
#pragma unroll
              for (int w_ = 0; w_ < 8; ++w_) add += (w_ < wave) ? wtot[w_] : 0;
#pragma unroll
              for (int q4 = 0; q4 < 4; ++q4) { add += v4[q4]; pfx[4 * tid + q4] = add; }
              __syncthreads(); }
            const int nitems = pfx[2047];
            moba_part_phase(lds, pfx, nitems, mbi, nmb, QP, KP, VP, kamax, gcnt, GL, PO, PL);
            XBAR(122, G);
            MB_QUEUE(64 * 32, {
                const int bh = k & 63, qb = 31 - (k >> 6);
                moba_comb_item(lds, bh, bh, qb, QP, KP, VP, kamax, PO, PL); });
#undef MB_QUEUE
        }
    }
    SEAM(2);
    if (IN(3)) {
        pg8::Gemm g{pg8::a_rowmajor(XN, D), WG, T, 2 * D, D}; pg8::PairOrder S; S.base.init(T, D, G, bx);
        EpiGate E{RAT, SGB};
        pg8::gemm_phase<EpiGate, true, pg8::PairOrder>(lds, g, S, E);
        asm volatile("s_waitcnt vmcnt(0)" ::: "memory"); __syncthreads();
    }
    if (IN(4)) {
        {
        pg8::AView av; av.b0 = (const char*)QP; av.b1 = (const char*)QI - 16 * MiB; av.tsplit = 16; av.bstride = 16 * MiB; av.tstride = 256 * 64 * 2; av.kstride = 1 * MiB; av.lda = 64;
        pg8::Gemm g{av, WBR, T, D, 2 * D}; pg8::StaticOrder S; S.init(T, D, G, bx);
        EpiMerged E{RAT, SGB, MG};
        pg8::gemm_phase<EpiMerged, true>(lds, g, S, E);
            }
#if (DUP_MASK >> 4) & 1
        {
        pg8::AView av; av.b0 = (const char*)QP; av.b1 = (const char*)QI - 16 * MiB; av.tsplit = 16; av.bstride = 16 * MiB; av.tstride = 256 * 64 * 2; av.kstride = 1 * MiB; av.lda = 64;
        pg8::Gemm g{av, WBR, T, D, 2 * D}; pg8::StaticOrder S; S.init(T, D, G, bx);
        EpiMerged E{RAT, SGB, MG};
        pg8::gemm_phase<EpiMerged, true>(lds, g, S, E);
            }
#endif
    }
    SEAM(4);
    if (IN(5)) {
        pg8::Gemm g{pg8::a_rowmajor(MG, D), WOUT, T, D, D}; pg8::StaticOrder S; S.init(T, D, G, bx);
        EpiRes<false> E{a.x, HB, ssq1};
        pg8::gemm_phase<EpiRes<false>, true>(lds, g, S, E);
    }
    SEAM(5);
    if (IN(6)) {
        {
        pg8::Gemm g{pg8::a_rowmajor(HB, D), WQ, T, D, D}; pg8::StaticOrder S; S.init(T, D, G, bx);
        EpiScaleRow E{ssq1, QX, XSCALE};
        pg8::gemm_phase<EpiScaleRow, true>(lds, g, S, E);
#if STAGE_XATTN
        asm volatile("s_waitcnt vmcnt(0)" ::: "memory"); __syncthreads();
        { pg8::Unit u; for (int i = 0; S.next(i, u); ++i) xattn_unit(lds, u.pm >> 5, u.pn, 256 * u.pm, QX, KX, VX, OX); }
#endif
            }
#if (DUP_MASK >> 6) & 1
        {
        pg8::Gemm g{pg8::a_rowmajor(HB, D), WQ, T, D, D}; pg8::StaticOrder S; S.init(T, D, G, bx);
        EpiScaleRow E{ssq1, QX, XSCALE};
        pg8::gemm_phase<EpiScaleRow, true>(lds, g, S, E);
#if STAGE_XATTN
        asm volatile("s_waitcnt vmcnt(0)" ::: "memory"); __syncthreads();
        { pg8::Unit u; for (int i = 0; S.next(i, u); ++i) xattn_unit(lds, u.pm >> 5, u.pn, 256 * u.pm, QX, KX, VX, OX); }
#endif
            }
#endif
    }
#if !STAGE_XATTN
    SEAM(6);
#endif
    if (IN(7)) {
#if STAGE_XATTN
#else
        LAS float* qsh = (LAS float*)(lds + wave * 2048); LAS float* psh = qsh + 256;
        for (int it = gw; it < T * XH; it += NGW) {
            const int tok = it >> 2, hx = it & 3, b = tok >> 13;
            { const u32x2 w = *(const u32x2*)(QX + (size_t)tok * D + hx * 256 + 4 * lane); qsh[4 * lane] = bflo(w.x); qsh[4 * lane + 1] = bfhi(w.x); qsh[4 * lane + 2] = bflo(w.y); qsh[4 * lane + 3] = bfhi(w.y); }
            asm volatile("s_waitcnt lgkmcnt(0)" ::: "memory");
            const bf16_t* kb = KX + (size_t)(b * 4 + hx) * 256 * 256; const bf16_t* vb = VX + (size_t)(b * 4 + hx) * 256 * 256;
            float sc[4]; float mx = -INFINITY;
#pragma unroll
            for (int i = 0; i < 4; ++i) { const u32x4* kr = (const u32x4*)(kb + (size_t)(lane + 64 * i) * 256); float s_ = 0.f;
#pragma unroll 2
                for (int c = 0; c < 32; ++c) { const u32x4 w = kr[c]; f32x4 x0, x1; unpack8(w, x0, x1);
#pragma unroll
                    for (int e = 0; e < 4; ++e) s_ += x0[e] * qsh[8 * c + e] + x1[e] * qsh[8 * c + 4 + e]; }
                sc[i] = s_; mx = fmaxf(mx, s_); }
            mx = wave_max(mx); float lsum = 0.f;
#pragma unroll
            for (int i = 0; i < 4; ++i) { const float p = exp2f(sc[i] - mx); psh[lane + 64 * i] = p; lsum += p; }
            lsum = wave_sum(lsum);
            asm volatile("s_waitcnt lgkmcnt(0)" ::: "memory");
            f32x4 ov = {0.f, 0.f, 0.f, 0.f};
#pragma unroll 4
            for (int m = 0; m < 256; ++m) { const u32x2 w = *(const u32x2*)(vb + (size_t)m * 256 + 4 * lane); const float p = psh[m]; ov[0] += p * bflo(w.x); ov[1] += p * bfhi(w.x); ov[2] += p * bflo(w.y); ov[3] += p * bfhi(w.y); }
            const float rl = 1.0f / lsum; u32x2 w; w.x = cvt_pk_bf16(ov[0] * rl, ov[1] * rl); w.y = cvt_pk_bf16(ov[2] * rl, ov[3] * rl);
            *(u32x2*)(OX + (size_t)tok * D + hx * 256 + 4 * lane) = w;
        }
#endif
    }
    SEAM(7);
    if (IN(8)) {
        pg8::Gemm g{pg8::a_rowmajor(OX, D), WO, T, D, D}; pg8::StaticOrder S; S.init(T, D, G, bx);
        EpiRes<true> E{HB, HB, ssq2};
        pg8::gemm_phase<EpiRes<true>, true>(lds, g, S, E);
    }
    SEAM(8);
    if (IN(9)) {
        pg8::Gemm g{pg8::a_rowmajor(HB, D), WFI, T, 2 * FFN, D}; pg8::StaticOrder S; S.init(T, 2 * FFN, G, bx);
        EpiSwiglu E{ssq2, ACT};
        pg8::gemm_phase<EpiSwiglu, true>(lds, g, S, E);
    }
    SEAM(9);
    if (IN(10)) {
        pg8::Gemm g{pg8::a_rowmajor(ACT, FFN), WFO, T, D, FFN}; pg8::StaticOrder S; S.init(T, D, G, bx);
        EpiRes<true> E{HB, HB, ssq3};
        pg8::gemm_phase<EpiRes<true>, true>(lds, g, S, E);
    }
    SEAM(10);
    if (IN(11)) {
        f32x4 gg[4];
#pragma unroll
        for (int j = 0; j < 4; ++j) gg[j] = ((const f32x4*)a.g_fin)[lane + 64 * j];
        for (int m0 = gw; m0 < T; m0 += 4 * NGW) {
            u32x2 hw[4][4]; float rs[4];
#pragma unroll
            for (int q = 0; q < 4; ++q) { const int m = m0 + q * NGW; const u32x2* hrow = (const u32x2*)(HB + (size_t)m * D);
#pragma unroll
                for (int j = 0; j < 4; ++j) hw[q][j] = hrow[lane + 64 * j];
                rs[q] = ssq3[m]; }
#pragma unroll
            for (int q = 0; q < 4; ++q) { const int m = m0 + q * NGW; const float rstd = rsqrtf(rs[q] * (1.0f / D) + EPS); f32x4* row = (f32x4*)(a.out + (size_t)m * D);
#pragma unroll
                for (int j = 0; j < 4; ++j) { const u32x2 w = hw[q][j]; row[lane + 64 * j] = (f32x4){bflo(w.x), bfhi(w.x), bflo(w.y), bfhi(w.y)} * rstd * gg[j]; } }
        }
    }
#undef IN
#undef SEAM
}
#undef kmean
#undef kamax
#undef ssq1
#undef ssq2
#undef ssq3
#undef WZ
#undef WG
#undef WBR
#undef WOUT
#undef WQ
#undef WKV
#undef WO
#undef WFI
#undef WFO
#undef RC
#undef RS
#undef MEMN
#undef KX
#undef VX
#undef E1
#undef E2
#undef XN
#undef HB
#undef QP
#undef QX
#undef QI
#undef OX
#undef KI
#undef RAT
#undef VB
#undef SGB
#undef OG
#undef MG
#undef ACT
#undef KP
#undef VP
#undef H

constexpr int N_PHASES = 12;
extern "C" void kernel_launch(void* const* d_in, const int* in_sizes, int n_in, void* d_out, int out_size, void* d_ws, size_t ws_size, hipStream_t stream) {
    static int grid = 0;
    if (grid == 0) {
        if (n_in != 19 || in_sizes[0] != T * D || out_size != T * D || ws_size < WS_END) { fprintf(stderr, "kernel_launch: unexpected shapes (n_in %d, in0 %d, out %d, ws %zu)\n", n_in, n_in > 0 ? in_sizes[0] : -1, out_size, ws_size); grid = -1; return; }
        int dev = 0, cus = 0, per_cu = 0;
        hipGetDevice(&dev); hipDeviceGetAttribute(&cus, hipDeviceAttributeMultiprocessorCount, dev);
        hipFuncSetAttribute((const void*)mega_fwd, hipFuncAttributeMaxDynamicSharedMemorySize, LDS_BYTES);
        if (hipOccupancyMaxActiveBlocksPerMultiprocessor(&per_cu, (const void*)mega_fwd, 512, LDS_BYTES) != hipSuccess || per_cu < 1) { fprintf(stderr, "kernel_launch: occupancy query says %d blocks/CU\n", per_cu); per_cu = 1; }
        (void)hipGetLastError();
        grid = cus;
    }
    if (grid < 0) return;
    hipMemsetAsync((char*)d_ws + WS_CTL, 0, CTL_ZERO_BYTES, stream);
    Args a{};
    a.x = (const float*)d_in[0]; a.mem = (const float*)d_in[1]; a.pos = (const int*)d_in[2]; a.g_mix = (const float*)d_in[3]; a.w_in = (const float*)d_in[4]; a.lbl = (const float*)d_in[5];
    a.g_hgrn = (const float*)d_in[6]; a.w_bra = (const float*)d_in[7]; a.w_brh = (const float*)d_in[8]; a.w_out = (const float*)d_in[9]; a.g_x = (const float*)d_in[10]; a.g_mem = (const float*)d_in[11];
    a.wq = (const float*)d_in[12]; a.wkv = (const float*)d_in[13]; a.wo = (const float*)d_in[14]; a.g_ffn = (const float*)d_in[15]; a.w_ffi = (const float*)d_in[16]; a.w_ffo = (const float*)d_in[17]; a.g_fin = (const float*)d_in[18];
    a.out = (float*)d_out; a.ws = (unsigned char*)d_ws;
#if MK_N_LAUNCHES == 1
    a.ph_lo = 0; a.ph_hi = N_PHASES;
    void* args[] = {&a};
    hipError_t e = hipLaunchCooperativeKernel((const void*)mega_fwd, dim3(grid), dim3(512), args, LDS_BYTES, stream);
    if (e != hipSuccess) fprintf(stderr, "cooperative launch failed: %s (grid %d)\n", hipGetErrorString(e), grid);
#else
    for (int p = 0; p < N_PHASES; ++p) { a.ph_lo = p; a.ph_hi = p + 1; hipLaunchKernelGGL(mega_fwd, dim3(grid), dim3(512), LDS_BYTES, stream, a); }
#endif
}
```

```cpp
#include <hip/hip_runtime.h>
#include <hip/hip_cooperative_groups.h>
#include <cstdio>
#include <cstdint>
namespace cg = cooperative_groups;

#ifndef MK_N_LAUNCHES
#define MK_N_LAUNCHES 1
#endif

#ifndef STAGE_HGRN
#define STAGE_HGRN 1
#endif
#ifndef STAGE_MOBA
#define STAGE_MOBA 1
#endif
#ifndef STAGE_XATTN
#define STAGE_XATTN 1
#endif
#define LAS __attribute__((address_space(3)))
typedef unsigned short bf16_t;
typedef short bf16x8 __attribute__((ext_vector_type(8)));
typedef float f32x4 __attribute__((ext_vector_type(4)));
typedef float f32x2 __attribute__((ext_vector_type(2)));
typedef unsigned u32x4 __attribute__((ext_vector_type(4)));
typedef unsigned u32x2 __attribute__((ext_vector_type(2)));

constexpr int NB = 4, SEQ = 8192, T = NB * SEQ, D = 1024;
constexpr int AH = 16, AHD = 64, NBLK = 32;
constexpr int BH = 8, BDK = 128, BDV = 128, NCH = SEQ / 64;
constexpr int XH = 4, XHD = 256, NMEM = 256;
constexpr int FFN = 2816;
constexpr int ZN = 7168;
constexpr float EPS = 1e-6f;
constexpr float LOG2E = 1.4426950408889634f;
constexpr float QSCALE = 0.125f * LOG2E;
constexpr float XSCALE = 0.0625f * LOG2E;
constexpr float DKS = 0.08838834764831845f;

constexpr size_t MiB = 1u << 20;
constexpr size_t WS_CTL = 0, CTL_ZERO_BYTES = 2 * MiB;
constexpr size_t CTL_KMEAN = 64 * 1024;
constexpr size_t CTL_KAMAX = CTL_KMEAN + 512 * 1024;
constexpr size_t CTL_SSQ1 = 1 * MiB, CTL_SSQ2 = CTL_SSQ1 + 128 * 1024, CTL_SSQ3 = CTL_SSQ2 + 128 * 1024;
constexpr size_t WS_WZ = 4 * MiB, WS_WG = 18 * MiB, WS_WBR = 22 * MiB, WS_WOUT = 26 * MiB, WS_WQ = 28 * MiB, WS_WKV = 30 * MiB, WS_WO = 34 * MiB, WS_WFI = 36 * MiB, WS_WFO = 47 * MiB;
constexpr size_t WS_RC = 53 * MiB, WS_RS = 57 * MiB, WS_MEMN = 61 * MiB, WS_KX = 63 * MiB, WS_VX = 65 * MiB, WS_E1 = 67 * MiB, WS_E2 = 69 * MiB;
constexpr size_t WS_XN = 72 * MiB;
constexpr size_t WS_Q = 136 * MiB;
constexpr size_t WS_QI = 200 * MiB;
constexpr size_t WS_KI = 264 * MiB;
constexpr size_t WS_VB = 328 * MiB;
constexpr size_t WS_OG = 392 * MiB;
constexpr size_t WS_ACT = 264 * MiB;
constexpr size_t WS_END = 512 * MiB;

typedef __bf16 bf16x2_t __attribute__((ext_vector_type(2)));
__device__ __forceinline__ unsigned cvt_pk_bf16(float lo, float hi) { const f32x2 v = {lo, hi}; const bf16x2_t b = __builtin_convertvector(v, bf16x2_t); return __builtin_bit_cast(unsigned, b); }
__device__ __forceinline__ float bf2f(bf16_t h) { return __uint_as_float(((unsigned)h) << 16); }
__device__ __forceinline__ float bflo(unsigned w) { return __uint_as_float(w << 16); }
__device__ __forceinline__ float bfhi(unsigned w) { return __uint_as_float(w & 0xffff0000u); }
__device__ __forceinline__ bf16_t f2bf(float f) { return (bf16_t)(cvt_pk_bf16(f, 0.f) & 0xffffu); }
__device__ __forceinline__ float sigmoidf_(float x) { return __builtin_amdgcn_rcpf(1.0f + __expf(-x)); }
__device__ __forceinline__ float wave_sum(float v) {
#pragma unroll
    for (int o = 1; o < 64; o <<= 1) v += __shfl_xor(v, o);
    return v;
}
__device__ __forceinline__ float wave_max(float v) {
#pragma unroll
    for (int o = 1; o < 64; o <<= 1) v = fmaxf(v, __shfl_xor(v, o));
    return v;
}
__device__ __forceinline__ u32x4 pack8(const f32x4& a, const f32x4& b) { u32x4 w; w.x = cvt_pk_bf16(a[0], a[1]); w.y = cvt_pk_bf16(a[2], a[3]); w.z = cvt_pk_bf16(b[0], b[1]); w.w = cvt_pk_bf16(b[2], b[3]); return w; }
__device__ __forceinline__ void unpack8(const u32x4& w, f32x4& a, f32x4& b) { a = (f32x4){bflo(w.x), bfhi(w.x), bflo(w.y), bfhi(w.y)}; b = (f32x4){bflo(w.z), bfhi(w.z), bflo(w.w), bfhi(w.w)}; }

namespace pg8 {
constexpr int BM = 256, BK = 64, HALF = 128, HTB = HALF * BK * 2, STAGE_BYTES = 8 * HTB, NXCD = 8, WGM = 8;
__host__ __device__ __forceinline__ int lds_byte(int r, int c) { const int st = (r >> 4) * 2 + (c >> 5), rr = r & 15, cc = c & 31, ob = rr * 64 + cc * 2; return st * 1024 + (ob ^ (((ob >> 9) & 1) << 5)); }
__host__ __device__ __forceinline__ void stage_rc(int b, int& R, int& C) { const int st = b / 1024, sb = b % 1024, swz = sb ^ (((sb >> 9) & 1) << 5); R = (st >> 1) * 16 + swz / 64; C = (st & 1) * 32 + (swz % 64) / 2; }
struct Unit { int pm, pn; };
struct AView {
    const char* b0; const char* b1; int tsplit; long bstride, tstride, kstride; int lda;
    __device__ __forceinline__ const char* ptr(int pm, int t) const { return (t < tsplit ? b0 : b1) + (long)(pm >> 5) * bstride + (long)(pm & 31) * tstride + (long)t * kstride; }
};
__device__ __forceinline__ AView a_rowmajor(const void* A, int lda) { AView v; v.b0 = (const char*)A; v.b1 = (const char*)A; v.tsplit = 1 << 30; v.tstride = (long)256 * lda * 2; v.bstride = 32 * v.tstride; v.kstride = 128; v.lda = lda; return v; }
struct Gemm { AView A; const bf16_t* Bt; int M, N, K; };
struct StaticOrder {
    int nM, nN, nwg, G, c;
    __device__ void init(int M, int N, int G_, int c_) { nM = M / BM; nN = N / BM; nwg = nM * nN; G = G_; c = c_; }
    __device__ bool next(int i, Unit& u) const {
        const long L = (long)i * G + c; if (L >= nwg) return false;
        int wgid = (int)L; { const int q = nwg / NXCD, r = nwg % NXCD, xcd = wgid % NXCD, off = wgid / NXCD; wgid = (xcd < r ? xcd * (q + 1) : r * (q + 1) + (xcd - r) * q) + off; }
        const int nig = WGM * nN, gid = wgid / nig, fm = gid * WGM, gsz = (nM - fm) < WGM ? (nM - fm) : WGM;
        u.pm = fm + ((wgid % nig) % gsz); u.pn = (wgid % nig) / gsz; return true;
    }
};
__device__ __forceinline__ int so_unit(int nM, int nN, int G, int c, int i) {
    const int nwg = nM * nN; const long L = (long)i * G + c; if (L >= nwg) return -1;
    int wgid = (int)L; { const int q = nwg / NXCD, r = nwg % NXCD, xcd = wgid % NXCD, off = wgid / NXCD; wgid = (xcd < r ? xcd * (q + 1) : r * (q + 1) + (xcd - r) * q) + off; }
    const int nig = WGM * nN, gid = wgid / nig, fm = gid * WGM, gsz = (nM - fm) < WGM ? (nM - fm) : WGM;
    return ((fm + ((wgid % nig) % gsz)) << 16) | ((wgid % nig) / gsz);
}
struct PairOrder { StaticOrder base;
    __device__ bool next(int i, Unit& u) const { Unit v; if (!base.next(i >> 1, v)) return false; u.pm = v.pm; u.pn = 2 * v.pn + (i & 1); return true; } };
template <class Epi, bool ALIGN_EPI, class Sched = StaticOrder>
__device__ __forceinline__ void gemm_phase(LAS unsigned char* lds, const Gemm g, const Sched& S, const Epi& E) {
    const int tid = threadIdx.x, wid = __builtin_amdgcn_readfirstlane(tid >> 6), lane = tid & 63, wr = wid >> 2, wc = wid & 3, fr = lane & 15, fq = lane >> 4;
    const int K = g.K, nt = K / BK;
    unsigned voffA[2], voffB[2];
#pragma unroll
    for (int i = 0; i < 2; ++i) { int R, C; stage_rc(tid * 16 + i * 8192, R, C); voffA[i] = (unsigned)(R * g.A.lda + C) * 2u; voffB[i] = (unsigned)(R * K + C) * 2u; }
    const size_t hstepA = (size_t)HALF * g.A.lda * 2, hstepB = (size_t)HALF * K * 2, tstepB = 2 * hstepB, kstep = 128;
    const unsigned ldsw = (unsigned)wid * 1024u;
    const int aoff = lds_byte(wr * 64 + fr, fq * 8), boff = lds_byte(wc * 32 + fr, fq * 8);
#define PG8_SA(b, h) (((b) * 2 + (h)) * HTB)
#define PG8_SB(b, h) ((4 + (b) * 2 + (h)) * HTB)
#define PG8_STAGE(bufoff, gbase, voff) do { _Pragma("unroll") for (int _i = 0; _i < 2; ++_i) \
        __builtin_amdgcn_global_load_lds((const unsigned*)((const char*)(gbase) + (voff)[_i]), (LAS unsigned*)(lds + (bufoff) + ldsw + _i * 8192), 16, 0, 0); } while (0)
#define PG8_LDA(dst, b, h) do { _Pragma("unroll") for (int m = 0; m < 4; ++m) _Pragma("unroll") for (int k = 0; k < 2; ++k) dst[m][k] = *(const LAS bf16x8*)(lds + PG8_SA(b, h) + aoff + m * 2048 + k * 1024); } while (0)
#define PG8_LDB(dst, b, h) do { _Pragma("unroll") for (int n = 0; n < 2; ++n) _Pragma("unroll") for (int k = 0; k < 2; ++k) dst[n][k] = *(const LAS bf16x8*)(lds + PG8_SB(b, h) + boff + n * 2048 + k * 1024); } while (0)
#define PG8_MMA(ai, bj, At, Bt) do { __builtin_amdgcn_s_setprio(1); _Pragma("unroll") for (int m = 0; m < 4; ++m) _Pragma("unroll") for (int n = 0; n < 2; ++n) _Pragma("unroll") for (int k = 0; k < 2; ++k) \
        acc[ai][bj][m][n] = __builtin_amdgcn_mfma_f32_16x16x32_bf16(Bt[n][k], At[m][k], acc[ai][bj][m][n], 0, 0, 0); __builtin_amdgcn_s_setprio(0); } while (0)
#define PG8_WAIT_V(n) asm volatile("s_waitcnt vmcnt(" #n ")" ::: "memory")
#define PG8_WAIT_L(n) asm volatile("s_waitcnt lgkmcnt(" #n ")" ::: "memory")
#define PG8_BAR __builtin_amdgcn_s_barrier()
#define PG8_SCHED __builtin_amdgcn_sched_barrier(0)
    Unit cur, nxt; int ui = 0;
    if (!S.next(0, cur)) return;
    f32x4 acc[2][2][4][2];
#pragma unroll
    for (int a = 0; a < 2; ++a)
#pragma unroll
        for (int b = 0; b < 2; ++b)
#pragma unroll
            for (int m = 0; m < 4; ++m)
#pragma unroll
                for (int n = 0; n < 2; ++n) acc[a][b][m][n] = (f32x4){0.f, 0.f, 0.f, 0.f};
    bf16x8 At[4][2], B0[2][2], B1[2][2];
    const char* cB = (const char*)g.Bt + (size_t)cur.pn * tstepB;
    {
        const char* cA = g.A.ptr(cur.pm, 0); const char* cA1 = g.A.ptr(cur.pm, 1);
        PG8_STAGE(PG8_SB(0, 0), cB, voffB); PG8_STAGE(PG8_SB(0, 1), cB + hstepB, voffB); PG8_STAGE(PG8_SA(0, 0), cA, voffA); PG8_STAGE(PG8_SA(0, 1), cA + hstepA, voffA);
        if (wr == 1) PG8_BAR;
        PG8_WAIT_V(2); PG8_BAR;
        PG8_STAGE(PG8_SB(1, 0), cB + kstep, voffB); PG8_STAGE(PG8_SA(1, 0), cA1, voffA); PG8_STAGE(PG8_SB(1, 1), cB + hstepB + kstep, voffB);
        PG8_WAIT_V(6); PG8_BAR;
    }
    for (;;) {
        const bool has_next = S.next(ui + 1, nxt);
        const int npm = has_next ? nxt.pm : cur.pm;
        const char* nB = has_next ? (const char*)g.Bt + (size_t)nxt.pn * tstepB : cB;
        for (int t = 0; t < nt; t += 2) {
            const bool last = (t == nt - 2);
            if constexpr (Epi::MID) { if (t == (nt >> 1)) E.mid(acc, cur, wr, wc, fr, fq); }
            const char* a1 = g.A.ptr(cur.pm, t + 1);
            const char* a2 = last ? g.A.ptr(npm, 0) : g.A.ptr(cur.pm, t + 2);
            const char* a3 = last ? g.A.ptr(npm, 1) : g.A.ptr(cur.pm, t + 3);
            const char* b2 = last ? nB : cB + (size_t)(t + 2) * kstep;
            const char* b3 = b2 + kstep;
            PG8_LDB(B0, 0, 0); PG8_LDB(B1, 0, 1); PG8_SCHED; PG8_LDA(At, 0, 0); PG8_STAGE(PG8_SA(1, 1), a1 + hstepA, voffA);
            PG8_WAIT_V(8); PG8_WAIT_L(0); PG8_BAR; PG8_MMA(0, 0, At, B0); PG8_MMA(0, 1, At, B1); PG8_BAR; PG8_SCHED;
            PG8_LDA(At, 0, 1); PG8_STAGE(PG8_SB(0, 0), b2, voffB); PG8_STAGE(PG8_SB(0, 1), b2 + hstepB, voffB); PG8_STAGE(PG8_SA(0, 0), a2, voffA);
            PG8_WAIT_V(8); PG8_WAIT_L(0); PG8_BAR; PG8_MMA(1, 0, At, B0); PG8_MMA(1, 1, At, B1); PG8_BAR; PG8_SCHED;
            PG8_LDB(B0, 1, 0); PG8_LDB(B1, 1, 1); PG8_SCHED; PG8_LDA(At, 1, 0); PG8_STAGE(PG8_SA(0, 1), a2 + hstepA, voffA);
            PG8_WAIT_V(8); PG8_WAIT_L(0); PG8_BAR; PG8_MMA(0, 0, At, B0); PG8_MMA(0, 1, At, B1); PG8_BAR; PG8_SCHED;
            PG8_LDA(At, 1, 1); PG8_STAGE(PG8_SB(1, 0), b3, voffB); PG8_STAGE(PG8_SB(1, 1), b3 + hstepB, voffB); PG8_STAGE(PG8_SA(1, 0), a3, voffA);
            PG8_WAIT_V(8); PG8_WAIT_L(0); PG8_BAR; PG8_MMA(1, 0, At, B0); PG8_MMA(1, 1, At, B1); PG8_BAR; PG8_SCHED;
        }
        if constexpr (ALIGN_EPI) { if (wr == 0) PG8_BAR; }
        E(acc, cur, wr, wc, fr, fq);
        if (!has_next) break;
#pragma unroll
        for (int a = 0; a < 2; ++a)
#pragma unroll
            for (int b = 0; b < 2; ++b)
#pragma unroll
                for (int m = 0; m < 4; ++m)
#pragma unroll
                    for (int n = 0; n < 2; ++n) acc[a][b][m][n] = (f32x4){0.f, 0.f, 0.f, 0.f};
        cur = nxt; cB = nB; ++ui;
        if constexpr (ALIGN_EPI) { if (wr == 1) PG8_BAR; }
    }
    PG8_WAIT_V(0);
    if constexpr (!ALIGN_EPI) { if (wr == 0) PG8_BAR; }
    PG8_BAR;
#undef PG8_SA
#undef PG8_SB
#undef PG8_STAGE
#undef PG8_LDA
#undef PG8_LDB
#undef PG8_MMA
#undef PG8_WAIT_V
#undef PG8_WAIT_L
#undef PG8_BAR
#undef PG8_SCHED
}
}
typedef f32x4 Acc[2][2][4][2];

__host__ __device__ __forceinline__ int perm8(int p) { return (p & ~31) | (((p >> 2) & 3) << 3) | (((p >> 4) & 1) << 2) | (p & 3); }

struct EpiZ {
    static constexpr bool MID = false;
    bf16_t *Q, *Kp, *Vp, *QI, *KI, *VB, *OG; float *E1, *E2; const float *rc, *rs; float* kmean; unsigned* kamax; const float* lbl;
    __device__ __forceinline__ void mid(Acc&, const pg8::Unit&, int, int, int, int) const {}
    template <bool ISK> __device__ __forceinline__ void rope_sec(bf16_t* dst, const Acc& acc, const pg8::Unit& u, int wr, int wc, int fr, int fq) const {
        const int pn = u.pn, b = u.pm >> 5, s0 = (u.pm & 31) * 256;
        const int dlo = 16 * (wc & 1) + 4 * fq;
#pragma unroll
        for (int bj = 0; bj < 2; ++bj) {
            const int plane = b * 16 + 4 * (pn & 3) + 2 * bj + (wc >> 1);
            f32x4 slo = {0.f, 0.f, 0.f, 0.f}, shi = {0.f, 0.f, 0.f, 0.f}; float amax = 0.f;
#pragma unroll
            for (int ai = 0; ai < 2; ++ai)
#pragma unroll
                for (int m = 0; m < 4; ++m) {
                    const int s = s0 + 128 * ai + 64 * wr + 16 * m + fr; const size_t tok = (size_t)b * SEQ + s;
                    const f32x4 c4 = *(const f32x4*)(rc + tok * 32 + dlo), s4 = *(const f32x4*)(rs + tok * 32 + dlo);
                    const f32x4 lo = acc[ai][bj][m][0], hi = acc[ai][bj][m][1];
                    f32x4 olo = lo * c4 - hi * s4, ohi = hi * c4 + lo * s4;
                    if (!ISK) { olo = olo * QSCALE; ohi = ohi * QSCALE; }
                    else { slo += olo; shi += ohi;
#pragma unroll
                        for (int j = 0; j < 4; ++j) amax = fmaxf(amax, fmaxf(fabsf(olo[j]), fabsf(ohi[j]))); }
                    bf16_t* p = dst + ((size_t)plane * SEQ + s) * 64 + dlo;
                    u32x2 w0, w1; w0.x = cvt_pk_bf16(olo[0], olo[1]); w0.y = cvt_pk_bf16(olo[2], olo[3]); w1.x = cvt_pk_bf16(ohi[0], ohi[1]); w1.y = cvt_pk_bf16(ohi[2], ohi[3]);
                    *(u32x2*)p = w0; *(u32x2*)(p + 32) = w1;
                }
            if (ISK) {
#pragma unroll
                for (int j = 0; j < 4; ++j) {
#pragma unroll
                    for (int o = 1; o < 16; o <<= 1) { slo[j] += __shfl_xor(slo[j], o); shi[j] += __shfl_xor(shi[j], o); } }
                amax = wave_max(amax);
                if (fr == 0) { float* km = kmean + ((size_t)plane * NBLK + (u.pm & 31)) * 64 + dlo;
#pragma unroll
                    for (int j = 0; j < 4; ++j) { atomicAdd(km + j, slo[j]); atomicAdd(km + 32 + j, shi[j]); } }
                if ((threadIdx.x & 63) == 0) atomicMax(kamax + plane, __float_as_uint(amax));
            }
        }
    }
    template <bool ACT> __device__ __forceinline__ void plane_sec(bf16_t* dst, int pbase, const Acc& acc, const pg8::Unit& u, int wr, int wc, int fr, int fq) const {
        const int b = u.pm >> 5, s0 = (u.pm & 31) * 256, dc0 = 32 * (wc & 1) + 8 * fq;
#pragma unroll
        for (int bj = 0; bj < 2; ++bj) {
            const int plane = b * 16 + pbase + 2 * bj + (wc >> 1);
#pragma unroll
            for (int ai = 0; ai < 2; ++ai)
#pragma unroll
                for (int m = 0; m < 4; ++m) {
                    const int s = s0 + 128 * ai + 64 * wr + 16 * m + fr;
                    f32x4 v0 = acc[ai][bj][m][0], v1 = acc[ai][bj][m][1];
                    if (ACT) {
#pragma unroll
                        for (int j = 0; j < 4; ++j) { v0[j] = v0[j] * sigmoidf_(v0[j]); v1[j] = v1[j] * sigmoidf_(v1[j]); } }
                    *(u32x4*)(dst + ((size_t)plane * SEQ + s) * 64 + dc0) = pack8(v0, v1);
                }
        }
    }
    __device__ __forceinline__ void qf_sec(const Acc& acc, const pg8::Unit& u, int wr, int wc, int fr, int fq) const {
        const int b = u.pm >> 5, s0 = (u.pm & 31) * 256;
        {
            const int h = u.pn, hp = b * 16 + 2 * h + (wc >> 1);
#pragma unroll
            for (int nn = 0; nn < 2; ++nn) {
                const int dc0 = 32 * (wc & 1) + 8 * fq + 4 * nn, lcol = h * 128 + 32 * wc + 8 * fq + 4 * nn;
                float lb[4];
#pragma unroll
                for (int i = 0; i < 4; ++i) { const float l0 = lbl[lcol + i], l1 = lbl[1024 + lcol + i]; lb[i] = 1.0f / (1.0f + __expf(l1 - l0)); }
#pragma unroll
                for (int ai = 0; ai < 2; ++ai) {
                    float bcs[4][4], kk[4][4];
#pragma unroll
                    for (int m = 0; m < 4; ++m)
#pragma unroll
                        for (int i = 0; i < 4; ++i) {
                            const float zf = acc[ai][1][m][nn][i];
                            const float e = __expf(-zf), sg = __builtin_amdgcn_rcpf(1.0f + e);
                            kk[m][i] = (1.0f - lb[i]) * (e * sg);
                            float v = __logf(lb[i] + (1.0f - lb[i]) * sg);
#pragma unroll
                            for (int o = 1; o < 16; o <<= 1) { const float t = __shfl_up(v, o, 16); if (fr >= o) v += t; }
                            bcs[m][i] = v;
                        }
                    float bmid[4], blast[4];
#pragma unroll
                    for (int i = 0; i < 4; ++i) {
                        float base = 0.f;
#pragma unroll
                        for (int m = 0; m < 4; ++m) { const float tot = __shfl(bcs[m][i], 15, 16); bcs[m][i] += base; base += tot; }
                        bmid[i] = __shfl(bcs[1][i], 15, 16); blast[i] = __shfl(bcs[3][i], 15, 16);
                    }
#pragma unroll
                    for (int m = 0; m < 4; ++m) {
                        const int s = s0 + 128 * ai + 64 * wr + 16 * m + fr;
                        f32x4 qv, kv;
#pragma unroll
                        for (int i = 0; i < 4; ++i) {
                            const float zq = acc[ai][0][m][nn][i];
                            const float ex = __expf(bcs[m][i] - bmid[i]);
                            qv[i] = zq * sigmoidf_(zq) * DKS * ex;
                            kv[i] = kk[m][i] * __builtin_amdgcn_rcpf(ex);
                        }
                        const size_t off = ((size_t)hp * SEQ + s) * 64 + dc0;
                        u32x2 wq_, wk_; wq_.x = cvt_pk_bf16(qv[0], qv[1]); wq_.y = cvt_pk_bf16(qv[2], qv[3]); wk_.x = cvt_pk_bf16(kv[0], kv[1]); wk_.y = cvt_pk_bf16(kv[2], kv[3]);
                        *(u32x2*)(QI + off) = wq_; *(u32x2*)(KI + off) = wk_;
                    }
                    if (fr == 15) {
                        const int chunk = (s0 + 128 * ai + 64 * wr) >> 6;
                        const size_t eo = (((size_t)(b * BH + h)) * NCH + chunk) * 128 + 32 * wc + 8 * fq + 4 * nn;
                        f32x4 a0, c0;
#pragma unroll
                        for (int i = 0; i < 4; ++i) { a0[i] = __expf(bmid[i]); c0[i] = __expf(blast[i] - bmid[i]); }
                        *(f32x4*)(E1 + eo) = a0; *(f32x4*)(E2 + eo) = c0;
                    }
                }
            }
        }
    }
};
template <bool ISK> struct EpiRope { static constexpr bool MID = false; EpiZ z;
    __device__ __forceinline__ void mid(Acc&, const pg8::Unit&, int, int, int, int) const {}
    __device__ __forceinline__ void operator()(const Acc& acc, const pg8::Unit& u, int wr, int wc, int fr, int fq) const { z.template rope_sec<ISK>(ISK ? z.Kp : z.Q, acc, u, wr, wc, fr, fq); } };
template <bool ACT> struct EpiPlane { static constexpr bool MID = false; EpiZ z; bf16_t* dst;
    __device__ __forceinline__ void mid(Acc&, const pg8::Unit&, int, int, int, int) const {}
    __device__ __forceinline__ void operator()(const Acc& acc, const pg8::Unit& u, int wr, int wc, int fr, int fq) const { z.template plane_sec<ACT>(dst, 4 * u.pn, acc, u, wr, wc, fr, fq); } };
struct EpiQF { static constexpr bool MID = false; EpiZ z;
    __device__ __forceinline__ void mid(Acc&, const pg8::Unit&, int, int, int, int) const {}
    __device__ __forceinline__ void operator()(const Acc& acc, const pg8::Unit& u, int wr, int wc, int fr, int fq) const { z.qf_sec(acc, u, wr, wc, fr, fq); } };
struct EpiKV {
    static constexpr bool MID = false;
    bf16_t *KX, *VX;
    __device__ __forceinline__ void mid(Acc&, const pg8::Unit&, int, int, int, int) const {}
    __device__ __forceinline__ void operator()(const Acc& acc, const pg8::Unit& u, int wr, int wc, int fr, int fq) const {
        bf16_t* dst = (u.pn < 4 ? KX : VX) + (size_t)(u.pm * 4 + (u.pn & 3)) * 256 * 256;
#pragma unroll
        for (int ai = 0; ai < 2; ++ai)
#pragma unroll
            for (int m = 0; m < 4; ++m) { const int r = 128 * ai + 64 * wr + 16 * m + fr;
#pragma unroll
                for (int bj = 0; bj < 2; ++bj) *(u32x4*)(dst + (size_t)r * 256 + 128 * bj + 32 * wc + 8 * fq) = pack8(acc[ai][bj][m][0], acc[ai][bj][m][1]); }
    }
};
struct EpiGate {
    static constexpr bool MID = false;
    bf16_t *RAT, *SGB;
    __device__ __forceinline__ void mid(Acc&, const pg8::Unit&, int, int, int, int) const {}
    __device__ __forceinline__ void operator()(const Acc& acc, const pg8::Unit& u, int wr, int wc, int fr, int fq) const {
        const int c0 = 128 * u.pn + 32 * wc + 8 * fq;
#pragma unroll
        for (int ai = 0; ai < 2; ++ai)
#pragma unroll
            for (int m = 0; m < 4; ++m) { const size_t r = (size_t)u.pm * 256 + 128 * ai + 64 * wr + 16 * m + fr;
                f32x4 ra[2], sb[2];
#pragma unroll
                for (int n = 0; n < 2; ++n)
#pragma unroll
                    for (int j = 0; j < 4; ++j) { const float ea = __expf(-acc[ai][0][m][n][j]), eb = __expf(-acc[ai][1][m][n][j]); sb[n][j] = __builtin_amdgcn_rcpf(1.0f + eb); ra[n][j] = (1.0f + eb) * __builtin_amdgcn_rcpf(1.0f + ea); }
                *(u32x4*)(RAT + r * D + c0) = pack8(ra[0], ra[1]); *(u32x4*)(SGB + r * D + c0) = pack8(sb[0], sb[1]); }
    }
};
struct EpiMerged {
    static constexpr bool MID = true;
    const bf16_t *RAT, *SGB; bf16_t* MG;
    __device__ __forceinline__ void mid(Acc& acc, const pg8::Unit& u, int wr, int wc, int fr, int fq) const {
        const int c0 = 256 * u.pn + 32 * wc + 8 * fq;
#pragma unroll
        for (int ai = 0; ai < 2; ++ai)
#pragma unroll
            for (int m = 0; m < 4; ++m) { const size_t r = (size_t)u.pm * 256 + 128 * ai + 64 * wr + 16 * m + fr;
#pragma unroll
                for (int bj = 0; bj < 2; ++bj) { const u32x4 wa = *(const u32x4*)(RAT + r * D + c0 + 128 * bj);
                    f32x4 a0, a1; unpack8(wa, a0, a1); acc[ai][bj][m][0] *= a0; acc[ai][bj][m][1] *= a1; }
                asm volatile("" ::: "memory"); }
    }
    __device__ __forceinline__ void operator()(const Acc& acc, const pg8::Unit& u, int wr, int wc, int fr, int fq) const {
        const int c0 = 256 * u.pn + 32 * wc + 8 * fq;
#pragma unroll
        for (int ai = 0; ai < 2; ++ai)
#pragma unroll
            for (int m = 0; m < 4; ++m) { const size_t r = (size_t)u.pm * 256 + 128 * ai + 64 * wr + 16 * m + fr;
#pragma unroll
                for (int bj = 0; bj < 2; ++bj) { const u32x4 wb = *(const u32x4*)(SGB + r * D + c0 + 128 * bj); f32x4 b0, b1; unpack8(wb, b0, b1);
                    *(u32x4*)(MG + r * D + c0 + 128 * bj) = pack8(acc[ai][bj][m][0] * b0, acc[ai][bj][m][1] * b1); } }
    }
};
template <bool RBF> struct EpiRes {
    static constexpr bool MID = false;
    const void* R; bf16_t* Hb; float* ssq;
    __device__ __forceinline__ void mid(Acc&, const pg8::Unit&, int, int, int, int) const {}
    __device__ __forceinline__ void operator()(const Acc& acc, const pg8::Unit& u, int wr, int wc, int fr, int fq) const {
        const int c0 = 256 * u.pn + 32 * wc + 4 * fq;
#pragma unroll
        for (int ai = 0; ai < 2; ++ai)
#pragma unroll
            for (int m = 0; m < 4; ++m) { const size_t r = (size_t)u.pm * 256 + 128 * ai + 64 * wr + 16 * m + fr; float ss = 0.f;
#pragma unroll
                for (int bj = 0; bj < 2; ++bj)
#pragma unroll
                    for (int n = 0; n < 2; ++n) { const size_t off = r * D + c0 + 128 * bj + 16 * n; f32x4 h = acc[ai][bj][m][n];
                        if (RBF) { const u32x2 w = *(const u32x2*)((const bf16_t*)R + off); h[0] += bflo(w.x); h[1] += bfhi(w.x); h[2] += bflo(w.y); h[3] += bfhi(w.y); }
                        else h += *(const f32x4*)((const float*)R + off);
                        ss += (h[0] * h[0] + h[1] * h[1]) + (h[2] * h[2] + h[3] * h[3]);
                        u32x2 w; w.x = cvt_pk_bf16(h[0], h[1]); w.y = cvt_pk_bf16(h[2], h[3]); *(u32x2*)(Hb + off) = w; }
                ss += __shfl_xor(ss, 16); ss += __shfl_xor(ss, 32);
                if (fq == 0) atomicAdd(ssq + r, ss); }
    }
};
struct EpiScaleRow {
    static constexpr bool MID = false;
    const float* ssq; bf16_t* O; float scale;
    __device__ __forceinline__ void mid(Acc&, const pg8::Unit&, int, int, int, int) const {}
    __device__ __forceinline__ void operator()(const Acc& acc, const pg8::Unit& u, int wr, int wc, int fr, int fq) const {
        const int c0 = 256 * u.pn + 32 * wc + 8 * fq;
#pragma unroll
        for (int ai = 0; ai < 2; ++ai)
#pragma unroll
            for (int m = 0; m < 4; ++m) { const size_t r = (size_t)u.pm * 256 + 128 * ai + 64 * wr + 16 * m + fr; const float rs = rsqrtf(ssq[r] * (1.0f / D) + EPS) * scale;
#pragma unroll
                for (int bj = 0; bj < 2; ++bj) *(u32x4*)(O + r * D + c0 + 128 * bj) = pack8(acc[ai][bj][m][0] * rs, acc[ai][bj][m][1] * rs); }
    }
};
struct EpiSwiglu {
    static constexpr bool MID = false;
    const float* ssq; bf16_t* ACT;
    __device__ __forceinline__ void mid(Acc&, const pg8::Unit&, int, int, int, int) const {}
    __device__ __forceinline__ void operator()(const Acc& acc, const pg8::Unit& u, int wr, int wc, int fr, int fq) const {
        const int c0 = 128 * u.pn + 32 * wc + 8 * fq;
#pragma unroll
        for (int ai = 0; ai < 2; ++ai)
#pragma unroll
            for (int m = 0; m < 4; ++m) { const size_t r = (size_t)u.pm * 256 + 128 * ai + 64 * wr + 16 * m + fr; const float rs = rsqrtf(ssq[r] * (1.0f / D) + EPS);
                f32x4 o[2];
#pragma unroll
                for (int n = 0; n < 2; ++n)
#pragma unroll
                    for (int j = 0; j < 4; ++j) { const float gv = acc[ai][0][m][n][j] * rs, uv = acc[ai][1][m][n][j] * rs; o[n][j] = gv * sigmoidf_(gv) * uv; }
                *(u32x4*)(ACT + r * FFN + c0) = pack8(o[0], o[1]); }
    }
};

typedef short s16x4 __attribute__((ext_vector_type(4)));
typedef short v4i16_t __attribute__((ext_vector_type(4)));
__device__ __forceinline__ s16x4 tr_read(const LAS unsigned char* p) { return __builtin_bit_cast(s16x4, __builtin_amdgcn_ds_read_tr16_b64_v4i16((LAS v4i16_t*)p)); }
__device__ __forceinline__ bf16x8 mk8(s16x4 lo, s16x4 hi) { return (bf16x8){lo[0], lo[1], lo[2], lo[3], hi[0], hi[1], hi[2], hi[3]}; }
__device__ __forceinline__ bf16x8 tr_frag(const LAS unsigned char* base, int pitch, int r0, int c0, int lane) {
    const int g = lane >> 4, i = lane & 15; const LAS unsigned char* p = base + (r0 + 8 * g + (i >> 2)) * pitch + (c0 + 4 * (i & 3)) * 2;
    return mk8(tr_read(p), tr_read(p + 4 * pitch));
}
__device__ __forceinline__ bf16x8 tr_frag_split(const LAS unsigned char* base, int pitch, int r0, int c0, int lane) {
    const int g = lane >> 4, i = lane & 15; const LAS unsigned char* p = base + (r0 + 4 * g + (i >> 2)) * pitch + (c0 + 4 * (i & 3)) * 2;
    return mk8(tr_read(p), tr_read(p + 16 * pitch));
}
__device__ __forceinline__ bf16x8 ld_frag(const LAS unsigned char* base, int pitch, int row, int col) { return *(const LAS bf16x8*)(base + row * pitch + col * 2); }
#define MFMA16(A, B, C) __builtin_amdgcn_mfma_f32_16x16x32_bf16((A), (B), (C), 0, 0, 0)
#define LDS_FADD(p, v) ((void)__hip_atomic_fetch_add((LAS float*)(p), (v), __ATOMIC_RELAXED, __HIP_MEMORY_SCOPE_WORKGROUP))

namespace hg {
constexpr int PITCH = 272;
constexpr int TILE = 64 * PITCH, HBUF = 3 * TILE;
constexpr int OFF_SP = 2 * HBUF, OFF_AM = OFF_SP + 128 * PITCH, AMP = 144, OFF_RSS = OFF_AM + 64 * AMP, OFF_E = OFF_RSS + 512, END = OFF_E + 2 * 1024;
static_assert(END <= 160 * 1024, "hgrn lds");
}
__device__ __forceinline__ void hgrn_item(LAS unsigned char* lds, int b, int h, const bf16_t* QIp, bf16_t* OUTp, size_t omask, const bf16_t* KIp, const bf16_t* VBp, const bf16_t* OGp, const float* E1p, const float* E2p, const float* gh) {
    using namespace hg;
    const int tid = threadIdx.x, lane = tid & 63, w = __builtin_amdgcn_readfirstlane(tid >> 6), c = lane & 15, g = lane >> 4;
    const size_t pl0 = ((size_t)(b * 16 + 2 * h)) * SEQ * 64, pl1 = pl0 + (size_t)SEQ * 64;
    const size_t eb = ((size_t)(b * BH + h)) * NCH * 128;
    const int tt = w >> 1, dvh = w & 1;
    f32x4 S[8];
#pragma unroll
    for (int j = 0; j < 8; ++j) S[j] = (f32x4){0.f, 0.f, 0.f, 0.f};
    f32x4 ghv[4];
#pragma unroll
    for (int jj = 0; jj < 4; ++jj) ghv[jj] = *(const f32x4*)(gh + h * 128 + 64 * dvh + 16 * jj + 4 * g);
    const size_t oplane = (dvh ? pl1 : pl0) + (size_t)(16 * tt + c) * 64 + 4 * g;
    u32x4 pq[2], pk[2], pv[2]; float pe = 0.f;
    auto issue = [&](int ch) {
#pragma unroll
        for (int k = 0; k < 2; ++k) { const int i = tid + 512 * k, row = i >> 4, pc = i & 15; const size_t src = (pc < 8 ? pl0 : pl1) + ((size_t)(64 * ch + row)) * 64 + (pc & 7) * 8;
            pq[k] = *(const u32x4*)(QIp + src); pk[k] = *(const u32x4*)(KIp + src); pv[k] = *(const u32x4*)(VBp + src); }
        if (tid < 256) pe = (tid < 128 ? E1p : E2p)[eb + (size_t)ch * 128 + (tid & 127)];
    };
    auto commit = [&](int p) {
        LAS unsigned char* bufp = lds + p * HBUF;
#pragma unroll
        for (int k = 0; k < 2; ++k) { const int i = tid + 512 * k, row = i >> 4, pc = i & 15; const int o = row * PITCH + pc * 16;
            *(LAS u32x4*)(bufp + o) = pq[k]; *(LAS u32x4*)(bufp + TILE + o) = pk[k]; *(LAS u32x4*)(bufp + 2 * TILE + o) = pv[k]; }
        if (tid < 256) ((LAS float*)(lds + OFF_E + p * 1024))[tid] = pe;
    };
    __syncthreads();
    issue(0); commit(0);
    __syncthreads();
    for (int ch = 0; ch < NCH; ++ch) {
        const int p = ch & 1;
        const LAS unsigned char* qb_ = lds + p * HBUF; const LAS unsigned char* kb_ = qb_ + TILE; const LAS unsigned char* vb_ = qb_ + 2 * TILE;
        const LAS float* e1s = (const LAS float*)(lds + OFF_E + p * 1024); const LAS float* e2s = e1s + 128;
        u32x2 ogv[4];
#pragma unroll
        for (int jj = 0; jj < 4; ++jj) ogv[jj] = *(const u32x2*)(OGp + oplane + (size_t)ch * 4096 + 16 * jj);
        issue(ch + 1 < NCH ? ch + 1 : ch);
#pragma unroll
        for (int s2 = 0; s2 < 2; ++s2) {
            const int si = 2 * (w & 1) + s2; f32x4 acc = {0.f, 0.f, 0.f, 0.f};
#pragma unroll
            for (int ks = 0; ks < 4; ++ks) acc = MFMA16(ld_frag(kb_, PITCH, 16 * si + c, 32 * ks + 8 * g), ld_frag(qb_, PITCH, 16 * tt + c, 32 * ks + 8 * g), acc);
#pragma unroll
            for (int r = 0; r < 4; ++r) acc[r] = (16 * si + 4 * g + r > 16 * tt + c) ? 0.f : acc[r];
            u32x2 w_; w_.x = cvt_pk_bf16(acc[0], acc[1]); w_.y = cvt_pk_bf16(acc[2], acc[3]);
            *(LAS u32x2*)(lds + OFF_AM + (16 * tt + c) * AMP + (16 * si + 4 * g) * 2) = w_;
        }
        {
            const f32x4 e1v = *(const LAS f32x4*)(e1s + 16 * w + 4 * g);
#pragma unroll
            for (int j = 0; j < 8; ++j) { S[j] = S[j] * e1v; u32x2 w_; w_.x = cvt_pk_bf16(S[j][0], S[j][1]); w_.y = cvt_pk_bf16(S[j][2], S[j][3]);
                *(LAS u32x2*)(lds + OFF_SP + (16 * j + c) * PITCH + (16 * w + 4 * g) * 2) = w_; }
        }
        __syncthreads();
        f32x4 o[4];
        {
            bf16x8 aq[4], aa[2];
#pragma unroll
            for (int ks = 0; ks < 4; ++ks) aq[ks] = ld_frag(qb_, PITCH, 16 * tt + c, 32 * ks + 8 * g);
#pragma unroll
            for (int j2 = 0; j2 < 2; ++j2) aa[j2] = ld_frag(lds + OFF_AM, AMP, 16 * tt + c, 32 * j2 + 8 * g);
            float ss = 0.f;
#pragma unroll
            for (int jj = 0; jj < 4; ++jj) {
                const int j = 4 * dvh + jj; f32x4 acc = {0.f, 0.f, 0.f, 0.f};
#pragma unroll
                for (int ks = 0; ks < 4; ++ks) acc = MFMA16(ld_frag(lds + OFF_SP, PITCH, 16 * j + c, 32 * ks + 8 * g), aq[ks], acc);
#pragma unroll
                for (int j2 = 0; j2 < 2; ++j2) acc = MFMA16(tr_frag(vb_, PITCH, 32 * j2, 16 * j, lane), aa[j2], acc);
                o[jj] = acc; ss += (acc[0] * acc[0] + acc[1] * acc[1]) + (acc[2] * acc[2] + acc[3] * acc[3]);
            }
            ss += __shfl_xor(ss, 16); ss += __shfl_xor(ss, 32);
            if (g == 0) ((LAS float*)(lds + OFF_RSS))[(16 * tt + c) * 2 + dvh] = ss;
        }
        __syncthreads();
        {
            const LAS float* rp = (const LAS float*)(lds + OFF_RSS) + (16 * tt + c) * 2; const float rs = rsqrtf((rp[0] + rp[1]) * (1.0f / 128.0f) + EPS);
#pragma unroll
            for (int jj = 0; jj < 4; ++jj) { const f32x4 v = o[jj] * rs * ghv[jj]; u32x2 w_;
                w_.x = cvt_pk_bf16(v[0] * bflo(ogv[jj].x), v[1] * bfhi(ogv[jj].x)); w_.y = cvt_pk_bf16(v[2] * bflo(ogv[jj].y), v[3] * bfhi(ogv[jj].y));
                *(u32x2*)(OUTp + ((oplane + (size_t)ch * 4096 + 16 * jj) & omask)) = w_; }
            bf16x8 ak[2];
#pragma unroll
            for (int k2 = 0; k2 < 2; ++k2) ak[k2] = tr_frag(kb_, PITCH, 32 * k2, 16 * w, lane);
            const f32x4 e2v = *(const LAS f32x4*)(e2s + 16 * w + 4 * g);
#pragma unroll
            for (int j = 0; j < 8; ++j) {
#pragma unroll
                for (int k2 = 0; k2 < 2; ++k2) S[j] = MFMA16(ak[k2], tr_frag(vb_, PITCH, 32 * k2, 16 * j, lane), S[j]);
                S[j] = S[j] * e2v;
            }
            commit(p ^ 1);
        }
        __syncthreads();
    }
}

namespace hg {
constexpr int NSEG = 8, SEGCH = NCH / NSEG;
}
__device__ __forceinline__ void hgrn_seg_a(LAS unsigned char* lds, int b, int h, int seg, const bf16_t* QIp, bf16_t* KIp, bf16_t* VBp, const float* E1p, const float* E2p) {
    using namespace hg;
    const int tid = threadIdx.x, lane = tid & 63, w = __builtin_amdgcn_readfirstlane(tid >> 6), c = lane & 15, g = lane >> 4;
    const size_t pl0 = ((size_t)(b * 16 + 2 * h)) * SEQ * 64, pl1 = pl0 + (size_t)SEQ * 64;
    const size_t eb = ((size_t)(b * BH + h)) * NCH * 128;
    const int tt = w >> 1, dvh = w & 1, ch0 = seg * SEGCH;
    f32x4 S[8];
#pragma unroll
    for (int j = 0; j < 8; ++j) S[j] = (f32x4){0.f, 0.f, 0.f, 0.f};
    f32x4 Dv = {1.f, 1.f, 1.f, 1.f};
    const size_t oplane = (dvh ? pl1 : pl0) + (size_t)(16 * tt + c) * 64 + 4 * g;
    u32x4 pq[2], pk[2], pv[2]; float pe = 0.f;
    auto issue = [&](int ch) {
#pragma unroll
        for (int k = 0; k < 2; ++k) { const int i = tid + 512 * k, row = i >> 4, pc = i & 15; const size_t src = (pc < 8 ? pl0 : pl1) + ((size_t)(64 * ch + row)) * 64 + (pc & 7) * 8;
            pq[k] = *(const u32x4*)(QIp + src); pk[k] = *(const u32x4*)(KIp + src); pv[k] = *(const u32x4*)(VBp + src); }
        if (tid < 256) pe = (tid < 128 ? E1p : E2p)[eb + (size_t)ch * 128 + (tid & 127)];
    };
    auto commit = [&](int p) {
        LAS unsigned char* bufp = lds + p * HBUF;
#pragma unroll
        for (int k = 0; k < 2; ++k) { const int i = tid + 512 * k, row = i >> 4, pc = i & 15; const int o = row * PITCH + pc * 16;
            *(LAS u32x4*)(bufp + o) = pq[k]; *(LAS u32x4*)(bufp + TILE + o) = pk[k]; *(LAS u32x4*)(bufp + 2 * TILE + o) = pv[k]; }
        if (tid < 256) ((LAS float*)(lds + OFF_E + p * 1024))[tid] = pe;
    };
    __syncthreads();
    issue(ch0); commit(0);
    __syncthreads();
    for (int cc = 0; cc < SEGCH; ++cc) {
        const int ch = ch0 + cc, p = cc & 1;
        const LAS unsigned char* qb_ = lds + p * HBUF; const LAS unsigned char* kb_ = qb_ + TILE; const LAS unsigned char* vb_ = qb_ + 2 * TILE;
        const LAS float* e1s = (const LAS float*)(lds + OFF_E + p * 1024); const LAS float* e2s = e1s + 128;
        issue(cc + 1 < SEGCH ? ch + 1 : ch);
#pragma unroll
        for (int s2 = 0; s2 < 2; ++s2) {
            const int si = 2 * (w & 1) + s2; f32x4 acc = {0.f, 0.f, 0.f, 0.f};
#pragma unroll
            for (int ks = 0; ks < 4; ++ks) acc = MFMA16(ld_frag(kb_, PITCH, 16 * si + c, 32 * ks + 8 * g), ld_frag(qb_, PITCH, 16 * tt + c, 32 * ks + 8 * g), acc);
#pragma unroll
            for (int r = 0; r < 4; ++r) acc[r] = (16 * si + 4 * g + r > 16 * tt + c) ? 0.f : acc[r];
            u32x2 w_; w_.x = cvt_pk_bf16(acc[0], acc[1]); w_.y = cvt_pk_bf16(acc[2], acc[3]);
            *(LAS u32x2*)(lds + OFF_AM + (16 * tt + c) * AMP + (16 * si + 4 * g) * 2) = w_;
        }
        const f32x4 e1v = *(const LAS f32x4*)(e1s + 16 * w + 4 * g), e2v = *(const LAS f32x4*)(e2s + 16 * w + 4 * g);
#pragma unroll
        for (int j = 0; j < 8; ++j) { S[j] = S[j] * e1v; u32x2 w_; w_.x = cvt_pk_bf16(S[j][0], S[j][1]); w_.y = cvt_pk_bf16(S[j][2], S[j][3]);
            *(LAS u32x2*)(lds + OFF_SP + (16 * j + c) * PITCH + (16 * w + 4 * g) * 2) = w_; }
        Dv = Dv * e1v * e2v;
        __syncthreads();
        {
            bf16x8 aq[4], aa[2];
#pragma unroll
            for (int ks = 0; ks < 4; ++ks) aq[ks] = ld_frag(qb_, PITCH, 16 * tt + c, 32 * ks + 8 * g);
#pragma unroll
            for (int j2 = 0; j2 < 2; ++j2) aa[j2] = ld_frag(lds + OFF_AM, AMP, 16 * tt + c, 32 * j2 + 8 * g);
#pragma unroll
            for (int jj = 0; jj < 4; ++jj) {
                const int j = 4 * dvh + jj; f32x4 acc = {0.f, 0.f, 0.f, 0.f};
#pragma unroll
                for (int ks = 0; ks < 4; ++ks) acc = MFMA16(ld_frag(lds + OFF_SP, PITCH, 16 * j + c, 32 * ks + 8 * g), aq[ks], acc);
#pragma unroll
                for (int j2 = 0; j2 < 2; ++j2) acc = MFMA16(tr_frag(vb_, PITCH, 32 * j2, 16 * j, lane), aa[j2], acc);
                u32x2 w_; w_.x = cvt_pk_bf16(acc[0], acc[1]); w_.y = cvt_pk_bf16(acc[2], acc[3]);
                *(u32x2*)(KIp + oplane + (size_t)ch * 4096 + 16 * jj) = w_;
            }
        }
        {
            bf16x8 ak[2];
#pragma unroll
            for (int k2 = 0; k2 < 2; ++k2) ak[k2] = tr_frag(kb_, PITCH, 32 * k2, 16 * w, lane);
#pragma unroll
            for (int j = 0; j < 8; ++j) {
#pragma unroll
                for (int k2 = 0; k2 < 2; ++k2) S[j] = MFMA16(ak[k2], tr_frag(vb_, PITCH, 32 * k2, 16 * j, lane), S[j]);
                S[j] = S[j] * e2v;
            }
            commit(p ^ 1);
        }
        __syncthreads();
    }
    float* Lg = (float*)(VBp + pl0 + (size_t)seg * SEGCH * 4096); float* Dg = (float*)(VBp + pl1 + (size_t)seg * SEGCH * 4096);
#pragma unroll
    for (int j = 0; j < 8; ++j)
#pragma unroll
        for (int r = 0; r < 4; ++r) Lg[(16 * w + 4 * g + r) * 128 + 16 * j + c] = S[j][r];
    if (c == 0) *(f32x4*)(Dg + 16 * w + 4 * g) = Dv;
}
__device__ __forceinline__ void hgrn_seg_b(LAS unsigned char* lds, int b, int h, int seg, bf16_t* QIp, const bf16_t* KIp, const bf16_t* VBp, const bf16_t* OGp, const float* E1p, const float* E2p, const float* gh) {
    using namespace hg;
    const int tid = threadIdx.x, lane = tid & 63, w = __builtin_amdgcn_readfirstlane(tid >> 6), c = lane & 15, g = lane >> 4;
    const size_t pl0 = ((size_t)(b * 16 + 2 * h)) * SEQ * 64, pl1 = pl0 + (size_t)SEQ * 64;
    const size_t eb = ((size_t)(b * BH + h)) * NCH * 128;
    const int tt = w >> 1, dvh = w & 1, ch0 = seg * SEGCH;
    f32x4 S[8];
#pragma unroll
    for (int j = 0; j < 8; ++j) S[j] = (f32x4){0.f, 0.f, 0.f, 0.f};
    for (int gp = 0; gp < seg; ++gp) {
        const float* Lg = (const float*)(VBp + pl0 + (size_t)gp * SEGCH * 4096); const float* Dg = (const float*)(VBp + pl1 + (size_t)gp * SEGCH * 4096);
        const f32x4 dv_ = *(const f32x4*)(Dg + 16 * w + 4 * g);
#pragma unroll
        for (int j = 0; j < 8; ++j)
#pragma unroll
            for (int r = 0; r < 4; ++r) S[j][r] = dv_[r] * S[j][r] + Lg[(16 * w + 4 * g + r) * 128 + 16 * j + c];
    }
    f32x4 ghv[4];
#pragma unroll
    for (int jj = 0; jj < 4; ++jj) ghv[jj] = *(const f32x4*)(gh + h * 128 + 64 * dvh + 16 * jj + 4 * g);
    const size_t oplane = (dvh ? pl1 : pl0) + (size_t)(16 * tt + c) * 64 + 4 * g;
    const size_t qrow = (size_t)(16 * tt + c) * 64 + 8 * g;
    f32x4 P = {1.f, 1.f, 1.f, 1.f};
    __syncthreads();
    for (int cc = 0; cc < SEGCH; ++cc) {
        const int ch = ch0 + cc;
        bf16x8 qf[4]; u32x2 ol[4], ogv[4];
#pragma unroll
        for (int ks = 0; ks < 4; ++ks) qf[ks] = *(const bf16x8*)(QIp + ((ks >> 1) ? pl1 : pl0) + (size_t)ch * 4096 + qrow + 32 * (ks & 1));
#pragma unroll
        for (int jj = 0; jj < 4; ++jj) { ol[jj] = *(const u32x2*)(KIp + oplane + (size_t)ch * 4096 + 16 * jj); ogv[jj] = *(const u32x2*)(OGp + oplane + (size_t)ch * 4096 + 16 * jj); }
        const f32x4 e1r = *(const f32x4*)(E1p + eb + (size_t)ch * 128 + 16 * w + 4 * g), e2r = *(const f32x4*)(E2p + eb + (size_t)ch * 128 + 16 * w + 4 * g);
        const f32x4 cv = e1r * P;
#pragma unroll
        for (int j = 0; j < 8; ++j) { const f32x4 sv = S[j] * cv; u32x2 w_; w_.x = cvt_pk_bf16(sv[0], sv[1]); w_.y = cvt_pk_bf16(sv[2], sv[3]);
            *(LAS u32x2*)(lds + OFF_SP + (16 * j + c) * PITCH + (16 * w + 4 * g) * 2) = w_; }
        P = P * e1r * e2r;
        __syncthreads();
        f32x4 o[4]; float ss = 0.f;
#pragma unroll
        for (int jj = 0; jj < 4; ++jj) {
            const int j = 4 * dvh + jj; f32x4 acc = {bflo(ol[jj].x), bfhi(ol[jj].x), bflo(ol[jj].y), bfhi(ol[jj].y)};
#pragma unroll
            for (int ks = 0; ks < 4; ++ks) acc = MFMA16(ld_frag(lds + OFF_SP, PITCH, 16 * j + c, 32 * ks + 8 * g), qf[ks], acc);
            o[jj] = acc; ss += (acc[0] * acc[0] + acc[1] * acc[1]) + (acc[2] * acc[2] + acc[3] * acc[3]);
        }
        ss += __shfl_xor(ss, 16); ss += __shfl_xor(ss, 32);
        if (g == 0) ((LAS float*)(lds + OFF_RSS))[(16 * tt + c) * 2 + dvh] = ss;
        __syncthreads();
        const LAS float* rp = (const LAS float*)(lds + OFF_RSS) + (16 * tt + c) * 2; const float rs = rsqrtf((rp[0] + rp[1]) * (1.0f / 128.0f) + EPS);
#pragma unroll
        for (int jj = 0; jj < 4; ++jj) { const f32x4 v = o[jj] * rs * ghv[jj]; u32x2 w_;
            w_.x = cvt_pk_bf16(v[0] * bflo(ogv[jj].x), v[1] * bfhi(ogv[jj].x)); w_.y = cvt_pk_bf16(v[2] * bflo(ogv[jj].y), v[3] * bfhi(ogv[jj].y));
            *(u32x2*)(QIp + oplane + (size_t)ch * 4096 + 16 * jj) = w_; }
    }
}

namespace mb {
constexpr int KP_ = 144;
constexpr int OFF_K = 0, OFF_V = 256 * KP_, OFF_KM = 2 * 256 * KP_, OFF_CNT = OFF_KM + 8192, OFF_BASE = OFF_CNT + 128, END = OFF_BASE + 128;
static_assert(END <= 160 * 1024, "moba lds");
constexpr size_t WS_PO = 264 * MiB, WS_PL = 456 * MiB, WS_LIST = 462 * MiB;
constexpr int LIST_PER_BH = 256 * 496;
static_assert(WS_PO + (size_t)64 * SEQ * 3 * 128 <= WS_PL && WS_PL + (size_t)64 * SEQ * 3 * 4 <= WS_LIST && WS_LIST + (size_t)64 * LIST_PER_BH * 2 <= 512 * MiB, "moba ws");
__device__ __forceinline__ int list_off(int n) { return 256 * (31 * n - (n * (n - 1)) / 2); }
}
__device__ __forceinline__ void mb_stage(LAS unsigned char* dst, const bf16_t* g, int tid) {
    u32x4 r[4];
#pragma unroll
    for (int k = 0; k < 4; ++k) { const int i = tid + 512 * k; r[k] = *(const u32x4*)(g + (size_t)(i >> 3) * 64 + (i & 7) * 8); }
#pragma unroll
    for (int k = 0; k < 4; ++k) { const int i = tid + 512 * k; *(LAS u32x4*)(dst + (i >> 3) * mb::KP_ + (i & 7) * 16) = r[k]; }
}
struct MbStage { u32x4 rk[4], rv[4]; };
__device__ __forceinline__ void mb_stage_issue(MbStage& st, const bf16_t* gk, const bf16_t* gv, int tid) {
#pragma unroll
    for (int k = 0; k < 4; ++k) { const int i = tid + 512 * k; const size_t o = (size_t)(i >> 3) * 64 + (i & 7) * 8; st.rk[k] = *(const u32x4*)(gk + o); st.rv[k] = *(const u32x4*)(gv + o); }
}
__device__ __forceinline__ void mb_stage_commit(const MbStage& st, LAS unsigned char* lds, int tid) {
#pragma unroll
    for (int k = 0; k < 4; ++k) { const int i = tid + 512 * k; const int o = (i >> 3) * mb::KP_ + (i & 7) * 16; *(LAS u32x4*)(lds + mb::OFF_K + o) = st.rk[k]; *(LAS u32x4*)(lds + mb::OFF_V + o) = st.rv[k]; }
}
__device__ __forceinline__ void mb_granule(const LAS unsigned char* lds, int lane, bf16x8 q0, bf16x8 q1, float mref, int qpos, int nstep, f32x4 (&o)[4], float& l) {
    using namespace mb;
    const int c = lane & 15, g = lane >> 4;
    float ls = 0.f;
#pragma unroll
    for (int dt = 0; dt < 4; ++dt) o[dt] = (f32x4){0.f, 0.f, 0.f, 0.f};
#pragma unroll
    for (int j = 0; j < 8; ++j) {
        if (j < nstep) {
            f32x4 s0 = {-mref, -mref, -mref, -mref}, s1 = s0;
            s0 = MFMA16(ld_frag(lds + OFF_K, KP_, 32 * j + c, 8 * g), q0, s0); s0 = MFMA16(ld_frag(lds + OFF_K, KP_, 32 * j + c, 32 + 8 * g), q1, s0);
            s1 = MFMA16(ld_frag(lds + OFF_K, KP_, 32 * j + 16 + c, 8 * g), q0, s1); s1 = MFMA16(ld_frag(lds + OFF_K, KP_, 32 * j + 16 + c, 32 + 8 * g), q1, s1);
#pragma unroll
            for (int r = 0; r < 4; ++r) { float p0 = __builtin_amdgcn_exp2f(s0[r]), p1 = __builtin_amdgcn_exp2f(s1[r]);
                p0 = (32 * j + 4 * g + r > qpos) ? 0.f : p0; p1 = (32 * j + 16 + 4 * g + r > qpos) ? 0.f : p1; s0[r] = p0; s1[r] = p1; ls += p0 + p1; }
            u32x4 w_; w_.x = cvt_pk_bf16(s0[0], s0[1]); w_.y = cvt_pk_bf16(s0[2], s0[3]); w_.z = cvt_pk_bf16(s1[0], s1[1]); w_.w = cvt_pk_bf16(s1[2], s1[3]);
            const bf16x8 pf = __builtin_bit_cast(bf16x8, w_);
#pragma unroll
            for (int dt = 0; dt < 4; ++dt) o[dt] = MFMA16(tr_frag_split(lds + OFF_V, KP_, 32 * j, 16 * dt, lane), pf, o[dt]);
        }
    }
    asm volatile("s_nop 15" : "+v"(o[0]), "+v"(o[1]), "+v"(o[2]), "+v"(o[3]));
    ls += __shfl_xor(ls, 16); ls += __shfl_xor(ls, 32); l = ls;
}
__device__ __forceinline__ float mb_mref(bf16x8 q0, bf16x8 q1, float kam) {
    float s = 0.f;
#pragma unroll
    for (int i = 0; i < 8; ++i) s += fabsf(bf2f((bf16_t)q0[i])) + fabsf(bf2f((bf16_t)q1[i]));
    s += __shfl_xor(s, 16); s += __shfl_xor(s, 32); return s * kam;
}
__device__ __forceinline__ void moba_gate_item(LAS unsigned char* lds, int bh, int bhl, int qb, const bf16_t* Qg, const float* kmeang, unsigned* gcnt, unsigned short* glist) {
    using namespace mb;
    int tid_ = threadIdx.x; asm volatile("" : "+v"(tid_)); const int tid = tid_;
    const size_t pbase = (size_t)bh * SEQ * 64;
    u32x4 rq[4]; float rkm[4];
#pragma unroll
    for (int k = 0; k < 4; ++k) { const int i = tid + 512 * k; rq[k] = *(const u32x4*)(Qg + pbase + (size_t)256 * qb * 64 + (size_t)(i >> 3) * 64 + (i & 7) * 8); rkm[k] = (i < qb * 64) ? kmeang[(size_t)bh * NBLK * 64 + i] : 0.f; }
    __syncthreads();
    LAS float* kms = (LAS float*)(lds + OFF_KM);
#pragma unroll
    for (int k = 0; k < 4; ++k) { const int i = tid + 512 * k; *(LAS u32x4*)(lds + OFF_K + (i >> 3) * KP_ + (i & 7) * 16) = rq[k]; kms[i] = rkm[k]; }
    if (tid < 32) ((LAS int*)(lds + OFF_CNT))[tid] = 0;
    __syncthreads();
    const int q = tid >> 1, hf = tid & 1; float qv[32];
#pragma unroll
    for (int k = 0; k < 4; ++k) { const u32x4 w_ = *(const LAS u32x4*)(lds + OFF_K + q * KP_ + hf * 64 + k * 16); f32x4 x0, x1; unpack8(w_, x0, x1);
#pragma unroll
        for (int e = 0; e < 4; ++e) { qv[8 * k + e] = x0[e]; qv[8 * k + 4 + e] = x1[e]; } }
    float v0 = -INFINITY, v1 = -INFINITY, v2 = -INFINITY; int i0 = -1, i1 = -1, i2 = -1;
    for (int n = 0; n < qb; ++n) { float gsum = 0.f; const LAS float* km = kms + n * 64 + hf * 32;
#pragma unroll
        for (int d = 0; d < 32; ++d) gsum += qv[d] * km[d];
        gsum += __shfl_xor(gsum, 1);
        if (gsum > v0) { v2 = v1; i2 = i1; v1 = v0; i1 = i0; v0 = gsum; i0 = n; } else if (gsum > v1) { v2 = v1; i2 = i1; v1 = gsum; i1 = n; } else if (gsum > v2) { v2 = gsum; i2 = n; } }
    int p0 = 0, p1 = 0, p2 = 0; LAS int* cnt = (LAS int*)(lds + OFF_CNT);
    if (hf == 0) {
        if (i0 >= 0) p0 = __hip_atomic_fetch_add(cnt + i0, 1, __ATOMIC_RELAXED, __HIP_MEMORY_SCOPE_WORKGROUP);
        if (i1 >= 0) p1 = __hip_atomic_fetch_add(cnt + i1, 1, __ATOMIC_RELAXED, __HIP_MEMORY_SCOPE_WORKGROUP);
        if (i2 >= 0) p2 = __hip_atomic_fetch_add(cnt + i2, 1, __ATOMIC_RELAXED, __HIP_MEMORY_SCOPE_WORKGROUP);
    }
    __syncthreads();
    if (tid < 32) { const int cn = cnt[tid]; ((LAS int*)(lds + OFF_BASE))[tid] = cn > 0 ? (int)atomicAdd(gcnt + bhl * 32 + tid, (unsigned)cn) : 0; }
    __syncthreads();
    if (hf == 0) {
        const LAS int* base = (const LAS int*)(lds + OFF_BASE); unsigned short* gl = glist + (size_t)bhl * LIST_PER_BH; const unsigned qg = (unsigned)(256 * qb + q);
        if (i0 >= 0) gl[list_off(i0) + base[i0] + p0] = (unsigned short)(qg);
        if (i1 >= 0) gl[list_off(i1) + base[i1] + p1] = (unsigned short)(qg | (1u << 13));
        if (i2 >= 0) gl[list_off(i2) + base[i2] + p2] = (unsigned short)(qg | (2u << 13));
    }
}
__device__ __forceinline__ void moba_part_item(LAS unsigned char* lds, int bh, int bhl, int n, int chunk, const bf16_t* Qg, const bf16_t* Kg, const bf16_t* Vg, const unsigned* kamaxg, const unsigned* gcnt, const unsigned short* glist, bf16_t* PO, float* PL) {
    using namespace mb;
    int tid_ = threadIdx.x; asm volatile("" : "+v"(tid_)); const int tid = tid_, lane = tid & 63, w = __builtin_amdgcn_readfirstlane(tid >> 6), c = lane & 15, g = lane >> 4;
    const int cnt = (int)gcnt[bhl * 32 + n], e0 = 512 * chunk;
    if (e0 >= cnt) return;
    const size_t pbase = (size_t)bh * SEQ * 64;
    MbStage st; mb_stage_issue(st, Kg + pbase + (size_t)256 * n * 64, Vg + pbase + (size_t)256 * n * 64, tid);
    const float kam = __uint_as_float(kamaxg[bh]); const unsigned short* gl = glist + (size_t)bhl * LIST_PER_BH + list_off(n);
    unsigned ent[4]; bool valid[4]; bf16x8 q0[4], q1[4];
#pragma unroll
    for (int k = 0; k < 4; ++k) { const int e = e0 + 16 * (w + 8 * k) + c; valid[k] = e < cnt; ent[k] = gl[valid[k] ? e : e0]; }
#pragma unroll
    for (int k = 0; k < 4; ++k) { const bf16_t* qr = Qg + pbase + (size_t)(ent[k] & 8191) * 64; q0[k] = *(const bf16x8*)(qr + 8 * g); q1[k] = *(const bf16x8*)(qr + 32 + 8 * g); }
    __syncthreads();
    mb_stage_commit(st, lds, tid);
    __syncthreads();
    if (e0 + 16 * w >= cnt) return;
    float mref[4], ls[4]; f32x4 o[4][4];
#pragma unroll
    for (int k = 0; k < 4; ++k) { mref[k] = valid[k] ? mb_mref(q0[k], q1[k], kam) : INFINITY; ls[k] = 0.f;
#pragma unroll
        for (int dt = 0; dt < 4; ++dt) o[k][dt] = (f32x4){0.f, 0.f, 0.f, 0.f}; }
#pragma unroll 1
    for (int j = 0; j < 8; ++j) {
        const bf16x8 ka0 = ld_frag(lds + OFF_K, KP_, 32 * j + c, 8 * g), ka1 = ld_frag(lds + OFF_K, KP_, 32 * j + c, 32 + 8 * g);
        const bf16x8 kb0 = ld_frag(lds + OFF_K, KP_, 32 * j + 16 + c, 8 * g), kb1 = ld_frag(lds + OFF_K, KP_, 32 * j + 16 + c, 32 + 8 * g);
        bf16x8 pf[4];
#pragma unroll
        for (int k = 0; k < 4; ++k) {
            f32x4 s0 = {0.f, 0.f, 0.f, 0.f}, s1 = {0.f, 0.f, 0.f, 0.f};
            s0 = MFMA16(ka0, q0[k], s0); s0 = MFMA16(ka1, q1[k], s0); s1 = MFMA16(kb0, q0[k], s1); s1 = MFMA16(kb1, q1[k], s1);
#pragma unroll
            for (int r = 0; r < 4; ++r) { s0[r] = __builtin_amdgcn_exp2f(s0[r] - mref[k]); s1[r] = __builtin_amdgcn_exp2f(s1[r] - mref[k]); ls[k] += s0[r] + s1[r]; }
            u32x4 w_; w_.x = cvt_pk_bf16(s0[0], s0[1]); w_.y = cvt_pk_bf16(s0[2], s0[3]); w_.z = cvt_pk_bf16(s1[0], s1[1]); w_.w = cvt_pk_bf16(s1[2], s1[3]);
            pf[k] = __builtin_bit_cast(bf16x8, w_); __builtin_amdgcn_sched_barrier(0);
        }
#pragma unroll
        for (int dt = 0; dt < 4; ++dt) { const bf16x8 vf = tr_frag_split(lds + OFF_V, KP_, 32 * j, 16 * dt, lane);
#pragma unroll
            for (int k = 0; k < 4; ++k) o[k][dt] = MFMA16(vf, pf[k], o[k][dt]); }
    }
#pragma unroll
    for (int k = 0; k < 4; ++k) {
        float l = ls[k]; l += __shfl_xor(l, 16); l += __shfl_xor(l, 32);
        if (valid[k]) { const int q = ent[k] & 8191, j = ent[k] >> 13; const size_t slot = ((size_t)bhl * SEQ + q) * 3 + j; bf16_t* po = PO + slot * 64 + 4 * g;
#pragma unroll
            for (int dt = 0; dt < 4; ++dt) { u32x2 w_; w_.x = cvt_pk_bf16(o[k][dt][0], o[k][dt][1]); w_.y = cvt_pk_bf16(o[k][dt][2], o[k][dt][3]); *(u32x2*)(po + 16 * dt) = w_; }
            if (g == 0) PL[slot] = l; }
    }
}
__device__ __forceinline__ void moba_part_phase(LAS unsigned char* lds, const LAS int* pfx, int nitems, int mbi, int nmb, const bf16_t* Qg, const bf16_t* Kg, const bf16_t* Vg, const unsigned* kamaxg, const unsigned* gcnt, const unsigned short* glist, bf16_t* PO, float* PL) {
    using namespace mb;
    int tid_ = threadIdx.x; asm volatile("" : "+v"(tid_)); const int tid = tid_, lane = tid & 63, w = __builtin_amdgcn_readfirstlane(tid >> 6), c = lane & 15, g = lane >> 4;
    MbStage st; unsigned ent[4]; bool valid[4]; int bh = 0, bhl = 0, cnt = 0, e0 = 0; bool have = false;
    auto fetch = [&](int r) {
        const int k = r * nmb + ((r & 1) ? nmb - 1 - mbi : mbi);
        have = (r * nmb < nitems) && (k < nitems);
        if (!have) return;
        int lo_ = 0, hi_ = 2047;
        while (lo_ < hi_) { const int mid = (lo_ + hi_) >> 1; if (pfx[mid] > k) hi_ = mid; else lo_ = mid + 1; }
        const int n = lo_ >> 6; bhl = lo_ & 63; const int chunk = k - (lo_ ? pfx[lo_ - 1] : 0); bh = bhl;
        cnt = (int)gcnt[bhl * 32 + n]; e0 = 512 * chunk;
        const size_t pbase = (size_t)bh * SEQ * 64;
        mb_stage_issue(st, Kg + pbase + (size_t)256 * n * 64, Vg + pbase + (size_t)256 * n * 64, tid);
        const unsigned short* gl = glist + (size_t)bhl * LIST_PER_BH + list_off(n);
#pragma unroll
        for (int k4 = 0; k4 < 4; ++k4) { const int e = e0 + 16 * (w + 8 * k4) + c; valid[k4] = e < cnt; ent[k4] = gl[valid[k4] ? e : e0]; }
    };
    fetch(0);
    for (int r = 0; have; ++r) {
        const int cbh = bh, cbhl = bhl, ccnt = cnt, ce0 = e0; unsigned cent[4]; bool cval[4]; bf16x8 q0[4], q1[4];
        const size_t pbase = (size_t)cbh * SEQ * 64;
#pragma unroll
        for (int k = 0; k < 4; ++k) { cent[k] = ent[k]; cval[k] = valid[k]; const bf16_t* qr = Qg + pbase + (size_t)(cent[k] & 8191) * 64; q0[k] = *(const bf16x8*)(qr + 8 * g); q1[k] = *(const bf16x8*)(qr + 32 + 8 * g); }
        const float kam = __uint_as_float(kamaxg[cbh]);
        __syncthreads();
        mb_stage_commit(st, lds, tid);
        __syncthreads();
        fetch(r + 1);
        if (ce0 + 16 * w < ccnt) {
            float nmr[4], ls[4]; f32x4 o[4][4];
#pragma unroll
            for (int k = 0; k < 4; ++k) { nmr[k] = cval[k] ? -mb_mref(q0[k], q1[k], kam) : -INFINITY; ls[k] = 0.f;
#pragma unroll
                for (int dt = 0; dt < 4; ++dt) o[k][dt] = (f32x4){0.f, 0.f, 0.f, 0.f}; }
#pragma unroll 1
            for (int j = 0; j < 8; ++j) {
                const bf16x8 ka0 = ld_frag(lds + OFF_K, KP_, 32 * j + c, 8 * g), ka1 = ld_frag(lds + OFF_K, KP_, 32 * j + c, 32 + 8 * g);
                const bf16x8 kb0 = ld_frag(lds + OFF_K, KP_, 32 * j + 16 + c, 8 * g), kb1 = ld_frag(lds + OFF_K, KP_, 32 * j + 16 + c, 32 + 8 * g);
                bf16x8 pf[4];
#pragma unroll
                for (int k = 0; k < 4; ++k) {
                    f32x4 s0 = {nmr[k], nmr[k], nmr[k], nmr[k]}, s1 = s0;
                    s0 = MFMA16(ka0, q0[k], s0); s0 = MFMA16(ka1, q1[k], s0); s1 = MFMA16(kb0, q0[k], s1); s1 = MFMA16(kb1, q1[k], s1);
#pragma unroll
                    for (int rr = 0; rr < 4; ++rr) { s0[rr] = __builtin_amdgcn_exp2f(s0[rr]); s1[rr] = __builtin_amdgcn_exp2f(s1[rr]); ls[k] += s0[rr] + s1[rr]; }
                    u32x4 w_; w_.x = cvt_pk_bf16(s0[0], s0[1]); w_.y = cvt_pk_bf16(s0[2], s0[3]); w_.z = cvt_pk_bf16(s1[0], s1[1]); w_.w = cvt_pk_bf16(s1[2], s1[3]);
                    pf[k] = __builtin_bit_cast(bf16x8, w_); __builtin_amdgcn_sched_barrier(0);
                }
#pragma unroll
                for (int dt = 0; dt < 4; ++dt) { const bf16x8 vf = tr_frag_split(lds + OFF_V, KP_, 32 * j, 16 * dt, lane);
#pragma unroll
                    for (int k = 0; k < 4; ++k) o[k][dt] = MFMA16(vf, pf[k], o[k][dt]); }
            }
#pragma unroll
            for (int k = 0; k < 4; ++k) {
                float l = ls[k]; l += __shfl_xor(l, 16); l += __shfl_xor(l, 32);
                if (cval[k]) { const int q = cent[k] & 8191, j = cent[k] >> 13; const size_t slot = ((size_t)cbhl * SEQ + q) * 3 + j; bf16_t* po = PO + slot * 64 + 4 * g;
#pragma unroll
                    for (int dt = 0; dt < 4; ++dt) { u32x2 w_; w_.x = cvt_pk_bf16(o[k][dt][0], o[k][dt][1]); w_.y = cvt_pk_bf16(o[k][dt][2], o[k][dt][3]); *(u32x2*)(po + 16 * dt) = w_; }
                    if (g == 0) PL[slot] = l; }
            }
        }
    }
}
__device__ __forceinline__ void moba_comb_item(LAS unsigned char* lds, int bh, int bhl, int qb, bf16_t* Qg, const bf16_t* Kg, const bf16_t* Vg, const unsigned* kamaxg, const bf16_t* PO, const float* PL) {
    using namespace mb;
    int tid_ = threadIdx.x; asm volatile("" : "+v"(tid_)); const int tid = tid_, lane = tid & 63, w = __builtin_amdgcn_readfirstlane(tid >> 6), c = lane & 15, g = lane >> 4;
    const size_t pbase = (size_t)bh * SEQ * 64;
    MbStage st; mb_stage_issue(st, Kg + pbase + (size_t)256 * qb * 64, Vg + pbase + (size_t)256 * qb * 64, tid);
    const float kam = __uint_as_float(kamaxg[bh]); const int nsel = qb < 3 ? qb : 3;
    bf16x8 q0[2], q1[2];
#pragma unroll
    for (int k = 0; k < 2; ++k) { const int gq = k ? 15 - w : w; const bf16_t* qr = Qg + pbase + (size_t)(256 * qb + 16 * gq + c) * 64; q0[k] = *(const bf16x8*)(qr + 8 * g); q1[k] = *(const bf16x8*)(qr + 32 + 8 * g); }
    __syncthreads();
    mb_stage_commit(st, lds, tid);
    __syncthreads();
#pragma unroll 1
    for (int k = 0; k < 2; ++k) {
        const int gq = k ? 15 - w : w, ql = 16 * gq + c, q = 256 * qb + ql;
        const bf16x8 qa = k ? q0[1] : q0[0], qb_ = k ? q1[1] : q1[0];
        const size_t slot = ((size_t)bhl * SEQ + q) * 3;
        u32x2 pp[3][4]; float pl[3];
#pragma unroll
        for (int j = 0; j < 3; ++j) { const bool on = j < nsel; pl[j] = on ? PL[slot + j] : 0.f; const bf16_t* po = PO + (slot + (on ? j : 0)) * 64 + 4 * g;
#pragma unroll
            for (int dt = 0; dt < 4; ++dt) pp[j][dt] = on ? *(const u32x2*)(po + 16 * dt) : (u32x2){0u, 0u}; }
        const float mref = mb_mref(qa, qb_, kam);
        f32x4 o[4]; float l; mb_granule(lds, lane, qa, qb_, mref, ql, (gq >> 1) + 1, o, l);
#pragma unroll
        for (int j = 0; j < 3; ++j) { l += pl[j];
#pragma unroll
            for (int dt = 0; dt < 4; ++dt) { o[dt][0] += bflo(pp[j][dt].x); o[dt][1] += bfhi(pp[j][dt].x); o[dt][2] += bflo(pp[j][dt].y); o[dt][3] += bfhi(pp[j][dt].y); } }
        const float rl = 1.0f / l; bf16_t* qr = Qg + pbase + (size_t)q * 64;
#pragma unroll
        for (int dt = 0; dt < 4; ++dt) { u32x2 w_; w_.x = cvt_pk_bf16(o[dt][0] * rl, o[dt][1] * rl); w_.y = cvt_pk_bf16(o[dt][2] * rl, o[dt][3] * rl); *(u32x2*)(qr + 16 * dt + 4 * g) = w_; }
    }
}

namespace xa {
constexpr int P = 528;
constexpr int END = 256 * P;
static_assert(END <= 160 * 1024, "xattn lds");
}
__device__ __forceinline__ void xattn_unit(LAS unsigned char* lds, int b, int hx, int tok0, const bf16_t* QXg, const bf16_t* KXg, const bf16_t* VXg, bf16_t* OXg) {
    using namespace xa;
    int tid_ = threadIdx.x; asm volatile("" : "+v"(tid_));
    const int tid = tid_, lane = tid & 63, w = __builtin_amdgcn_readfirstlane(tid >> 6), c = lane & 15, g = lane >> 4;
    const bf16_t* kb = KXg + (size_t)(b * 4 + hx) * 256 * 256; const bf16_t* vb = VXg + (size_t)(b * 4 + hx) * 256 * 256;
    auto stage = [&](const bf16_t* src) {
#pragma unroll
        for (int h2 = 0; h2 < 2; ++h2) { u32x4 rr[8]; int tid = tid_; asm volatile("" : "+v"(tid));
#pragma unroll
            for (int k = 0; k < 8; ++k) { const int i = tid + 512 * (8 * h2 + k); rr[k] = *(const u32x4*)(src + (size_t)(i >> 5) * 256 + (i & 31) * 8); }
#pragma unroll
            for (int k = 0; k < 8; ++k) { const int i = tid + 512 * (8 * h2 + k); *(LAS u32x4*)(lds + (i >> 5) * P + (i & 31) * 16) = rr[k]; } }
    };
    __syncthreads();
    stage(kb);
    __syncthreads();
    bf16x8 pf[2][8]; float rl[2], fa[2];
#pragma unroll
    for (int t2 = 0; t2 < 2; ++t2) {
        const size_t tok = (size_t)tok0 + 128 * t2 + 16 * w + c;
        bf16x8 qf[8];
#pragma unroll
        for (int ks = 0; ks < 8; ++ks) qf[ks] = *(const bf16x8*)(QXg + tok * D + hx * 256 + 32 * ks + 8 * g);
        float mh[2], lh[2];
#pragma unroll
        for (int hf = 0; hf < 2; ++hf) {
            f32x4 sc[8]; float mx = -INFINITY;
#pragma unroll
            for (int t = 0; t < 8; ++t) { f32x4 acc = {0.f, 0.f, 0.f, 0.f};
#pragma unroll
                for (int ks = 0; ks < 8; ++ks) acc = MFMA16(ld_frag(lds, P, 128 * hf + 16 * t + c, 32 * ks + 8 * g), qf[ks], acc);
                sc[t] = acc; mx = fmaxf(mx, fmaxf(fmaxf(acc[0], acc[1]), fmaxf(acc[2], acc[3]))); __builtin_amdgcn_sched_barrier(0); }
            mx = fmaxf(mx, __shfl_xor(mx, 16)); mx = fmaxf(mx, __shfl_xor(mx, 32));
            if (hf == 1) mx = fmaxf(mx, mh[0]);
            float ls = 0.f;
#pragma unroll
            for (int t = 0; t < 8; ++t)
#pragma unroll
                for (int r = 0; r < 4; ++r) { const float p = __builtin_amdgcn_exp2f(sc[t][r] - mx); sc[t][r] = p; ls += p; }
            ls += __shfl_xor(ls, 16); ls += __shfl_xor(ls, 32); mh[hf] = mx; lh[hf] = ls;
#pragma unroll
            for (int j = 0; j < 4; ++j) { u32x4 w_; w_.x = cvt_pk_bf16(sc[2 * j][0], sc[2 * j][1]); w_.y = cvt_pk_bf16(sc[2 * j][2], sc[2 * j][3]); w_.z = cvt_pk_bf16(sc[2 * j + 1][0], sc[2 * j + 1][1]); w_.w = cvt_pk_bf16(sc[2 * j + 1][2], sc[2 * j + 1][3]);
                pf[t2][4 * hf + j] = __builtin_bit_cast(bf16x8, w_); }
            __builtin_amdgcn_sched_barrier(0);
        }
        fa[t2] = __builtin_amdgcn_exp2f(mh[0] - mh[1]);
        rl[t2] = __builtin_amdgcn_rcpf(fa[t2] * lh[0] + lh[1]);
    }
    __syncthreads();
    stage(vb);
    __syncthreads();
#pragma unroll
    for (int t2 = 0; t2 < 2; ++t2) {
        const size_t tok = (size_t)tok0 + 128 * t2 + 16 * w + c;
        f32x4 o[16];
#pragma unroll
        for (int dt = 0; dt < 16; ++dt) o[dt] = (f32x4){0.f, 0.f, 0.f, 0.f};
#pragma unroll
        for (int j = 0; j < 8; ++j) {
            if (j == 4) {
#pragma unroll
                for (int dt = 0; dt < 16; ++dt) o[dt] = o[dt] * fa[t2]; }
#pragma unroll
            for (int dt = 0; dt < 16; ++dt) { o[dt] = MFMA16(tr_frag_split(lds, P, 32 * j, 16 * dt, lane), pf[t2][j], o[dt]); if ((dt & 3) == 3) __builtin_amdgcn_sched_barrier(0); }
        }
#pragma unroll
        for (int dt = 0; dt < 16; ++dt) { u32x2 w_; w_.x = cvt_pk_bf16(o[dt][0] * rl[t2], o[dt][1] * rl[t2]); w_.y = cvt_pk_bf16(o[dt][2] * rl[t2], o[dt][3] * rl[t2]); *(u32x2*)(OXg + tok * D + hx * 256 + 16 * dt + 4 * g) = w_; }
    }
}

#define XB_TMO      128
#define XB_XCNT(j)  (256  + 64 * (j))
#define XB_XSUB(j)  (1280 + 64 * (j))
#define XB_XGEN(j)  (2304 + 64 * (j))
#define XB_TOP      3328
#define XB_TOPGEN   3392
#define XCD_BAR_WORDS 3456
#define XB_SPIN_CAP (1u << 18)

__device__ __forceinline__ unsigned xb_ld(unsigned* p)              { return __hip_atomic_load(p, __ATOMIC_RELAXED, __HIP_MEMORY_SCOPE_AGENT); }
__device__ __forceinline__ unsigned xb_add(unsigned* p, unsigned v) { return __hip_atomic_fetch_add(p, v, __ATOMIC_RELAXED, __HIP_MEMORY_SCOPE_AGENT); }
__device__ __forceinline__ unsigned xb_xcc_id() { return (unsigned)__builtin_amdgcn_s_getreg((3 << 11) | 20) & 0xFu; }
#define XB_SPIN(cond, bar) do { unsigned _sp = 0; while (cond) { __builtin_amdgcn_s_sleep(1); \
    if ((++_sp & 255u) == 0u) { if (xb_ld(&(bar)[XB_TMO])) break; if (_sp > XB_SPIN_CAP) { atomicAdd(&(bar)[XB_TMO], 1u); break; } } } } while (0)

struct XcdBarrier {
    unsigned* bar; unsigned x;
    volatile LAS unsigned* st;
};

__device__ __forceinline__ XcdBarrier xcd_barrier_post(unsigned* bar, volatile LAS unsigned* st) {
    XcdBarrier b; b.bar = bar; b.x = xb_xcc_id(); b.st = st;
    if (threadIdx.x == 0) (void)xb_add(&bar[XB_XCNT(b.x)], 1u);
    return b;
}
__device__ __forceinline__ void xcd_barrier_complete(unsigned* bar, unsigned x, unsigned& nloc, unsigned& nx) {
    const unsigned G = gridDim.x * gridDim.y * gridDim.z;
    unsigned sum, cnt, mine, sp = 0u;
    for (;;) {
        sum = 0u; cnt = 0u; mine = 0u;
#pragma unroll
        for (unsigned j = 0; j < 16; ++j) { const unsigned c = xb_ld(&bar[XB_XCNT(j)]); sum += c; cnt += (c > 0u) ? 1u : 0u; mine = (j == x) ? c : mine; }
        if (sum == G) break;
        __builtin_amdgcn_s_sleep(1);
        if ((++sp & 255u) == 0u) { if (xb_ld(&bar[XB_TMO])) break; if (sp > XB_SPIN_CAP) { atomicAdd(&bar[XB_TMO], 1u); break; } }
    }
    nloc = mine > 0u ? mine : 1u; nx = cnt > 0u ? cnt : 1u;
}

__device__ __forceinline__ void xcd_barrier(unsigned* const b_bar, const unsigned b_x, volatile LAS unsigned* const b_st) {
    asm volatile("s_waitcnt vmcnt(0)" ::: "memory");
    __syncthreads();
    if (threadIdx.x == 0) {
        unsigned* bar = b_bar;
        __builtin_amdgcn_s_waitcnt(0);
        unsigned nloc = b_st[0], nx = b_st[1];
        if (nloc == 0u) { xcd_barrier_complete(bar, b_x, nloc, nx); b_st[0] = nloc; b_st[1] = nx; }
        const unsigned old = xb_add(&bar[XB_XSUB(b_x)], 1u);
        const unsigned gen = old / nloc;
        if (old + 1u == (gen + 1u) * nloc) {
            __builtin_amdgcn_fence(__ATOMIC_RELEASE, "agent");
            asm volatile("s_waitcnt vmcnt(0)" ::: "memory");
            const unsigned og = xb_add(&bar[XB_TOP], 1u);
            const unsigned tg = og / nx;
            if (og + 1u == (tg + 1u) * nx) xb_add(&bar[XB_TOPGEN], 1u);
            else XB_SPIN(xb_ld(&bar[XB_TOPGEN]) == tg, bar);
            __builtin_amdgcn_fence(__ATOMIC_ACQUIRE, "agent");
            xb_add(&bar[XB_XGEN(b_x)], 1u);
            asm volatile("s_waitcnt vmcnt(0)" ::: "memory");
        } else {
            XB_SPIN(xb_ld(&bar[XB_XGEN(b_x)]) == gen, bar);
            __builtin_amdgcn_fence(__ATOMIC_ACQUIRE, "agent");
            asm volatile("s_waitcnt vmcnt(0)" ::: "memory");
        }
    }
    __syncthreads();
}


struct Args {
    const float* x; const float* mem; const int* pos; const float* g_mix; const float* w_in; const float* lbl; const float* g_hgrn; const float* w_bra; const float* w_brh; const float* w_out;
    const float* g_x; const float* g_mem; const float* wq; const float* wkv; const float* wo; const float* g_ffn; const float* w_ffi; const float* w_ffo; const float* g_fin;
    float* out; unsigned char* ws; int ph_lo, ph_hi;
};

template <class MapFn>
__device__ __forceinline__ void wt_item(const float* W, int ldw, const float* gain, bf16_t* WT, int ldwt, int koff, int nblk, int item, LAS float* scr, int lane, MapFn colmap) {
    const int kb = item / nblk, nb = item % nblk, k0 = 64 * kb, n0 = 32 * nb;
    const int col = colmap(n0 + (lane & 31));
    float wv[32];
#pragma unroll
    for (int i = 0; i < 32; ++i) wv[i] = W[(size_t)(k0 + 2 * i + (lane >> 5)) * ldw + col];
    if (gain) {
#pragma unroll
        for (int i = 0; i < 32; ++i) wv[i] *= gain[k0 + 2 * i + (lane >> 5)]; }
#pragma unroll
    for (int i = 0; i < 32; ++i) scr[(2 * i + (lane >> 5)) * 33 + (lane & 31)] = wv[i];
    asm volatile("s_waitcnt lgkmcnt(0)" ::: "memory");
    const int c = lane & 7;
#pragma unroll
    for (int j = 0; j < 4; ++j) { const int n = (lane >> 3) + 8 * j; const LAS float* s = scr + (8 * c) * 33 + n;
        u32x4 o; o.x = cvt_pk_bf16(s[0 * 33], s[1 * 33]); o.y = cvt_pk_bf16(s[2 * 33], s[3 * 33]); o.z = cvt_pk_bf16(s[4 * 33], s[5 * 33]); o.w = cvt_pk_bf16(s[6 * 33], s[7 * 33]);
        *(u32x4*)(WT + (size_t)(n0 + n) * ldwt + koff + k0 + 8 * c) = o; }
    asm volatile("s_waitcnt lgkmcnt(0)" ::: "memory");
}
__device__ __forceinline__ int zmap(int n) {
    const int tile = n >> 8, p = n & 255, bj = p >> 7, wc = (p >> 5) & 3, nn = (p >> 4) & 1, fq = (p >> 2) & 3, j = p & 3;
    if (tile < 8) return 256 * tile + 64 * (2 * bj + (wc >> 1)) + 32 * nn + 16 * (wc & 1) + 4 * fq + j;
    if (tile < 12) return 2048 + 256 * (tile - 8) + perm8(p);
    if (tile < 20) return (bj ? 4096 : 3072) + 128 * (tile - 12) + (perm8(p) & 127);
    if (tile < 24) return 5120 + 256 * (tile - 20) + perm8(p);
    return 6144 + 256 * (tile - 24) + perm8(p);
}
__device__ __forceinline__ void norm_row_bf16(const float* xrow, const float* g, bf16_t* orow, int lane) {
    f32x4 v[4]; float s = 0.f;
#pragma unroll
    for (int j = 0; j < 4; ++j) { v[j] = ((const f32x4*)xrow)[lane + 64 * j]; s += (v[j][0] * v[j][0] + v[j][1] * v[j][1]) + (v[j][2] * v[j][2] + v[j][3] * v[j][3]); }
    const float rstd = rsqrtf(wave_sum(s) * (1.0f / D) + EPS);
#pragma unroll
    for (int j = 0; j < 4; ++j) { const f32x4 gg = ((const f32x4*)g)[lane + 64 * j]; u32x2 w; w.x = cvt_pk_bf16(v[j][0] * rstd * gg[0], v[j][1] * rstd * gg[1]); w.y = cvt_pk_bf16(v[j][2] * rstd * gg[2], v[j][3] * rstd * gg[3]);
        ((u32x2*)orow)[lane + 64 * j] = w; }
}
__device__ __forceinline__ void sincos_acc(float ang, float& sn, float& cs) {
    const double a = (double)ang; const double q = __builtin_rint(a * 0.6366197723675814);
    const double t = __builtin_fma(-q, 1.5707963267948966, a) - q * 6.123233995736766e-17;
    const double t2 = t * t;
    double sp = -2.5052108385441720e-08; sp = sp * t2 + 2.7557319223985893e-06; sp = sp * t2 - 1.9841269841269841e-04; sp = sp * t2 + 8.3333333333333332e-03; sp = sp * t2 - 1.6666666666666666e-01; sp = sp * t2 * t + t;
    double cp = 2.0876756987868099e-09; cp = cp * t2 - 2.7557319223985888e-07; cp = cp * t2 + 2.4801587301587302e-05; cp = cp * t2 - 1.3888888888888889e-03; cp = cp * t2 + 4.1666666666666664e-02; cp = cp * t2 - 0.5; cp = cp * t2 + 1.0;
    const int qi = ((int)q) & 3;
    const double s_ = (qi & 1) ? cp : sp, c_ = (qi & 1) ? sp : cp;
    sn = (float)((qi & 2) ? -s_ : s_); cs = (float)(((qi == 1) || (qi == 2)) ? -c_ : c_);
}

constexpr int LDS_BYTES = 160 * 1024;
__global__ void __launch_bounds__(512, 2) mega_fwd(Args a) {
    extern __shared__ __attribute__((aligned(16))) unsigned char lds_raw[];
    LAS unsigned char* lds = (LAS unsigned char*)lds_raw;
    const int tid = threadIdx.x, lane = tid & 63, wave = __builtin_amdgcn_readfirstlane(tid >> 6);
    const int G = gridDim.x, bx = blockIdx.x;
    const int vcu = (G % 8 == 0) ? (bx % 8) * (G / 8) + bx / 8 : bx;
    const int gw = vcu * 8 + wave, NGW = G * 8;
#define kmean ((float*)(a.ws + CTL_KMEAN))
#define kamax ((unsigned*)(a.ws + CTL_KAMAX))
#define ssq1 ((float*)(a.ws + CTL_SSQ1))
#define ssq2 ((float*)(a.ws + CTL_SSQ2))
#define ssq3 ((float*)(a.ws + CTL_SSQ3))
#define WZ ((bf16_t*)(a.ws + WS_WZ))
#define WG ((bf16_t*)(a.ws + WS_WG))
#define WBR ((bf16_t*)(a.ws + WS_WBR))
#define WOUT ((bf16_t*)(a.ws + WS_WOUT))
#define WQ ((bf16_t*)(a.ws + WS_WQ))
#define WKV ((bf16_t*)(a.ws + WS_WKV))
#define WO ((bf16_t*)(a.ws + WS_WO))
#define WFI ((bf16_t*)(a.ws + WS_WFI))
#define WFO ((bf16_t*)(a.ws + WS_WFO))
#define RC ((float*)(a.ws + WS_RC))
#define RS ((float*)(a.ws + WS_RS))
#define MEMN ((bf16_t*)(a.ws + WS_MEMN))
#define KX ((bf16_t*)(a.ws + WS_KX))
#define VX ((bf16_t*)(a.ws + WS_VX))
#define E1 ((float*)(a.ws + WS_E1))
#define E2 ((float*)(a.ws + WS_E2))
#define XN ((bf16_t*)(a.ws + WS_XN))
#define HB XN
#define QP ((bf16_t*)(a.ws + WS_Q))
#define QX QP
#define QI ((bf16_t*)(a.ws + WS_QI))
#define OX QI
#define KI ((bf16_t*)(a.ws + WS_KI))
#define RAT KI
#define VB ((bf16_t*)(a.ws + WS_VB))
#define SGB VB
#define OG ((bf16_t*)(a.ws + WS_OG))
#define MG OG
#define ACT ((bf16_t*)(a.ws + WS_ACT))
#define KP ((bf16_t*)a.out)
#define VP ((bf16_t*)((unsigned char*)a.out + 64 * MiB))
#define H (a.out)
    cg::grid_group grid = cg::this_grid();
    volatile LAS unsigned* xb_st = (volatile LAS unsigned*)(lds + LDS_BYTES - 32);
    if (tid == 0) { xb_st[0] = 0u; xb_st[1] = 0u; }
    __syncthreads();
    unsigned* const xb_bar = (unsigned*)(a.ws + WS_CTL + 40960); const unsigned xb_x = xb_xcc_id();
    if (tid == 0) (void)xb_add(&xb_bar[XB_XCNT(xb_x)], 1u);
    const int lo = a.ph_lo, hi = a.ph_hi;
#ifndef PH_MASK
#define PH_MASK 0xfff
#endif
#define IN(k) (((PH_MASK >> (k)) & 1) && lo <= (k) && (k) < hi)
#define XBAR(word, count) xcd_barrier(xb_bar, xb_x, xb_st)
#define SEAM(k) do { if (IN(k) && IN((k) + 1)) { if (a.ph_lo < 0) grid.sync(); else XBAR(100 + (k), G); } } while (0)
#ifndef DUP_MASK
#define DUP_MASK 0
#endif
#define REPS(k) for (int rep_ = 0; rep_ < (((DUP_MASK >> (k)) & 1) ? 2 : 1); ++rep_)

    if (IN(0)) {
        LAS float* scr = (LAS float*)(lds + wave * 16384);
        constexpr int I_Z = 16 * (ZN / 32), I_G = 16 * 64, I_BR = 16 * 32, I_SQ = 16 * 32, I_KV = 16 * 64, I_FI = 16 * 176, I_FO = 44 * 32;
        constexpr int NITEMS = I_Z + I_G + 2 * I_BR + 3 * I_SQ + I_KV + I_FI + I_FO;
        for (int it = gw; it < NITEMS; it += NGW) {
            int r = it;
            if (r < I_Z) { wt_item(a.w_in, 9216, nullptr, WZ, 1024, 0, ZN / 32, r, scr, lane, [](int n) { return zmap(n); }); continue; } r -= I_Z;
            if (r < I_G) { wt_item(a.w_in, 9216, nullptr, WG, 1024, 0, 64, r, scr, lane, [](int n) { const int p = n & 255; return ((p >> 7) ? 8192 : 7168) + 128 * (n >> 8) + (perm8(p) & 127); }); continue; } r -= I_G;
            if (r < I_BR) { wt_item(a.w_bra, 1024, nullptr, WBR, 2048, 0, 32, r, scr, lane, [](int n) { return (n & ~255) + perm8(n & 255); }); continue; } r -= I_BR;
            if (r < I_BR) { wt_item(a.w_brh, 1024, nullptr, WBR, 2048, 1024, 32, r, scr, lane, [](int n) { return (n & ~255) + perm8(n & 255); }); continue; } r -= I_BR;
            if (r < I_SQ) { wt_item(a.w_out, 1024, nullptr, WOUT, 1024, 0, 32, r, scr, lane, [](int n) { return n; }); continue; } r -= I_SQ;
            if (r < I_SQ) { wt_item(a.wq, 1024, a.g_x, WQ, 1024, 0, 32, r, scr, lane, [](int n) { return (n & ~255) + perm8(n & 255); }); continue; } r -= I_SQ;
            if (r < I_SQ) { wt_item(a.wo, 1024, nullptr, WO, 1024, 0, 32, r, scr, lane, [](int n) { return n; }); continue; } r -= I_SQ;
            if (r < I_KV) { wt_item(a.wkv, 2048, nullptr, WKV, 1024, 0, 64, r, scr, lane, [](int n) { return (n & ~255) + perm8(n & 255); }); continue; } r -= I_KV;
            if (r < I_FI) { wt_item(a.w_ffi, 2 * FFN, a.g_ffn, WFI, 1024, 0, 176, r, scr, lane, [](int n) { const int p = n & 255; return ((p >> 7) ? FFN : 0) + 128 * (n >> 8) + (perm8(p) & 127); }); continue; } r -= I_FI;
            wt_item(a.w_ffo, 1024, nullptr, WFO, FFN, 0, 32, r, scr, lane, [](int n) { return n; });
        }
        for (int m = gw; m < T; m += 2 * NGW) {
            const int m2 = m + NGW; f32x4 v0[4], v1[4]; float s0 = 0.f, s1 = 0.f;
#pragma unroll
            for (int j = 0; j < 4; ++j) { v0[j] = ((const f32x4*)(a.x + (size_t)m * D))[lane + 64 * j]; v1[j] = ((const f32x4*)(a.x + (size_t)m2 * D))[lane + 64 * j]; }
#pragma unroll
            for (int j = 0; j < 4; ++j) { s0 += (v0[j][0] * v0[j][0] + v0[j][1] * v0[j][1]) + (v0[j][2] * v0[j][2] + v0[j][3] * v0[j][3]); s1 += (v1[j][0] * v1[j][0] + v1[j][1] * v1[j][1]) + (v1[j][2] * v1[j][2] + v1[j][3] * v1[j][3]); }
            const float r0 = rsqrtf(wave_sum(s0) * (1.0f / D) + EPS), r1 = rsqrtf(wave_sum(s1) * (1.0f / D) + EPS);
#pragma unroll
            for (int j = 0; j < 4; ++j) { const f32x4 gg = ((const f32x4*)a.g_mix)[lane + 64 * j]; const f32x4 a0 = v0[j] * r0 * gg, a1 = v1[j] * r1 * gg; u32x2 w0, w1;
                w0.x = cvt_pk_bf16(a0[0], a0[1]); w0.y = cvt_pk_bf16(a0[2], a0[3]); w1.x = cvt_pk_bf16(a1[0], a1[1]); w1.y = cvt_pk_bf16(a1[2], a1[3]);
                ((u32x2*)(XN + (size_t)m * D))[lane + 64 * j] = w0; ((u32x2*)(XN + (size_t)m2 * D))[lane + 64 * j] = w1; }
        }
        for (int m = gw; m < NB * NMEM; m += NGW) norm_row_bf16(a.mem + (size_t)m * D, a.g_mem, MEMN + (size_t)m * D, lane);
        for (int i = bx * 512 + tid; i < T * 32; i += G * 512) {
            const int tok = i >> 5, f = i & 31;
            const float inv = powf(10000.0f, -(float)(2 * f) * (1.0f / 64.0f));
            const float ang = (float)a.pos[tok] * inv;
            float sn, cs; sincos_acc(ang, sn, cs); RC[i] = cs; RS[i] = sn;
        }
    }
    SEAM(0);
    if (IN(1)) {

        const EpiZ Z{QP, KP, VP, QI, KI, VB, OG, E1, E2, RC, RS, kmean, kamax, a.lbl};
#define ZSEC(EPI, einit, tile0, ntile) { pg8::Gemm g{pg8::a_rowmajor(XN, D), WZ + (size_t)(tile0) * 256 * D, T, (ntile) * 256, D}; pg8::StaticOrder S; S.init(T, (ntile) * 256, G, bx); \
            const EPI E einit; pg8::gemm_phase<EPI, true>(lds, g, S, E); }
        ZSEC(EpiRope<false>, {Z}, 0, 4)
        ZSEC(EpiRope<true>, {Z}, 4, 4)
        ZSEC(EpiPlane<false>, ({Z, VP}), 8, 4)
        ZSEC(EpiQF, {Z}, 12, 8)
        ZSEC(EpiPlane<false>, ({Z, VB}), 20, 4)
        ZSEC(EpiPlane<true>, ({Z, OG}), 24, 4)
    #if (DUP_MASK >> 1) & 1
        ZSEC(EpiRope<false>, {Z}, 0, 4)
        ZSEC(EpiRope<true>, {Z}, 4, 4)
        ZSEC(EpiPlane<false>, ({Z, VP}), 8, 4)
        ZSEC(EpiQF, {Z}, 12, 8)
        ZSEC(EpiPlane<false>, ({Z, VB}), 20, 4)
        ZSEC(EpiPlane<true>, ({Z, OG}), 24, 4)
    #endif
#undef ZSEC
    }
    SEAM(1);
    if (IN(2)) {
        for (int it = bx; it < NB * BH * hg::NSEG; it += G) hgrn_seg_a(lds, it / (BH * hg::NSEG), (it / hg::NSEG) % BH, it % hg::NSEG, QI, KI, VB, E1, E2);
        XBAR(120, G);
        for (int it = bx; it < NB * BH * hg::NSEG; it += G) hgrn_seg_b(lds, it / (BH * hg::NSEG), (it / hg::NSEG) % BH, it % hg::NSEG, QI, KI, VB, OG, E1, E2, a.g_hgrn);
        {
            unsigned* ctl = (unsigned*)(a.ws + WS_CTL);
            unsigned* gcnt = ctl + 4096;
            bf16_t* PO = (bf16_t*)(a.ws + mb::WS_PO); float* PL = (float*)(a.ws + mb::WS_PL); unsigned short* GL = (unsigned short*)(a.ws + mb::WS_LIST);
            const int nmb = G, mbi = bx;
#define MB_QUEUE(total, ...) do { for (int r_ = 0;; ++r_) { const int k = r_ * nmb + ((r_ & 1) ? nmb - 1 - mbi : mbi); if (r_ * nmb >= (total)) break; if (k < (total)) { __VA_ARGS__ } } } while (0)
            if (bx < 32) { __syncthreads(); pg8::Gemm g{pg8::a_rowmajor(MEMN, D), WKV, NB * NMEM, 2 * D, D}; pg8::StaticOrder S; S.init(NB * NMEM, 2 * D, 32, bx);
                EpiKV E{KX, VX};
                pg8::gemm_phase<EpiKV, true>(lds, g, S, E); }
            { const int n1 = G - 32, head = 3 * n1;
              if (bx >= 32) for (int r_ = 0; r_ < 3; ++r_) { const int k = r_ * n1 + ((r_ & 1) ? n1 - 1 - (bx - 32) : bx - 32);
                  moba_gate_item(lds, k & 63, k & 63, 31 - (k >> 6), QP, kmean, gcnt, GL); }
              for (int r_ = 0; head + r_ * G < 64 * 31; ++r_) { const int k = head + r_ * G + ((r_ & 1) ? G - 1 - bx : bx);
                  if (k < 64 * 31) moba_gate_item(lds, k & 63, k & 63, 31 - (k >> 6), QP, kmean, gcnt, GL); } }
            XBAR(121, G);
            LAS int* pfx = (LAS int*)(lds + LDS_BYTES - 12288);
            { __syncthreads();
              int v4[4], v = 0;
#pragma unroll
              for (int q4 = 0; q4 < 4; ++q4) { const int i = 4 * tid + q4; v4[q4] = (int)((gcnt[(i & 63) * 32 + (i >> 6)] + 511u) >> 9); v += v4[q4]; }
              const int mine = v;
#pragma unroll
              for (int o = 1; o < 64; o <<= 1) { const int t_ = __shfl_up(v, o); if (lane >= o) v += t_; }
              LAS int* wtot = pfx + 2048;
              if (lane == 63) wtot[wave] = v;
              __syncthreads();
              int add = v - mine;
#pragma unroll
              for (int w_ = 0; w_ < 8; ++w_) add += (w_ < wave) ? wtot[w_] : 0;
#pragma unroll
              for (int q4 = 0; q4 < 4; ++q4) { add += v4[q4]; pfx[4 * tid + q4] = add; }
              __syncthreads(); }
            const int nitems = pfx[2047];
            moba_part_phase(lds, pfx, nitems, mbi, nmb, QP, KP, VP, kamax, gcnt, GL, PO, PL);
            XBAR(122, G);
            MB_QUEUE(64 * 32, {
                const int bh = k & 63, qb = 31 - (k >> 6);
                moba_comb_item(lds, bh, bh, qb, QP, KP, VP, kamax, PO, PL); });
#undef MB_QUEUE
        }
    }
    SEAM(2);
    if (IN(3)) {
        pg8::Gemm g{pg8::a_rowmajor(XN, D), WG, T, 2 * D, D}; pg8::PairOrder S; S.base.init(T, D, G, bx);
        EpiGate E{RAT, SGB};
        pg8::gemm_phase<EpiGate, true, pg8::PairOrder>(lds, g, S, E);
        asm volatile("s_waitcnt vmcnt(0)" ::: "memory"); __syncthreads();
    }
    if (IN(4)) {
        {
        pg8::AView av; av.b0 = (const char*)QP; av.b1 = (const char*)QI - 16 * MiB; av.tsplit = 16; av.bstride = 16 * MiB; av.tstride = 256 * 64 * 2; av.kstride = 1 * MiB; av.lda = 64;
        pg8::Gemm g{av, WBR, T, D, 2 * D}; pg8::StaticOrder S; S.init(T, D, G, bx);
        EpiMerged E{RAT, SGB, MG};
        pg8::gemm_phase<EpiMerged, true>(lds, g, S, E);
            }
#if (DUP_MASK >> 4) & 1
        {
        pg8::AView av; av.b0 = (const char*)QP; av.b1 = (const char*)QI - 16 * MiB; av.tsplit = 16; av.bstride = 16 * MiB; av.tstride = 256 * 64 * 2; av.kstride = 1 * MiB; av.lda = 64;
        pg8::Gemm g{av, WBR, T, D, 2 * D}; pg8::StaticOrder S; S.init(T, D, G, bx);
        EpiMerged E{RAT, SGB, MG};
        pg8::gemm_phase<EpiMerged, true>(lds, g, S, E);
            }
#endif
    }
    SEAM(4);
    if (IN(5)) {
        pg8::Gemm g{pg8::a_rowmajor(MG, D), WOUT, T, D, D}; pg8::StaticOrder S; S.init(T, D, G, bx);
        EpiRes<false> E{a.x, HB, ssq1};
        pg8::gemm_phase<EpiRes<false>, true>(lds, g, S, E);
    }
    SEAM(5);
    if (IN(6)) {
        {
        pg8::Gemm g{pg8::a_rowmajor(HB, D), WQ, T, D, D}; pg8::StaticOrder S; S.init(T, D, G, bx);
        EpiScaleRow E{ssq1, QX, XSCALE};
        pg8::gemm_phase<EpiScaleRow, true>(lds, g, S, E);
#if STAGE_XATTN
        asm volatile("s_waitcnt vmcnt(0)" ::: "memory"); __syncthreads();
        for (int i = 0;; ++i) { const int u = pg8::so_unit(T / 256, D / 256, G, bx, i); if (u < 0) break; xattn_unit(lds, (u >> 16) >> 5, u & 0xffff, 256 * (u >> 16), QX, KX, VX, OX); }
#endif
            }
#if (DUP_MASK >> 6) & 1
        {
        pg8::Gemm g{pg8::a_rowmajor(HB, D), WQ, T, D, D}; pg8::StaticOrder S; S.init(T, D, G, bx);
        EpiScaleRow E{ssq1, QX, XSCALE};
        pg8::gemm_phase<EpiScaleRow, true>(lds, g, S, E);
#if STAGE_XATTN
        asm volatile("s_waitcnt vmcnt(0)" ::: "memory"); __syncthreads();
        for (int i = 0;; ++i) { const int u = pg8::so_unit(T / 256, D / 256, G, bx, i); if (u < 0) break; xattn_unit(lds, (u >> 16) >> 5, u & 0xffff, 256 * (u >> 16), QX, KX, VX, OX); }
#endif
            }
#endif
    }
#if !STAGE_XATTN
    SEAM(6);
#endif
    if (IN(7)) {
#if STAGE_XATTN
#else
        LAS float* qsh = (LAS float*)(lds + wave * 2048); LAS float* psh = qsh + 256;
        for (int it = gw; it < T * XH; it += NGW) {
            const int tok = it >> 2, hx = it & 3, b = tok >> 13;
            { const u32x2 w = *(const u32x2*)(QX + (size_t)tok * D + hx * 256 + 4 * lane); qsh[4 * lane] = bflo(w.x); qsh[4 * lane + 1] = bfhi(w.x); qsh[4 * lane + 2] = bflo(w.y); qsh[4 * lane + 3] = bfhi(w.y); }
            asm volatile("s_waitcnt lgkmcnt(0)" ::: "memory");
            const bf16_t* kb = KX + (size_t)(b * 4 + hx) * 256 * 256; const bf16_t* vb = VX + (size_t)(b * 4 + hx) * 256 * 256;
            float sc[4]; float mx = -INFINITY;
#pragma unroll
            for (int i = 0; i < 4; ++i) { const u32x4* kr = (const u32x4*)(kb + (size_t)(lane + 64 * i) * 256); float s_ = 0.f;
#pragma unroll 2
                for (int c = 0; c < 32; ++c) { const u32x4 w = kr[c]; f32x4 x0, x1; unpack8(w, x0, x1);
#pragma unroll
                    for (int e = 0; e < 4; ++e) s_ += x0[e] * qsh[8 * c + e] + x1[e] * qsh[8 * c + 4 + e]; }
                sc[i] = s_; mx = fmaxf(mx, s_); }
            mx = wave_max(mx); float lsum = 0.f;
#pragma unroll
            for (int i = 0; i < 4; ++i) { const float p = exp2f(sc[i] - mx); psh[lane + 64 * i] = p; lsum += p; }
            lsum = wave_sum(lsum);
            asm volatile("s_waitcnt lgkmcnt(0)" ::: "memory");
            f32x4 ov = {0.f, 0.f, 0.f, 0.f};
#pragma unroll 4
            for (int m = 0; m < 256; ++m) { const u32x2 w = *(const u32x2*)(vb + (size_t)m * 256 + 4 * lane); const float p = psh[m]; ov[0] += p * bflo(w.x); ov[1] += p * bfhi(w.x); ov[2] += p * bflo(w.y); ov[3] += p * bfhi(w.y); }
            const float rl = 1.0f / lsum; u32x2 w; w.x = cvt_pk_bf16(ov[0] * rl, ov[1] * rl); w.y = cvt_pk_bf16(ov[2] * rl, ov[3] * rl);
            *(u32x2*)(OX + (size_t)tok * D + hx * 256 + 4 * lane) = w;
        }
#endif
    }
    SEAM(7);
    if (IN(8)) {
        pg8::Gemm g{pg8::a_rowmajor(OX, D), WO, T, D, D}; pg8::StaticOrder S; S.init(T, D, G, bx);
        EpiRes<true> E{HB, HB, ssq2};
        pg8::gemm_phase<EpiRes<true>, true>(lds, g, S, E);
    }
    SEAM(8);
    if (IN(9)) {
        pg8::Gemm g{pg8::a_rowmajor(HB, D), WFI, T, 2 * FFN, D}; pg8::StaticOrder S; S.init(T, 2 * FFN, G, bx);
        EpiSwiglu E{ssq2, ACT};
        pg8::gemm_phase<EpiSwiglu, true>(lds, g, S, E);
    }
    SEAM(9);
    if (IN(10)) {
        pg8::Gemm g{pg8::a_rowmajor(ACT, FFN), WFO, T, D, FFN}; pg8::StaticOrder S; S.init(T, D, G, bx);
        EpiRes<true> E{HB, HB, ssq3};
        pg8::gemm_phase<EpiRes<true>, true>(lds, g, S, E);
    }
    SEAM(10);
    if (IN(11)) {
        f32x4 gg[4];
#pragma unroll
        for (int j = 0; j < 4; ++j) gg[j] = ((const f32x4*)a.g_fin)[lane + 64 * j];
        for (int m0 = gw; m0 < T; m0 += 4 * NGW) {
            u32x2 hw[4][4]; float rs[4];
#pragma unroll
            for (int q = 0; q < 4; ++q) { const int m = m0 + q * NGW; const u32x2* hrow = (const u32x2*)(HB + (size_t)m * D);
#pragma unroll
                for (int j = 0; j < 4; ++j) hw[q][j] = hrow[lane + 64 * j];
                rs[q] = ssq3[m]; }
#pragma unroll
            for (int q = 0; q < 4; ++q) { const int m = m0 + q * NGW; const float rstd = rsqrtf(rs[q] * (1.0f / D) + EPS); f32x4* row = (f32x4*)(a.out + (size_t)m * D);
#pragma unroll
                for (int j = 0; j < 4; ++j) { const u32x2 w = hw[q][j]; row[lane + 64 * j] = (f32x4){bflo(w.x), bfhi(w.x), bflo(w.y), bfhi(w.y)} * rstd * gg[j]; } }
        }
    }
#undef IN
#undef SEAM
}
#undef kmean
#undef kamax
#undef ssq1
#undef ssq2
#undef ssq3
#undef WZ
#undef WG
#undef WBR
#undef WOUT
#undef WQ
#undef WKV
#undef WO
#undef WFI
#undef WFO
#undef RC
#undef RS
#undef MEMN
#undef KX
#undef VX
#undef E1
#undef E2
#undef XN
#undef HB
#undef QP
#undef QX
#undef QI
#undef OX
#undef KI
#undef RAT
#undef VB
#undef SGB
#undef OG
#undef MG
#undef ACT
#undef KP
#undef VP
#undef H

constexpr int N_PHASES = 12;
extern "C" void kernel_launch(void* const* d_in, const int* in_sizes, int n_in, void* d_out, int out_size, void* d_ws, size_t ws_size, hipStream_t stream) {
    static int grid = 0;
    if (grid == 0) {
        if (n_in != 19 || in_sizes[0] != T * D || out_size != T * D || ws_size < WS_END) { fprintf(stderr, "kernel_launch: unexpected shapes (n_in %d, in0 %d, out %d, ws %zu)\n", n_in, n_in > 0 ? in_sizes[0] : -1, out_size, ws_size); grid = -1; return; }
        int dev = 0, cus = 0, per_cu = 0;
        hipGetDevice(&dev); hipDeviceGetAttribute(&cus, hipDeviceAttributeMultiprocessorCount, dev);
        hipFuncSetAttribute((const void*)mega_fwd, hipFuncAttributeMaxDynamicSharedMemorySize, LDS_BYTES);
        if (hipOccupancyMaxActiveBlocksPerMultiprocessor(&per_cu, (const void*)mega_fwd, 512, LDS_BYTES) != hipSuccess || per_cu < 1) { fprintf(stderr, "kernel_launch: occupancy query says %d blocks/CU\n", per_cu); per_cu = 1; }
        (void)hipGetLastError();
        grid = cus;
    }
    if (grid < 0) return;
    hipMemsetAsync((char*)d_ws + WS_CTL, 0, CTL_ZERO_BYTES, stream);
    Args a{};
    a.x = (const float*)d_in[0]; a.mem = (const float*)d_in[1]; a.pos = (const int*)d_in[2]; a.g_mix = (const float*)d_in[3]; a.w_in = (const float*)d_in[4]; a.lbl = (const float*)d_in[5];
    a.g_hgrn = (const float*)d_in[6]; a.w_bra = (const float*)d_in[7]; a.w_brh = (const float*)d_in[8]; a.w_out = (const float*)d_in[9]; a.g_x = (const float*)d_in[10]; a.g_mem = (const float*)d_in[11];
    a.wq = (const float*)d_in[12]; a.wkv = (const float*)d_in[13]; a.wo = (const float*)d_in[14]; a.g_ffn = (const float*)d_in[15]; a.w_ffi = (const float*)d_in[16]; a.w_ffo = (const float*)d_in[17]; a.g_fin = (const float*)d_in[18];
    a.out = (float*)d_out; a.ws = (unsigned char*)d_ws;
#if MK_N_LAUNCHES == 1
    a.ph_lo = 0; a.ph_hi = N_PHASES;
    void* args[] = {&a};
    hipError_t e = hipLaunchCooperativeKernel((const void*)mega_fwd, dim3(grid), dim3(512), args, LDS_BYTES, stream);
    if (e != hipSuccess) fprintf(stderr, "cooperative launch failed: %s (grid %d)\n", hipGetErrorString(e), grid);
#else
    for (int p = 0; p < N_PHASES; ++p) { a.ph_lo = p; a.ph_hi = p + 1; hipLaunchKernelGGL(mega_fwd, dim3(grid), dim3(512), LDS_BYTES, stream, a); }
#endif
}
```

```cpp
#include <hip/hip_runtime.h>
#include <hip/hip_cooperative_groups.h>
#include <cstdio>
#include <cstdint>
namespace cg = cooperative_groups;

#ifndef MK_N_LAUNCHES
#define MK_N_LAUNCHES 1
#endif

#ifndef STAGE_HGRN
#define STAGE_HGRN 1
#endif
#ifndef STAGE_MOBA
#define STAGE_MOBA 1
#endif
#ifndef STAGE_XATTN
#define STAGE_XATTN 1
#endif
#define LAS __attribute__((address_space(3)))
typedef unsigned short bf16_t;
typedef short bf16x8 __attribute__((ext_vector_type(8)));
typedef float f32x4 __attribute__((ext_vector_type(4)));
typedef float f32x2 __attribute__((ext_vector_type(2)));
typedef unsigned u32x4 __attribute__((ext_vector_type(4)));
typedef unsigned u32x2 __attribute__((ext_vector_type(2)));

constexpr int NB = 4, SEQ = 8192, T = NB * SEQ, D = 1024;
constexpr int AH = 16, AHD = 64, NBLK = 32;
constexpr int BH = 8, BDK = 128, BDV = 128, NCH = SEQ / 64;
constexpr int XH = 4, XHD = 256, NMEM = 256;
constexpr int FFN = 2816;
constexpr int ZN = 7168;
constexpr float EPS = 1e-6f;
constexpr float LOG2E = 1.4426950408889634f;
constexpr float QSCALE = 0.125f * LOG2E;
constexpr float XSCALE = 0.0625f * LOG2E;
constexpr float DKS = 0.08838834764831845f;

constexpr size_t MiB = 1u << 20;
constexpr size_t WS_CTL = 0, CTL_ZERO_BYTES = 2 * MiB;
constexpr size_t CTL_KMEAN = 64 * 1024;
constexpr size_t CTL_KAMAX = CTL_KMEAN + 512 * 1024;
constexpr size_t CTL_SSQ1 = 1 * MiB, CTL_SSQ2 = CTL_SSQ1 + 128 * 1024, CTL_SSQ3 = CTL_SSQ2 + 128 * 1024;
constexpr size_t WS_WZ = 4 * MiB, WS_WG = 18 * MiB, WS_WBR = 22 * MiB, WS_WOUT = 26 * MiB, WS_WQ = 28 * MiB, WS_WKV = 30 * MiB, WS_WO = 34 * MiB, WS_WFI = 36 * MiB, WS_WFO = 47 * MiB;
constexpr size_t WS_RC = 53 * MiB, WS_RS = 57 * MiB, WS_MEMN = 61 * MiB, WS_KX = 63 * MiB, WS_VX = 65 * MiB, WS_E1 = 67 * MiB, WS_E2 = 69 * MiB;
constexpr size_t WS_XN = 72 * MiB;
constexpr size_t WS_Q = 136 * MiB;
constexpr size_t WS_QI = 200 * MiB;
constexpr size_t WS_KI = 264 * MiB;
constexpr size_t WS_VB = 328 * MiB;
constexpr size_t WS_OG = 392 * MiB;
constexpr size_t WS_ACT = 264 * MiB;
constexpr size_t WS_END = 512 * MiB;

typedef __bf16 bf16x2_t __attribute__((ext_vector_type(2)));
__device__ __forceinline__ unsigned cvt_pk_bf16(float lo, float hi) { const f32x2 v = {lo, hi}; const bf16x2_t b = __builtin_convertvector(v, bf16x2_t); return __builtin_bit_cast(unsigned, b); }
__device__ __forceinline__ float bf2f(bf16_t h) { return __uint_as_float(((unsigned)h) << 16); }
__device__ __forceinline__ float bflo(unsigned w) { return __uint_as_float(w << 16); }
__device__ __forceinline__ float bfhi(unsigned w) { return __uint_as_float(w & 0xffff0000u); }
__device__ __forceinline__ bf16_t f2bf(float f) { return (bf16_t)(cvt_pk_bf16(f, 0.f) & 0xffffu); }
__device__ __forceinline__ float sigmoidf_(float x) { return __builtin_amdgcn_rcpf(1.0f + __expf(-x)); }
template <int N> __device__ __forceinline__ float dpp_row_shr(float v) { return __builtin_bit_cast(float, __builtin_amdgcn_update_dpp(0, __builtin_bit_cast(int, v), 0x110 + N, 0xf, 0xf, false)); }
template <int N> __device__ __forceinline__ float dpp_row_share(float v) { return __builtin_bit_cast(float, __builtin_amdgcn_update_dpp(0, __builtin_bit_cast(int, v), 0x150 + N, 0xf, 0xf, false)); }
__device__ __forceinline__ float wave_sum(float v) {
#pragma unroll
    for (int o = 1; o < 64; o <<= 1) v += __shfl_xor(v, o);
    return v;
}
__device__ __forceinline__ float wave_max(float v) {
#pragma unroll
    for (int o = 1; o < 64; o <<= 1) v = fmaxf(v, __shfl_xor(v, o));
    return v;
}
__device__ __forceinline__ u32x4 pack8(const f32x4& a, const f32x4& b) { u32x4 w; w.x = cvt_pk_bf16(a[0], a[1]); w.y = cvt_pk_bf16(a[2], a[3]); w.z = cvt_pk_bf16(b[0], b[1]); w.w = cvt_pk_bf16(b[2], b[3]); return w; }
__device__ __forceinline__ void unpack8(const u32x4& w, f32x4& a, f32x4& b) { a = (f32x4){bflo(w.x), bfhi(w.x), bflo(w.y), bfhi(w.y)}; b = (f32x4){bflo(w.z), bfhi(w.z), bflo(w.w), bfhi(w.w)}; }

namespace pg8 {
constexpr int BM = 256, BK = 64, HALF = 128, HTB = HALF * BK * 2, STAGE_BYTES = 8 * HTB, NXCD = 8, WGM = 8;
__host__ __device__ __forceinline__ int lds_byte(int r, int c) { const int st = (r >> 4) * 2 + (c >> 5), rr = r & 15, cc = c & 31, ob = rr * 64 + cc * 2; return st * 1024 + (ob ^ (((ob >> 9) & 1) << 5)); }
__host__ __device__ __forceinline__ void stage_rc(int b, int& R, int& C) { const int st = b / 1024, sb = b % 1024, swz = sb ^ (((sb >> 9) & 1) << 5); R = (st >> 1) * 16 + swz / 64; C = (st & 1) * 32 + (swz % 64) / 2; }
struct Unit { int pm, pn; };
struct AView {
    const char* b0; const char* b1; int tsplit; long bstride, tstride, kstride; int lda;
    __device__ __forceinline__ const char* ptr(int pm, int t) const { return (t < tsplit ? b0 : b1) + (long)(pm >> 5) * bstride + (long)(pm & 31) * tstride + (long)t * kstride; }
};
__device__ __forceinline__ AView a_rowmajor(const void* A, int lda) { AView v; v.b0 = (const char*)A; v.b1 = (const char*)A; v.tsplit = 1 << 30; v.tstride = (long)256 * lda * 2; v.bstride = 32 * v.tstride; v.kstride = 128; v.lda = lda; return v; }
struct Gemm { AView A; const bf16_t* Bt; int M, N, K; };
struct StaticOrder {
    int nM, nN, nwg, G, c;
    __device__ void init(int M, int N, int G_, int c_) { nM = M / BM; nN = N / BM; nwg = nM * nN; G = G_; c = c_; }
    __device__ bool next(int i, Unit& u) const {
        const long L = (long)i * G + c; if (L >= nwg) return false;
        int wgid = (int)L; { const int q = nwg / NXCD, r = nwg % NXCD, xcd = wgid % NXCD, off = wgid / NXCD; wgid = (xcd < r ? xcd * (q + 1) : r * (q + 1) + (xcd - r) * q) + off; }
        const int nig = WGM * nN, gid = wgid / nig, fm = gid * WGM, gsz = (nM - fm) < WGM ? (nM - fm) : WGM;
        u.pm = fm + ((wgid % nig) % gsz); u.pn = (wgid % nig) / gsz; return true;
    }
};
__device__ __forceinline__ int so_unit(int nM, int nN, int G, int c, int i) {
    const int nwg = nM * nN; const long L = (long)i * G + c; if (L >= nwg) return -1;
    int wgid = (int)L; { const int q = nwg / NXCD, r = nwg % NXCD, xcd = wgid % NXCD, off = wgid / NXCD; wgid = (xcd < r ? xcd * (q + 1) : r * (q + 1) + (xcd - r) * q) + off; }
    const int nig = WGM * nN, gid = wgid / nig, fm = gid * WGM, gsz = (nM - fm) < WGM ? (nM - fm) : WGM;
    return ((fm + ((wgid % nig) % gsz)) << 16) | ((wgid % nig) / gsz);
}
struct PairOrder { StaticOrder base;
    __device__ bool next(int i, Unit& u) const { Unit v; if (!base.next(i >> 1, v)) return false; u.pm = v.pm; u.pn = 2 * v.pn + (i & 1); return true; } };
template <class Epi, bool ALIGN_EPI, class Sched = StaticOrder>
__device__ __forceinline__ void gemm_phase(LAS unsigned char* lds, const Gemm g, const Sched& S, const Epi& E) {
    const int tid = threadIdx.x, wid = __builtin_amdgcn_readfirstlane(tid >> 6), lane = tid & 63, wr = wid >> 2, wc = wid & 3, fr = lane & 15, fq = lane >> 4;
    const int K = g.K, nt = K / BK;
    unsigned voffA[2], voffB[2];
#pragma unroll
    for (int i = 0; i < 2; ++i) { int R, C; stage_rc(tid * 16 + i * 8192, R, C); voffA[i] = (unsigned)(R * g.A.lda + C) * 2u; voffB[i] = (unsigned)(R * K + C) * 2u; }
    const size_t hstepA = (size_t)HALF * g.A.lda * 2, hstepB = (size_t)HALF * K * 2, tstepB = 2 * hstepB, kstep = 128;
    const unsigned ldsw = (unsigned)wid * 1024u;
    const int aoff = lds_byte(wr * 64 + fr, fq * 8), boff = lds_byte(wc * 32 + fr, fq * 8);
#define PG8_SA(b, h) (((b) * 2 + (h)) * HTB)
#define PG8_SB(b, h) ((4 + (b) * 2 + (h)) * HTB)
#define PG8_STAGE(bufoff, gbase, voff) do { _Pragma("unroll") for (int _i = 0; _i < 2; ++_i) \
        __builtin_amdgcn_global_load_lds((const unsigned*)((const char*)(gbase) + (voff)[_i]), (LAS unsigned*)(lds + (bufoff) + ldsw + _i * 8192), 16, 0, 0); } while (0)
#define PG8_LDA(dst, b, h) do { _Pragma("unroll") for (int m = 0; m < 4; ++m) _Pragma("unroll") for (int k = 0; k < 2; ++k) dst[m][k] = *(const LAS bf16x8*)(lds + PG8_SA(b, h) + aoff + m * 2048 + k * 1024); } while (0)
#define PG8_LDB(dst, b, h) do { _Pragma("unroll") for (int n = 0; n < 2; ++n) _Pragma("unroll") for (int k = 0; k < 2; ++k) dst[n][k] = *(const LAS bf16x8*)(lds + PG8_SB(b, h) + boff + n * 2048 + k * 1024); } while (0)
#define PG8_MMA(ai, bj, At, Bt) do { __builtin_amdgcn_s_setprio(1); _Pragma("unroll") for (int m = 0; m < 4; ++m) _Pragma("unroll") for (int n = 0; n < 2; ++n) _Pragma("unroll") for (int k = 0; k < 2; ++k) \
        acc[ai][bj][m][n] = __builtin_amdgcn_mfma_f32_16x16x32_bf16(Bt[n][k], At[m][k], acc[ai][bj][m][n], 0, 0, 0); __builtin_amdgcn_s_setprio(0); } while (0)
#define PG8_WAIT_V(n) asm volatile("s_waitcnt vmcnt(" #n ")" ::: "memory")
#define PG8_WAIT_L(n) asm volatile("s_waitcnt lgkmcnt(" #n ")" ::: "memory")
#define PG8_BAR __builtin_amdgcn_s_barrier()
#define PG8_SCHED __builtin_amdgcn_sched_barrier(0)
    Unit cur, nxt; int ui = 0;
    if (!S.next(0, cur)) return;
    f32x4 acc[2][2][4][2];
#pragma unroll
    for (int a = 0; a < 2; ++a)
#pragma unroll
        for (int b = 0; b < 2; ++b)
#pragma unroll
            for (int m = 0; m < 4; ++m)
#pragma unroll
                for (int n = 0; n < 2; ++n) acc[a][b][m][n] = (f32x4){0.f, 0.f, 0.f, 0.f};
    bf16x8 At[4][2], B0[2][2], B1[2][2];
    const char* cB = (const char*)g.Bt + (size_t)cur.pn * tstepB;
    {
        const char* cA = g.A.ptr(cur.pm, 0); const char* cA1 = g.A.ptr(cur.pm, 1);
        PG8_STAGE(PG8_SB(0, 0), cB, voffB); PG8_STAGE(PG8_SB(0, 1), cB + hstepB, voffB); PG8_STAGE(PG8_SA(0, 0), cA, voffA); PG8_STAGE(PG8_SA(0, 1), cA + hstepA, voffA);
        if (wr == 1) PG8_BAR;
        PG8_WAIT_V(2); PG8_BAR;
        PG8_STAGE(PG8_SB(1, 0), cB + kstep, voffB); PG8_STAGE(PG8_SA(1, 0), cA1, voffA); PG8_STAGE(PG8_SB(1, 1), cB + hstepB + kstep, voffB);
        PG8_WAIT_V(6); PG8_BAR;
    }
    for (;;) {
        const bool has_next = S.next(ui + 1, nxt);
        const int npm = has_next ? nxt.pm : cur.pm;
        const char* nB = has_next ? (const char*)g.Bt + (size_t)nxt.pn * tstepB : cB;
        for (int t = 0; t < nt; t += 2) {
            const bool last = (t == nt - 2);
            if constexpr (Epi::MID) { if (t == (nt >> 1)) E.mid(acc, cur, wr, wc, fr, fq); }
            const char* a1 = g.A.ptr(cur.pm, t + 1);
            const char* a2 = last ? g.A.ptr(npm, 0) : g.A.ptr(cur.pm, t + 2);
            const char* a3 = last ? g.A.ptr(npm, 1) : g.A.ptr(cur.pm, t + 3);
            const char* b2 = last ? nB : cB + (size_t)(t + 2) * kstep;
            const char* b3 = b2 + kstep;
            PG8_LDB(B0, 0, 0); PG8_LDB(B1, 0, 1); PG8_SCHED; PG8_LDA(At, 0, 0); PG8_STAGE(PG8_SA(1, 1), a1 + hstepA, voffA);
            PG8_WAIT_V(8); PG8_WAIT_L(0); PG8_BAR; PG8_MMA(0, 0, At, B0); PG8_MMA(0, 1, At, B1); PG8_BAR; PG8_SCHED;
            PG8_LDA(At, 0, 1); PG8_STAGE(PG8_SB(0, 0), b2, voffB); PG8_STAGE(PG8_SB(0, 1), b2 + hstepB, voffB); PG8_STAGE(PG8_SA(0, 0), a2, voffA);
            PG8_WAIT_V(8); PG8_WAIT_L(0); PG8_BAR; PG8_MMA(1, 0, At, B0); PG8_MMA(1, 1, At, B1); PG8_BAR; PG8_SCHED;
            PG8_LDB(B0, 1, 0); PG8_LDB(B1, 1, 1); PG8_SCHED; PG8_LDA(At, 1, 0); PG8_STAGE(PG8_SA(0, 1), a2 + hstepA, voffA);
            PG8_WAIT_V(8); PG8_WAIT_L(0); PG8_BAR; PG8_MMA(0, 0, At, B0); PG8_MMA(0, 1, At, B1); PG8_BAR; PG8_SCHED;
            PG8_LDA(At, 1, 1); PG8_STAGE(PG8_SB(1, 0), b3, voffB); PG8_STAGE(PG8_SB(1, 1), b3 + hstepB, voffB); PG8_STAGE(PG8_SA(1, 0), a3, voffA);
            PG8_WAIT_V(8); PG8_WAIT_L(0); PG8_BAR; PG8_MMA(1, 0, At, B0); PG8_MMA(1, 1, At, B1); PG8_BAR; PG8_SCHED;
        }
        if constexpr (ALIGN_EPI) { if (wr == 0) PG8_BAR; }
        E(acc, cur, wr, wc, fr, fq);
        if (!has_next) break;
#pragma unroll
        for (int a = 0; a < 2; ++a)
#pragma unroll
            for (int b = 0; b < 2; ++b)
#pragma unroll
                for (int m = 0; m < 4; ++m)
#pragma unroll
                    for (int n = 0; n < 2; ++n) acc[a][b][m][n] = (f32x4){0.f, 0.f, 0.f, 0.f};
        cur = nxt; cB = nB; ++ui;
        if constexpr (ALIGN_EPI) { if (wr == 1) PG8_BAR; }
    }
    PG8_WAIT_V(0);
    if constexpr (!ALIGN_EPI) { if (wr == 0) PG8_BAR; }
    PG8_BAR;
#undef PG8_SA
#undef PG8_SB
#undef PG8_STAGE
#undef PG8_LDA
#undef PG8_LDB
#undef PG8_MMA
#undef PG8_WAIT_V
#undef PG8_WAIT_L
#undef PG8_BAR
#undef PG8_SCHED
}
}
typedef f32x4 Acc[2][2][4][2];

__host__ __device__ __forceinline__ int perm8(int p) { return (p & ~31) | (((p >> 2) & 3) << 3) | (((p >> 4) & 1) << 2) | (p & 3); }

struct EpiZ {
    static constexpr bool MID = false;
    bf16_t *Q, *Kp, *Vp, *QI, *KI, *VB, *OG; float *E1, *E2; const float *rc, *rs; float* kmean; unsigned* kamax; const float* lbl;
    __device__ __forceinline__ void mid(Acc&, const pg8::Unit&, int, int, int, int) const {}
    template <bool ISK> __device__ __forceinline__ void rope_sec(bf16_t* dst, const Acc& acc, const pg8::Unit& u, int wr, int wc, int fr, int fq) const {
        const int pn = u.pn, b = u.pm >> 5, s0 = (u.pm & 31) * 256;
        const int dlo = 16 * (wc & 1) + 4 * fq;
#pragma unroll
        for (int bj = 0; bj < 2; ++bj) {
            const int plane = b * 16 + 4 * (pn & 3) + 2 * bj + (wc >> 1);
            f32x4 slo = {0.f, 0.f, 0.f, 0.f}, shi = {0.f, 0.f, 0.f, 0.f}; float amax = 0.f;
#pragma unroll
            for (int ai = 0; ai < 2; ++ai)
#pragma unroll
                for (int m = 0; m < 4; ++m) {
                    const int s = s0 + 128 * ai + 64 * wr + 16 * m + fr; const size_t tok = (size_t)b * SEQ + s;
                    const f32x4 c4 = *(const f32x4*)(rc + tok * 32 + dlo), s4 = *(const f32x4*)(rs + tok * 32 + dlo);
                    const f32x4 lo = acc[ai][bj][m][0], hi = acc[ai][bj][m][1];
                    f32x4 olo = lo * c4 - hi * s4, ohi = hi * c4 + lo * s4;
                    if (!ISK) { olo = olo * QSCALE; ohi = ohi * QSCALE; }
                    else { slo += olo; shi += ohi;
#pragma unroll
                        for (int j = 0; j < 4; ++j) amax = fmaxf(amax, fmaxf(fabsf(olo[j]), fabsf(ohi[j]))); }
                    bf16_t* p = dst + ((size_t)plane * SEQ + s) * 64 + dlo;
                    u32x2 w0, w1; w0.x = cvt_pk_bf16(olo[0], olo[1]); w0.y = cvt_pk_bf16(olo[2], olo[3]); w1.x = cvt_pk_bf16(ohi[0], ohi[1]); w1.y = cvt_pk_bf16(ohi[2], ohi[3]);
                    *(u32x2*)p = w0; *(u32x2*)(p + 32) = w1;
                }
            if (ISK) {
#pragma unroll
                for (int j = 0; j < 4; ++j) {
                    slo[j] += dpp_row_shr<1>(slo[j]); slo[j] += dpp_row_shr<2>(slo[j]); slo[j] += dpp_row_shr<4>(slo[j]); slo[j] += dpp_row_shr<8>(slo[j]);
                    shi[j] += dpp_row_shr<1>(shi[j]); shi[j] += dpp_row_shr<2>(shi[j]); shi[j] += dpp_row_shr<4>(shi[j]); shi[j] += dpp_row_shr<8>(shi[j]); }
                amax = wave_max(amax);
                if (fr == 15) { float* km = kmean + ((size_t)plane * NBLK + (u.pm & 31)) * 64 + dlo;
#pragma unroll
                    for (int j = 0; j < 4; ++j) { atomicAdd(km + j, slo[j]); atomicAdd(km + 32 + j, shi[j]); } }
                if ((threadIdx.x & 63) == 0) atomicMax(kamax + plane, __float_as_uint(amax));
            }
        }
    }
    template <bool ACT> __device__ __forceinline__ void plane_sec(bf16_t* dst, int pbase, const Acc& acc, const pg8::Unit& u, int wr, int wc, int fr, int fq) const {
        const int b = u.pm >> 5, s0 = (u.pm & 31) * 256, dc0 = 32 * (wc & 1) + 8 * fq;
#pragma unroll
        for (int bj = 0; bj < 2; ++bj) {
            const int plane = b * 16 + pbase + 2 * bj + (wc >> 1);
#pragma unroll
            for (int ai = 0; ai < 2; ++ai)
#pragma unroll
                for (int m = 0; m < 4; ++m) {
                    const int s = s0 + 128 * ai + 64 * wr + 16 * m + fr;
                    f32x4 v0 = acc[ai][bj][m][0], v1 = acc[ai][bj][m][1];
                    if (ACT) {
#pragma unroll
                        for (int j = 0; j < 4; ++j) { v0[j] = v0[j] * sigmoidf_(v0[j]); v1[j] = v1[j] * sigmoidf_(v1[j]); } }
                    *(u32x4*)(dst + ((size_t)plane * SEQ + s) * 64 + dc0) = pack8(v0, v1);
                }
        }
    }
    __device__ __forceinline__ void qf_sec(const Acc& acc, const pg8::Unit& u, int wr, int wc, int fr, int fq) const {
        const int b = u.pm >> 5, s0 = (u.pm & 31) * 256;
        {
            const int h = u.pn, hp = b * 16 + 2 * h + (wc >> 1);
#pragma unroll
            for (int nn = 0; nn < 2; ++nn) {
                const int dc0 = 32 * (wc & 1) + 8 * fq + 4 * nn, lcol = h * 128 + 32 * wc + 8 * fq + 4 * nn;
                float lb[4];
#pragma unroll
                for (int i = 0; i < 4; ++i) { const float l0 = lbl[lcol + i], l1 = lbl[1024 + lcol + i]; lb[i] = 1.0f / (1.0f + __expf(l1 - l0)); }
#pragma unroll
                for (int ai = 0; ai < 2; ++ai) {
                    float bcs[4][4], kk[4][4];
#pragma unroll
                    for (int m = 0; m < 4; ++m)
#pragma unroll
                        for (int i = 0; i < 4; ++i) {
                            const float zf = acc[ai][1][m][nn][i];
                            const float e = __expf(-zf), sg = __builtin_amdgcn_rcpf(1.0f + e);
                            kk[m][i] = (1.0f - lb[i]) * (e * sg);
                            float v = __logf(lb[i] + (1.0f - lb[i]) * sg);
                            v += dpp_row_shr<1>(v); v += dpp_row_shr<2>(v); v += dpp_row_shr<4>(v); v += dpp_row_shr<8>(v);
                            bcs[m][i] = v;
                        }
                    float bmid[4], blast[4];
#pragma unroll
                    for (int i = 0; i < 4; ++i) {
                        float base = 0.f;
#pragma unroll
                        for (int m = 0; m < 4; ++m) { const float tot = dpp_row_share<15>(bcs[m][i]); bcs[m][i] += base; base += tot; }
                        bmid[i] = dpp_row_share<15>(bcs[1][i]); blast[i] = dpp_row_share<15>(bcs[3][i]);
                    }
#pragma unroll
                    for (int m = 0; m < 4; ++m) {
                        const int s = s0 + 128 * ai + 64 * wr + 16 * m + fr;
                        f32x4 qv, kv;
#pragma unroll
                        for (int i = 0; i < 4; ++i) {
                            const float zq = acc[ai][0][m][nn][i];
                            const float ex = __expf(bcs[m][i] - bmid[i]);
                            qv[i] = zq * sigmoidf_(zq) * DKS * ex;
                            kv[i] = kk[m][i] * __builtin_amdgcn_rcpf(ex);
                        }
                        const size_t off = ((size_t)hp * SEQ + s) * 64 + dc0;
                        u32x2 wq_, wk_; wq_.x = cvt_pk_bf16(qv[0], qv[1]); wq_.y = cvt_pk_bf16(qv[2], qv[3]); wk_.x = cvt_pk_bf16(kv[0], kv[1]); wk_.y = cvt_pk_bf16(kv[2], kv[3]);
                        *(u32x2*)(QI + off) = wq_; *(u32x2*)(KI + off) = wk_;
                    }
                    if (fr == 15) {
                        const int chunk = (s0 + 128 * ai + 64 * wr) >> 6;
                        const size_t eo = (((size_t)(b * BH + h)) * NCH + chunk) * 128 + 32 * wc + 8 * fq + 4 * nn;
                        f32x4 a0, c0;
#pragma unroll
                        for (int i = 0; i < 4; ++i) { a0[i] = __expf(bmid[i]); c0[i] = __expf(blast[i] - bmid[i]); }
                        *(f32x4*)(E1 + eo) = a0; *(f32x4*)(E2 + eo) = c0;
                    }
                }
            }
        }
    }
};
template <bool ISK> struct EpiRope { static constexpr bool MID = false; EpiZ z;
    __device__ __forceinline__ void mid(Acc&, const pg8::Unit&, int, int, int, int) const {}
    __device__ __forceinline__ void operator()(const Acc& acc, const pg8::Unit& u, int wr, int wc, int fr, int fq) const { z.template rope_sec<ISK>(ISK ? z.Kp : z.Q, acc, u, wr, wc, fr, fq); } };
template <bool ACT> struct EpiPlane { static constexpr bool MID = false; EpiZ z; bf16_t* dst;
    __device__ __forceinline__ void mid(Acc&, const pg8::Unit&, int, int, int, int) const {}
    __device__ __forceinline__ void operator()(const Acc& acc, const pg8::Unit& u, int wr, int wc, int fr, int fq) const { z.template plane_sec<ACT>(dst, 4 * u.pn, acc, u, wr, wc, fr, fq); } };
struct EpiQF { static constexpr bool MID = false; EpiZ z;
    __device__ __forceinline__ void mid(Acc&, const pg8::Unit&, int, int, int, int) const {}
    __device__ __forceinline__ void operator()(const Acc& acc, const pg8::Unit& u, int wr, int wc, int fr, int fq) const { z.qf_sec(acc, u, wr, wc, fr, fq); } };
struct EpiKV {
    static constexpr bool MID = false;
    bf16_t *KX, *VX;
    __device__ __forceinline__ void mid(Acc&, const pg8::Unit&, int, int, int, int) const {}
    __device__ __forceinline__ void operator()(const Acc& acc, const pg8::Unit& u, int wr, int wc, int fr, int fq) const {
        bf16_t* dst = (u.pn < 4 ? KX : VX) + (size_t)(u.pm * 4 + (u.pn & 3)) * 256 * 256;
#pragma unroll
        for (int ai = 0; ai < 2; ++ai)
#pragma unroll
            for (int m = 0; m < 4; ++m) { const int r = 128 * ai + 64 * wr + 16 * m + fr;
#pragma unroll
                for (int bj = 0; bj < 2; ++bj) *(u32x4*)(dst + (size_t)r * 256 + 128 * bj + 32 * wc + 8 * fq) = pack8(acc[ai][bj][m][0], acc[ai][bj][m][1]); }
    }
};
struct EpiGate {
    static constexpr bool MID = false;
    bf16_t *RAT, *SGB;
    __device__ __forceinline__ void mid(Acc&, const pg8::Unit&, int, int, int, int) const {}
    __device__ __forceinline__ void operator()(const Acc& acc, const pg8::Unit& u, int wr, int wc, int fr, int fq) const {
        const int c0 = 128 * u.pn + 32 * wc + 8 * fq;
#pragma unroll
        for (int ai = 0; ai < 2; ++ai)
#pragma unroll
            for (int m = 0; m < 4; ++m) { const size_t r = (size_t)u.pm * 256 + 128 * ai + 64 * wr + 16 * m + fr;
                f32x4 ra[2], sb[2];
#pragma unroll
                for (int n = 0; n < 2; ++n)
#pragma unroll
                    for (int j = 0; j < 4; ++j) { const float ea = __expf(-acc[ai][0][m][n][j]), eb = __expf(-acc[ai][1][m][n][j]); sb[n][j] = __builtin_amdgcn_rcpf(1.0f + eb); ra[n][j] = (1.0f + eb) * __builtin_amdgcn_rcpf(1.0f + ea); }
                *(u32x4*)(RAT + r * D + c0) = pack8(ra[0], ra[1]); *(u32x4*)(SGB + r * D + c0) = pack8(sb[0], sb[1]); }
    }
};
struct EpiMerged {
    static constexpr bool MID = true;
    const bf16_t *RAT, *SGB; bf16_t* MG;
    __device__ __forceinline__ void mid(Acc& acc, const pg8::Unit& u, int wr, int wc, int fr, int fq) const {
        const int c0 = 256 * u.pn + 32 * wc + 8 * fq;
#pragma unroll
        for (int ai = 0; ai < 2; ++ai)
#pragma unroll
            for (int m = 0; m < 4; ++m) { const size_t r = (size_t)u.pm * 256 + 128 * ai + 64 * wr + 16 * m + fr;
#pragma unroll
                for (int bj = 0; bj < 2; ++bj) { const u32x4 wa = *(const u32x4*)(RAT + r * D + c0 + 128 * bj);
                    f32x4 a0, a1; unpack8(wa, a0, a1); acc[ai][bj][m][0] *= a0; acc[ai][bj][m][1] *= a1; }
                asm volatile("" ::: "memory"); }
    }
    __device__ __forceinline__ void operator()(const Acc& acc, const pg8::Unit& u, int wr, int wc, int fr, int fq) const {
        const int c0 = 256 * u.pn + 32 * wc + 8 * fq;
#pragma unroll
        for (int ai = 0; ai < 2; ++ai)
#pragma unroll
            for (int m = 0; m < 4; ++m) { const size_t r = (size_t)u.pm * 256 + 128 * ai + 64 * wr + 16 * m + fr;
#pragma unroll
                for (int bj = 0; bj < 2; ++bj) { const u32x4 wb = *(const u32x4*)(SGB + r * D + c0 + 128 * bj); f32x4 b0, b1; unpack8(wb, b0, b1);
                    *(u32x4*)(MG + r * D + c0 + 128 * bj) = pack8(acc[ai][bj][m][0] * b0, acc[ai][bj][m][1] * b1); } }
    }
};
template <bool RBF> struct EpiRes {
    static constexpr bool MID = false;
    const void* R; bf16_t* Hb; float* ssq;
    __device__ __forceinline__ void mid(Acc&, const pg8::Unit&, int, int, int, int) const {}
    __device__ __forceinline__ void operator()(const Acc& acc, const pg8::Unit& u, int wr, int wc, int fr, int fq) const {
        const int c0 = 256 * u.pn + 32 * wc + 4 * fq;
#pragma unroll
        for (int ai = 0; ai < 2; ++ai)
#pragma unroll
            for (int m = 0; m < 4; ++m) { const size_t r = (size_t)u.pm * 256 + 128 * ai + 64 * wr + 16 * m + fr; float ss = 0.f;
#pragma unroll
                for (int bj = 0; bj < 2; ++bj)
#pragma unroll
                    for (int n = 0; n < 2; ++n) { const size_t off = r * D + c0 + 128 * bj + 16 * n; f32x4 h = acc[ai][bj][m][n];
                        if (RBF) { const u32x2 w = *(const u32x2*)((const bf16_t*)R + off); h[0] += bflo(w.x); h[1] += bfhi(w.x); h[2] += bflo(w.y); h[3] += bfhi(w.y); }
                        else h += *(const f32x4*)((const float*)R + off);
                        ss += (h[0] * h[0] + h[1] * h[1]) + (h[2] * h[2] + h[3] * h[3]);
                        u32x2 w; w.x = cvt_pk_bf16(h[0], h[1]); w.y = cvt_pk_bf16(h[2], h[3]); *(u32x2*)(Hb + off) = w; }
                ss += __shfl_xor(ss, 16); ss += __shfl_xor(ss, 32);
                if (fq == 0) atomicAdd(ssq + r, ss); }
    }
};
struct EpiScaleRow {
    static constexpr bool MID = false;
    const float* ssq; bf16_t* O; float scale;
    __device__ __forceinline__ void mid(Acc&, const pg8::Unit&, int, int, int, int) const {}
    __device__ __forceinline__ void operator()(const Acc& acc, const pg8::Unit& u, int wr, int wc, int fr, int fq) const {
        const int c0 = 256 * u.pn + 32 * wc + 8 * fq;
#pragma unroll
        for (int ai = 0; ai < 2; ++ai)
#pragma unroll
            for (int m = 0; m < 4; ++m) { const size_t r = (size_t)u.pm * 256 + 128 * ai + 64 * wr + 16 * m + fr; const float rs = rsqrtf(ssq[r] * (1.0f / D) + EPS) * scale;
#pragma unroll
                for (int bj = 0; bj < 2; ++bj) *(u32x4*)(O + r * D + c0 + 128 * bj) = pack8(acc[ai][bj][m][0] * rs, acc[ai][bj][m][1] * rs); }
    }
};
struct EpiSwiglu {
    static constexpr bool MID = false;
    const float* ssq; bf16_t* ACT;
    __device__ __forceinline__ void mid(Acc&, const pg8::Unit&, int, int, int, int) const {}
    __device__ __forceinline__ void operator()(const Acc& acc, const pg8::Unit& u, int wr, int wc, int fr, int fq) const {
        const int c0 = 128 * u.pn + 32 * wc + 8 * fq;
#pragma unroll
        for (int ai = 0; ai < 2; ++ai)
#pragma unroll
            for (int m = 0; m < 4; ++m) { const size_t r = (size_t)u.pm * 256 + 128 * ai + 64 * wr + 16 * m + fr; const float rs = rsqrtf(ssq[r] * (1.0f / D) + EPS);
                f32x4 o[2];
#pragma unroll
                for (int n = 0; n < 2; ++n)
#pragma unroll
                    for (int j = 0; j < 4; ++j) { const float gv = acc[ai][0][m][n][j] * rs, uv = acc[ai][1][m][n][j] * rs; o[n][j] = gv * sigmoidf_(gv) * uv; }
                *(u32x4*)(ACT + r * FFN + c0) = pack8(o[0], o[1]); }
    }
};

typedef short s16x4 __attribute__((ext_vector_type(4)));
typedef short v4i16_t __attribute__((ext_vector_type(4)));
__device__ __forceinline__ s16x4 tr_read(const LAS unsigned char* p) { return __builtin_bit_cast(s16x4, __builtin_amdgcn_ds_read_tr16_b64_v4i16((LAS v4i16_t*)p)); }
__device__ __forceinline__ bf16x8 mk8(s16x4 lo, s16x4 hi) { return (bf16x8){lo[0], lo[1], lo[2], lo[3], hi[0], hi[1], hi[2], hi[3]}; }
__device__ __forceinline__ bf16x8 tr_frag(const LAS unsigned char* base, int pitch, int r0, int c0, int lane) {
    const int g = lane >> 4, i = lane & 15; const LAS unsigned char* p = base + (r0 + 8 * g + (i >> 2)) * pitch + (c0 + 4 * (i & 3)) * 2;
    return mk8(tr_read(p), tr_read(p + 4 * pitch));
}
__device__ __forceinline__ bf16x8 tr_frag_split(const LAS unsigned char* base, int pitch, int r0, int c0, int lane) {
    const int g = lane >> 4, i = lane & 15; const LAS unsigned char* p = base + (r0 + 4 * g + (i >> 2)) * pitch + (c0 + 4 * (i & 3)) * 2;
    return mk8(tr_read(p), tr_read(p + 16 * pitch));
}
__device__ __forceinline__ bf16x8 ld_frag(const LAS unsigned char* base, int pitch, int row, int col) { return *(const LAS bf16x8*)(base + row * pitch + col * 2); }
#define MFMA16(A, B, C) __builtin_amdgcn_mfma_f32_16x16x32_bf16((A), (B), (C), 0, 0, 0)
#define LDS_FADD(p, v) ((void)__hip_atomic_fetch_add((LAS float*)(p), (v), __ATOMIC_RELAXED, __HIP_MEMORY_SCOPE_WORKGROUP))

namespace hg {
constexpr int PITCH = 272;
constexpr int TILE = 64 * PITCH, HBUF = 3 * TILE;
constexpr int OFF_SP = 2 * HBUF, OFF_AM = OFF_SP + 128 * PITCH, AMP = 144, OFF_RSS = OFF_AM + 64 * AMP, OFF_E = OFF_RSS + 512, END = OFF_E + 2 * 1024;
static_assert(END <= 160 * 1024, "hgrn lds");
}
__device__ __forceinline__ void hgrn_item(LAS unsigned char* lds, int b, int h, const bf16_t* QIp, bf16_t* OUTp, size_t omask, const bf16_t* KIp, const bf16_t* VBp, const bf16_t* OGp, const float* E1p, const float* E2p, const float* gh) {
    using namespace hg;
    const int tid = threadIdx.x, lane = tid & 63, w = __builtin_amdgcn_readfirstlane(tid >> 6), c = lane & 15, g = lane >> 4;
    const size_t pl0 = ((size_t)(b * 16 + 2 * h)) * SEQ * 64, pl1 = pl0 + (size_t)SEQ * 64;
    const size_t eb = ((size_t)(b * BH + h)) * NCH * 128;
    const int tt = w >> 1, dvh = w & 1;
    f32x4 S[8];
#pragma unroll
    for (int j = 0; j < 8; ++j) S[j] = (f32x4){0.f, 0.f, 0.f, 0.f};
    f32x4 ghv[4];
#pragma unroll
    for (int jj = 0; jj < 4; ++jj) ghv[jj] = *(const f32x4*)(gh + h * 128 + 64 * dvh + 16 * jj + 4 * g);
    const size_t oplane = (dvh ? pl1 : pl0) + (size_t)(16 * tt + c) * 64 + 4 * g;
    u32x4 pq[2], pk[2], pv[2]; float pe = 0.f;
    auto issue = [&](int ch) {
#pragma unroll
        for (int k = 0; k < 2; ++k) { const int i = tid + 512 * k, row = i >> 4, pc = i & 15; const size_t src = (pc < 8 ? pl0 : pl1) + ((size_t)(64 * ch + row)) * 64 + (pc & 7) * 8;
            pq[k] = *(const u32x4*)(QIp + src); pk[k] = *(const u32x4*)(KIp + src); pv[k] = *(const u32x4*)(VBp + src); }
        if (tid < 256) pe = (tid < 128 ? E1p : E2p)[eb + (size_t)ch * 128 + (tid & 127)];
    };
    auto commit = [&](int p) {
        LAS unsigned char* bufp = lds + p * HBUF;
#pragma unroll
        for (int k = 0; k < 2; ++k) { const int i = tid + 512 * k, row = i >> 4, pc = i & 15; const int o = row * PITCH + pc * 16;
            *(LAS u32x4*)(bufp + o) = pq[k]; *(LAS u32x4*)(bufp + TILE + o) = pk[k]; *(LAS u32x4*)(bufp + 2 * TILE + o) = pv[k]; }
        if (tid < 256) ((LAS float*)(lds + OFF_E + p * 1024))[tid] = pe;
    };
    __syncthreads();
    issue(0); commit(0);
    __syncthreads();
    for (int ch = 0; ch < NCH; ++ch) {
        const int p = ch & 1;
        const LAS unsigned char* qb_ = lds + p * HBUF; const LAS unsigned char* kb_ = qb_ + TILE; const LAS unsigned char* vb_ = qb_ + 2 * TILE;
        const LAS float* e1s = (const LAS float*)(lds + OFF_E + p * 1024); const LAS float* e2s = e1s + 128;
        u32x2 ogv[4];
#pragma unroll
        for (int jj = 0; jj < 4; ++jj) ogv[jj] = *(const u32x2*)(OGp + oplane + (size_t)ch * 4096 + 16 * jj);
        issue(ch + 1 < NCH ? ch + 1 : ch);
#pragma unroll
        for (int s2 = 0; s2 < 2; ++s2) {
            const int si = 2 * (w & 1) + s2; f32x4 acc = {0.f, 0.f, 0.f, 0.f};
#pragma unroll
            for (int ks = 0; ks < 4; ++ks) acc = MFMA16(ld_frag(kb_, PITCH, 16 * si + c, 32 * ks + 8 * g), ld_frag(qb_, PITCH, 16 * tt + c, 32 * ks + 8 * g), acc);
#pragma unroll
            for (int r = 0; r < 4; ++r) acc[r] = (16 * si + 4 * g + r > 16 * tt + c) ? 0.f : acc[r];
            u32x2 w_; w_.x = cvt_pk_bf16(acc[0], acc[1]); w_.y = cvt_pk_bf16(acc[2], acc[3]);
            *(LAS u32x2*)(lds + OFF_AM + (16 * tt + c) * AMP + (16 * si + 4 * g) * 2) = w_;
        }
        {
            const f32x4 e1v = *(const LAS f32x4*)(e1s + 16 * w + 4 * g);
#pragma unroll
            for (int j = 0; j < 8; ++j) { S[j] = S[j] * e1v; u32x2 w_; w_.x = cvt_pk_bf16(S[j][0], S[j][1]); w_.y = cvt_pk_bf16(S[j][2], S[j][3]);
                *(LAS u32x2*)(lds + OFF_SP + (16 * j + c) * PITCH + (16 * w + 4 * g) * 2) = w_; }
        }
        __syncthreads();
        f32x4 o[4];
        {
            bf16x8 aq[4], aa[2];
#pragma unroll
            for (int ks = 0; ks < 4; ++ks) aq[ks] = ld_frag(qb_, PITCH, 16 * tt + c, 32 * ks + 8 * g);
#pragma unroll
            for (int j2 = 0; j2 < 2; ++j2) aa[j2] = ld_frag(lds + OFF_AM, AMP, 16 * tt + c, 32 * j2 + 8 * g);
            float ss = 0.f;
#pragma unroll
            for (int jj = 0; jj < 4; ++jj) {
                const int j = 4 * dvh + jj; f32x4 acc = {0.f, 0.f, 0.f, 0.f};
#pragma unroll
                for (int ks = 0; ks < 4; ++ks) acc = MFMA16(ld_frag(lds + OFF_SP, PITCH, 16 * j + c, 32 * ks + 8 * g), aq[ks], acc);
#pragma unroll
                for (int j2 = 0; j2 < 2; ++j2) acc = MFMA16(tr_frag(vb_, PITCH, 32 * j2, 16 * j, lane), aa[j2], acc);
                o[jj] = acc; ss += (acc[0] * acc[0] + acc[1] * acc[1]) + (acc[2] * acc[2] + acc[3] * acc[3]);
            }
            ss += __shfl_xor(ss, 16); ss += __shfl_xor(ss, 32);
            if (g == 0) ((LAS float*)(lds + OFF_RSS))[(16 * tt + c) * 2 + dvh] = ss;
        }
        __syncthreads();
        {
            const LAS float* rp = (const LAS float*)(lds + OFF_RSS) + (16 * tt + c) * 2; const float rs = rsqrtf((rp[0] + rp[1]) * (1.0f / 128.0f) + EPS);
#pragma unroll
            for (int jj = 0; jj < 4; ++jj) { const f32x4 v = o[jj] * rs * ghv[jj]; u32x2 w_;
                w_.x = cvt_pk_bf16(v[0] * bflo(ogv[jj].x), v[1] * bfhi(ogv[jj].x)); w_.y = cvt_pk_bf16(v[2] * bflo(ogv[jj].y), v[3] * bfhi(ogv[jj].y));
                *(u32x2*)(OUTp + ((oplane + (size_t)ch * 4096 + 16 * jj) & omask)) = w_; }
            bf16x8 ak[2];
#pragma unroll
            for (int k2 = 0; k2 < 2; ++k2) ak[k2] = tr_frag(kb_, PITCH, 32 * k2, 16 * w, lane);
            const f32x4 e2v = *(const LAS f32x4*)(e2s + 16 * w + 4 * g);
#pragma unroll
            for (int j = 0; j < 8; ++j) {
#pragma unroll
                for (int k2 = 0; k2 < 2; ++k2) S[j] = MFMA16(ak[k2], tr_frag(vb_, PITCH, 32 * k2, 16 * j, lane), S[j]);
                S[j] = S[j] * e2v;
            }
            commit(p ^ 1);
        }
        __syncthreads();
    }
}

namespace hg {
constexpr int NSEG = 8, SEGCH = NCH / NSEG;
}
__device__ __forceinline__ void hgrn_seg_a(LAS unsigned char* lds, int b, int h, int seg, const bf16_t* QIp, bf16_t* KIp, bf16_t* VBp, const float* E1p, const float* E2p) {
    using namespace hg;
    const int tid = threadIdx.x, lane = tid & 63, w = __builtin_amdgcn_readfirstlane(tid >> 6), c = lane & 15, g = lane >> 4;
    const size_t pl0 = ((size_t)(b * 16 + 2 * h)) * SEQ * 64, pl1 = pl0 + (size_t)SEQ * 64;
    const size_t eb = ((size_t)(b * BH + h)) * NCH * 128;
    const int tt = w >> 1, dvh = w & 1, ch0 = seg * SEGCH;
    f32x4 S[8];
#pragma unroll
    for (int j = 0; j < 8; ++j) S[j] = (f32x4){0.f, 0.f, 0.f, 0.f};
    f32x4 Dv = {1.f, 1.f, 1.f, 1.f};
    const size_t oplane = (dvh ? pl1 : pl0) + (size_t)(16 * tt + c) * 64 + 4 * g;
    u32x4 pq[2], pk[2], pv[2]; float pe = 0.f;
    auto issue = [&](int ch) {
#pragma unroll
        for (int k = 0; k < 2; ++k) { const int i = tid + 512 * k, row = i >> 4, pc = i & 15; const size_t src = (pc < 8 ? pl0 : pl1) + ((size_t)(64 * ch + row)) * 64 + (pc & 7) * 8;
            pq[k] = *(const u32x4*)(QIp + src); pk[k] = *(const u32x4*)(KIp + src); pv[k] = *(const u32x4*)(VBp + src); }
        if (tid < 256) pe = (tid < 128 ? E1p : E2p)[eb + (size_t)ch * 128 + (tid & 127)];
    };
    auto commit = [&](int p) {
        LAS unsigned char* bufp = lds + p * HBUF;
#pragma unroll
        for (int k = 0; k < 2; ++k) { const int i = tid + 512 * k, row = i >> 4, pc = i & 15; const int o = row * PITCH + pc * 16;
            *(LAS u32x4*)(bufp + o) = pq[k]; *(LAS u32x4*)(bufp + TILE + o) = pk[k]; *(LAS u32x4*)(bufp + 2 * TILE + o) = pv[k]; }
        if (tid < 256) ((LAS float*)(lds + OFF_E + p * 1024))[tid] = pe;
    };
    __syncthreads();
    issue(ch0); commit(0);
    __syncthreads();
    for (int cc = 0; cc < SEGCH; ++cc) {
        const int ch = ch0 + cc, p = cc & 1;
        const LAS unsigned char* qb_ = lds + p * HBUF; const LAS unsigned char* kb_ = qb_ + TILE; const LAS unsigned char* vb_ = qb_ + 2 * TILE;
        const LAS float* e1s = (const LAS float*)(lds + OFF_E + p * 1024); const LAS float* e2s = e1s + 128;
        issue(cc + 1 < SEGCH ? ch + 1 : ch);
#pragma unroll
        for (int s2 = 0; s2 < 2; ++s2) {
            const int si = 2 * (w & 1) + s2; f32x4 acc = {0.f, 0.f, 0.f, 0.f};
#pragma unroll
            for (int ks = 0; ks < 4; ++ks) acc = MFMA16(ld_frag(kb_, PITCH, 16 * si + c, 32 * ks + 8 * g), ld_frag(qb_, PITCH, 16 * tt + c, 32 * ks + 8 * g), acc);
#pragma unroll
            for (int r = 0; r < 4; ++r) acc[r] = (16 * si + 4 * g + r > 16 * tt + c) ? 0.f : acc[r];
            u32x2 w_; w_.x = cvt_pk_bf16(acc[0], acc[1]); w_.y = cvt_pk_bf16(acc[2], acc[3]);
            *(LAS u32x2*)(lds + OFF_AM + (16 * tt + c) * AMP + (16 * si + 4 * g) * 2) = w_;
        }
        const f32x4 e1v = *(const LAS f32x4*)(e1s + 16 * w + 4 * g), e2v = *(const LAS f32x4*)(e2s + 16 * w + 4 * g);
#pragma unroll
        for (int j = 0; j < 8; ++j) { S[j] = S[j] * e1v; u32x2 w_; w_.x = cvt_pk_bf16(S[j][0], S[j][1]); w_.y = cvt_pk_bf16(S[j][2], S[j][3]);
            *(LAS u32x2*)(lds + OFF_SP + (16 * j + c) * PITCH + (16 * w + 4 * g) * 2) = w_; }
        Dv = Dv * e1v * e2v;
        __syncthreads();
        {
            bf16x8 aq[4], aa[2];
#pragma unroll
            for (int ks = 0; ks < 4; ++ks) aq[ks] = ld_frag(qb_, PITCH, 16 * tt + c, 32 * ks + 8 * g);
#pragma unroll
            for (int j2 = 0; j2 < 2; ++j2) aa[j2] = ld_frag(lds + OFF_AM, AMP, 16 * tt + c, 32 * j2 + 8 * g);
#pragma unroll
            for (int jj = 0; jj < 4; ++jj) {
                const int j = 4 * dvh + jj; f32x4 acc = {0.f, 0.f, 0.f, 0.f};
#pragma unroll
                for (int ks = 0; ks < 4; ++ks) acc = MFMA16(ld_frag(lds + OFF_SP, PITCH, 16 * j + c, 32 * ks + 8 * g), aq[ks], acc);
#pragma unroll
                for (int j2 = 0; j2 < 2; ++j2) acc = MFMA16(tr_frag(vb_, PITCH, 32 * j2, 16 * j, lane), aa[j2], acc);
                u32x2 w_; w_.x = cvt_pk_bf16(acc[0], acc[1]); w_.y = cvt_pk_bf16(acc[2], acc[3]);
                *(u32x2*)(KIp + oplane + (size_t)ch * 4096 + 16 * jj) = w_;
            }
        }
        {
            bf16x8 ak[2];
#pragma unroll
            for (int k2 = 0; k2 < 2; ++k2) ak[k2] = tr_frag(kb_, PITCH, 32 * k2, 16 * w, lane);
#pragma unroll
            for (int j = 0; j < 8; ++j) {
#pragma unroll
                for (int k2 = 0; k2 < 2; ++k2) S[j] = MFMA16(ak[k2], tr_frag(vb_, PITCH, 32 * k2, 16 * j, lane), S[j]);
                S[j] = S[j] * e2v;
            }
            commit(p ^ 1);
        }
        __syncthreads();
    }
    float* Lg = (float*)(VBp + pl0 + (size_t)seg * SEGCH * 4096); float* Dg = (float*)(VBp + pl1 + (size_t)seg * SEGCH * 4096);
#pragma unroll
    for (int j = 0; j < 8; ++j)
#pragma unroll
        for (int r = 0; r < 4; ++r) Lg[(16 * w + 4 * g + r) * 128 + 16 * j + c] = S[j][r];
    if (c == 0) *(f32x4*)(Dg + 16 * w + 4 * g) = Dv;
}
__device__ __forceinline__ void hgrn_seg_b(LAS unsigned char* lds, int b, int h, int seg, bf16_t* QIp, const bf16_t* KIp, const bf16_t* VBp, const bf16_t* OGp, const float* E1p, const float* E2p, const float* gh) {
    using namespace hg;
    const int tid = threadIdx.x, lane = tid & 63, w = __builtin_amdgcn_readfirstlane(tid >> 6), c = lane & 15, g = lane >> 4;
    const size_t pl0 = ((size_t)(b * 16 + 2 * h)) * SEQ * 64, pl1 = pl0 + (size_t)SEQ * 64;
    const size_t eb = ((size_t)(b * BH + h)) * NCH * 128;
    const int tt = w >> 1, dvh = w & 1, ch0 = seg * SEGCH;
    f32x4 S[8];
#pragma unroll
    for (int j = 0; j < 8; ++j) S[j] = (f32x4){0.f, 0.f, 0.f, 0.f};
    for (int gp = 0; gp < seg; ++gp) {
        const float* Lg = (const float*)(VBp + pl0 + (size_t)gp * SEGCH * 4096); const float* Dg = (const float*)(VBp + pl1 + (size_t)gp * SEGCH * 4096);
        const f32x4 dv_ = *(const f32x4*)(Dg + 16 * w + 4 * g);
#pragma unroll
        for (int j = 0; j < 8; ++j)
#pragma unroll
            for (int r = 0; r < 4; ++r) S[j][r] = dv_[r] * S[j][r] + Lg[(16 * w + 4 * g + r) * 128 + 16 * j + c];
    }
    f32x4 ghv[4];
#pragma unroll
    for (int jj = 0; jj < 4; ++jj) ghv[jj] = *(const f32x4*)(gh + h * 128 + 64 * dvh + 16 * jj + 4 * g);
    const size_t oplane = (dvh ? pl1 : pl0) + (size_t)(16 * tt + c) * 64 + 4 * g;
    const size_t qrow = (size_t)(16 * tt + c) * 64 + 8 * g;
    f32x4 P = {1.f, 1.f, 1.f, 1.f};
    __syncthreads();
    for (int cc = 0; cc < SEGCH; ++cc) {
        const int ch = ch0 + cc;
        bf16x8 qf[4]; u32x2 ol[4], ogv[4];
#pragma unroll
        for (int ks = 0; ks < 4; ++ks) qf[ks] = *(const bf16x8*)(QIp + ((ks >> 1) ? pl1 : pl0) + (size_t)ch * 4096 + qrow + 32 * (ks & 1));
#pragma unroll
        for (int jj = 0; jj < 4; ++jj) { ol[jj] = *(const u32x2*)(KIp + oplane + (size_t)ch * 4096 + 16 * jj); ogv[jj] = *(const u32x2*)(OGp + oplane + (size_t)ch * 4096 + 16 * jj); }
        const f32x4 e1r = *(const f32x4*)(E1p + eb + (size_t)ch * 128 + 16 * w + 4 * g), e2r = *(const f32x4*)(E2p + eb + (size_t)ch * 128 + 16 * w + 4 * g);
        const f32x4 cv = e1r * P;
#pragma unroll
        for (int j = 0; j < 8; ++j) { const f32x4 sv = S[j] * cv; u32x2 w_; w_.x = cvt_pk_bf16(sv[0], sv[1]); w_.y = cvt_pk_bf16(sv[2], sv[3]);
            *(LAS u32x2*)(lds + OFF_SP + (16 * j + c) * PITCH + (16 * w + 4 * g) * 2) = w_; }
        P = P * e1r * e2r;
        __syncthreads();
        f32x4 o[4]; float ss = 0.f;
#pragma unroll
        for (int jj = 0; jj < 4; ++jj) {
            const int j = 4 * dvh + jj; f32x4 acc = {bflo(ol[jj].x), bfhi(ol[jj].x), bflo(ol[jj].y), bfhi(ol[jj].y)};
#pragma unroll
            for (int ks = 0; ks < 4; ++ks) acc = MFMA16(ld_frag(lds + OFF_SP, PITCH, 16 * j + c, 32 * ks + 8 * g), qf[ks], acc);
            o[jj] = acc; ss += (acc[0] * acc[0] + acc[1] * acc[1]) + (acc[2] * acc[2] + acc[3] * acc[3]);
        }
        ss += __shfl_xor(ss, 16); ss += __shfl_xor(ss, 32);
        if (g == 0) ((LAS float*)(lds + OFF_RSS))[(16 * tt + c) * 2 + dvh] = ss;
        __syncthreads();
        const LAS float* rp = (const LAS float*)(lds + OFF_RSS) + (16 * tt + c) * 2; const float rs = rsqrtf((rp[0] + rp[1]) * (1.0f / 128.0f) + EPS);
#pragma unroll
        for (int jj = 0; jj < 4; ++jj) { const f32x4 v = o[jj] * rs * ghv[jj]; u32x2 w_;
            w_.x = cvt_pk_bf16(v[0] * bflo(ogv[jj].x), v[1] * bfhi(ogv[jj].x)); w_.y = cvt_pk_bf16(v[2] * bflo(ogv[jj].y), v[3] * bfhi(ogv[jj].y));
            *(u32x2*)(QIp + oplane + (size_t)ch * 4096 + 16 * jj) = w_; }
    }
}

namespace mb {
constexpr int KP_ = 144;
constexpr int OFF_K = 0, OFF_V = 256 * KP_, OFF_KM = 2 * 256 * KP_, OFF_CNT = OFF_KM + 8192, OFF_BASE = OFF_CNT + 128, END = OFF_BASE + 128;
static_assert(END <= 160 * 1024, "moba lds");
constexpr size_t WS_PO = 264 * MiB, WS_PL = 456 * MiB, WS_LIST = 462 * MiB;
constexpr int LIST_PER_BH = 256 * 496;
static_assert(WS_PO + (size_t)64 * SEQ * 3 * 128 <= WS_PL && WS_PL + (size_t)64 * SEQ * 3 * 4 <= WS_LIST && WS_LIST + (size_t)64 * LIST_PER_BH * 2 <= 512 * MiB, "moba ws");
__device__ __forceinline__ int list_off(int n) { return 256 * (31 * n - (n * (n - 1)) / 2); }
}
__device__ __forceinline__ void mb_stage(LAS unsigned char* dst, const bf16_t* g, int tid) {
    u32x4 r[4];
#pragma unroll
    for (int k = 0; k < 4; ++k) { const int i = tid + 512 * k; r[k] = *(const u32x4*)(g + (size_t)(i >> 3) * 64 + (i & 7) * 8); }
#pragma unroll
    for (int k = 0; k < 4; ++k) { const int i = tid + 512 * k; *(LAS u32x4*)(dst + (i >> 3) * mb::KP_ + (i & 7) * 16) = r[k]; }
}
struct MbStage { u32x4 rk[4], rv[4]; };
__device__ __forceinline__ void mb_stage_issue(MbStage& st, const bf16_t* gk, const bf16_t* gv, int tid) {
#pragma unroll
    for (int k = 0; k < 4; ++k) { const int i = tid + 512 * k; const size_t o = (size_t)(i >> 3) * 64 + (i & 7) * 8; st.rk[k] = *(const u32x4*)(gk + o); st.rv[k] = *(const u32x4*)(gv + o); }
}
__device__ __forceinline__ void mb_stage_commit(const MbStage& st, LAS unsigned char* lds, int tid) {
#pragma unroll
    for (int k = 0; k < 4; ++k) { const int i = tid + 512 * k; const int o = (i >> 3) * mb::KP_ + (i & 7) * 16; *(LAS u32x4*)(lds + mb::OFF_K + o) = st.rk[k]; *(LAS u32x4*)(lds + mb::OFF_V + o) = st.rv[k]; }
}
__device__ __forceinline__ void mb_granule(const LAS unsigned char* lds, int lane, bf16x8 q0, bf16x8 q1, float mref, int qpos, int nstep, f32x4 (&o)[4], float& l) {
    using namespace mb;
    const int c = lane & 15, g = lane >> 4;
    float ls = 0.f;
#pragma unroll
    for (int dt = 0; dt < 4; ++dt) o[dt] = (f32x4){0.f, 0.f, 0.f, 0.f};
#pragma unroll
    for (int j = 0; j < 8; ++j) {
        if (j < nstep) {
            f32x4 s0 = {-mref, -mref, -mref, -mref}, s1 = s0;
            s0 = MFMA16(ld_frag(lds + OFF_K, KP_, 32 * j + c, 8 * g), q0, s0); s0 = MFMA16(ld_frag(lds + OFF_K, KP_, 32 * j + c, 32 + 8 * g), q1, s0);
            s1 = MFMA16(ld_frag(lds + OFF_K, KP_, 32 * j + 16 + c, 8 * g), q0, s1); s1 = MFMA16(ld_frag(lds + OFF_K, KP_, 32 * j + 16 + c, 32 + 8 * g), q1, s1);
#pragma unroll
            for (int r = 0; r < 4; ++r) { float p0 = __builtin_amdgcn_exp2f(s0[r]), p1 = __builtin_amdgcn_exp2f(s1[r]);
                p0 = (32 * j + 4 * g + r > qpos) ? 0.f : p0; p1 = (32 * j + 16 + 4 * g + r > qpos) ? 0.f : p1; s0[r] = p0; s1[r] = p1; ls += p0 + p1; }
            u32x4 w_; w_.x = cvt_pk_bf16(s0[0], s0[1]); w_.y = cvt_pk_bf16(s0[2], s0[3]); w_.z = cvt_pk_bf16(s1[0], s1[1]); w_.w = cvt_pk_bf16(s1[2], s1[3]);
            const bf16x8 pf = __builtin_bit_cast(bf16x8, w_);
#pragma unroll
            for (int dt = 0; dt < 4; ++dt) o[dt] = MFMA16(tr_frag_split(lds + OFF_V, KP_, 32 * j, 16 * dt, lane), pf, o[dt]);
        }
    }
    asm volatile("s_nop 15" : "+v"(o[0]), "+v"(o[1]), "+v"(o[2]), "+v"(o[3]));
    ls += __shfl_xor(ls, 16); ls += __shfl_xor(ls, 32); l = ls;
}
__device__ __forceinline__ float mb_mref(bf16x8 q0, bf16x8 q1, float kam) {
    float s = 0.f;
#pragma unroll
    for (int i = 0; i < 8; ++i) s += fabsf(bf2f((bf16_t)q0[i])) + fabsf(bf2f((bf16_t)q1[i]));
    s += __shfl_xor(s, 16); s += __shfl_xor(s, 32); return s * kam;
}
__device__ __forceinline__ void moba_gate_item(LAS unsigned char* lds, int bh, int bhl, int qb, const bf16_t* Qg, const float* kmeang, unsigned* gcnt, unsigned short* glist) {
    using namespace mb;
    int tid_ = threadIdx.x; asm volatile("" : "+v"(tid_)); const int tid = tid_;
    const size_t pbase = (size_t)bh * SEQ * 64;
    u32x4 rq[4]; float rkm[4];
#pragma unroll
    for (int k = 0; k < 4; ++k) { const int i = tid + 512 * k; rq[k] = *(const u32x4*)(Qg + pbase + (size_t)256 * qb * 64 + (size_t)(i >> 3) * 64 + (i & 7) * 8); rkm[k] = (i < qb * 64) ? kmeang[(size_t)bh * NBLK * 64 + i] : 0.f; }
    __syncthreads();
    LAS float* kms = (LAS float*)(lds + OFF_KM);
#pragma unroll
    for (int k = 0; k < 4; ++k) { const int i = tid + 512 * k; *(LAS u32x4*)(lds + OFF_K + (i >> 3) * KP_ + (i & 7) * 16) = rq[k]; kms[i] = rkm[k]; }
    if (tid < 32) ((LAS int*)(lds + OFF_CNT))[tid] = 0;
    __syncthreads();
    const int q = tid >> 1, hf = tid & 1; float qv[32];
#pragma unroll
    for (int k = 0; k < 4; ++k) { const u32x4 w_ = *(const LAS u32x4*)(lds + OFF_K + q * KP_ + hf * 64 + k * 16); f32x4 x0, x1; unpack8(w_, x0, x1);
#pragma unroll
        for (int e = 0; e < 4; ++e) { qv[8 * k + e] = x0[e]; qv[8 * k + 4 + e] = x1[e]; } }
    float v0 = -INFINITY, v1 = -INFINITY, v2 = -INFINITY; int i0 = -1, i1 = -1, i2 = -1;
    for (int n = 0; n < qb; ++n) { float gsum = 0.f; const LAS float* km = kms + n * 64 + hf * 32;
#pragma unroll
        for (int d = 0; d < 32; ++d) gsum += qv[d] * km[d];
        gsum += __shfl_xor(gsum, 1);
        if (gsum > v0) { v2 = v1; i2 = i1; v1 = v0; i1 = i0; v0 = gsum; i0 = n; } else if (gsum > v1) { v2 = v1; i2 = i1; v1 = gsum; i1 = n; } else if (gsum > v2) { v2 = gsum; i2 = n; } }
    int p0 = 0, p1 = 0, p2 = 0; LAS int* cnt = (LAS int*)(lds + OFF_CNT);
    if (hf == 0) {
        if (i0 >= 0) p0 = __hip_atomic_fetch_add(cnt + i0, 1, __ATOMIC_RELAXED, __HIP_MEMORY_SCOPE_WORKGROUP);
        if (i1 >= 0) p1 = __hip_atomic_fetch_add(cnt + i1, 1, __ATOMIC_RELAXED, __HIP_MEMORY_SCOPE_WORKGROUP);
        if (i2 >= 0) p2 = __hip_atomic_fetch_add(cnt + i2, 1, __ATOMIC_RELAXED, __HIP_MEMORY_SCOPE_WORKGROUP);
    }
    __syncthreads();
    if (tid < 32) { const int cn = cnt[tid]; ((LAS int*)(lds + OFF_BASE))[tid] = cn > 0 ? (int)atomicAdd(gcnt + bhl * 32 + tid, (unsigned)cn) : 0; }
    __syncthreads();
    if (hf == 0) {
        const LAS int* base = (const LAS int*)(lds + OFF_BASE); unsigned short* gl = glist + (size_t)bhl * LIST_PER_BH; const unsigned qg = (unsigned)(256 * qb + q);
        if (i0 >= 0) gl[list_off(i0) + base[i0] + p0] = (unsigned short)(qg);
        if (i1 >= 0) gl[list_off(i1) + base[i1] + p1] = (unsigned short)(qg | (1u << 13));
        if (i2 >= 0) gl[list_off(i2) + base[i2] + p2] = (unsigned short)(qg | (2u << 13));
    }
}
__device__ __forceinline__ void moba_part_item(LAS unsigned char* lds, int bh, int bhl, int n, int chunk, const bf16_t* Qg, const bf16_t* Kg, const bf16_t* Vg, const unsigned* kamaxg, const unsigned* gcnt, const unsigned short* glist, bf16_t* PO, float* PL) {
    using namespace mb;
    int tid_ = threadIdx.x; asm volatile("" : "+v"(tid_)); const int tid = tid_, lane = tid & 63, w = __builtin_amdgcn_readfirstlane(tid >> 6), c = lane & 15, g = lane >> 4;
    const int cnt = (int)gcnt[bhl * 32 + n], e0 = 512 * chunk;
    if (e0 >= cnt) return;
    const size_t pbase = (size_t)bh * SEQ * 64;
    MbStage st; mb_stage_issue(st, Kg + pbase + (size_t)256 * n * 64, Vg + pbase + (size_t)256 * n * 64, tid);
    const float kam = __uint_as_float(kamaxg[bh]); const unsigned short* gl = glist + (size_t)bhl * LIST_PER_BH + list_off(n);
    unsigned ent[4]; bool valid[4]; bf16x8 q0[4], q1[4];
#pragma unroll
    for (int k = 0; k < 4; ++k) { const int e = e0 + 16 * (w + 8 * k) + c; valid[k] = e < cnt; ent[k] = gl[valid[k] ? e : e0]; }
#pragma unroll
    for (int k = 0; k < 4; ++k) { const bf16_t* qr = Qg + pbase + (size_t)(ent[k] & 8191) * 64; q0[k] = *(const bf16x8*)(qr + 8 * g); q1[k] = *(const bf16x8*)(qr + 32 + 8 * g); }
    __syncthreads();
    mb_stage_commit(st, lds, tid);
    __syncthreads();
    if (e0 + 16 * w >= cnt) return;
    float mref[4], ls[4]; f32x4 o[4][4];
#pragma unroll
    for (int k = 0; k < 4; ++k) { mref[k] = valid[k] ? mb_mref(q0[k], q1[k], kam) : INFINITY; ls[k] = 0.f;
#pragma unroll
        for (int dt = 0; dt < 4; ++dt) o[k][dt] = (f32x4){0.f, 0.f, 0.f, 0.f}; }
#pragma unroll 1
    for (int j = 0; j < 8; ++j) {
        const bf16x8 ka0 = ld_frag(lds + OFF_K, KP_, 32 * j + c, 8 * g), ka1 = ld_frag(lds + OFF_K, KP_, 32 * j + c, 32 + 8 * g);
        const bf16x8 kb0 = ld_frag(lds + OFF_K, KP_, 32 * j + 16 + c, 8 * g), kb1 = ld_frag(lds + OFF_K, KP_, 32 * j + 16 + c, 32 + 8 * g);
        bf16x8 pf[4];
#pragma unroll
        for (int k = 0; k < 4; ++k) {
            f32x4 s0 = {0.f, 0.f, 0.f, 0.f}, s1 = {0.f, 0.f, 0.f, 0.f};
            s0 = MFMA16(ka0, q0[k], s0); s0 = MFMA16(ka1, q1[k], s0); s1 = MFMA16(kb0, q0[k], s1); s1 = MFMA16(kb1, q1[k], s1);
#pragma unroll
            for (int r = 0; r < 4; ++r) { s0[r] = __builtin_amdgcn_exp2f(s0[r] - mref[k]); s1[r] = __builtin_amdgcn_exp2f(s1[r] - mref[k]); ls[k] += s0[r] + s1[r]; }
            u32x4 w_; w_.x = cvt_pk_bf16(s0[0], s0[1]); w_.y = cvt_pk_bf16(s0[2], s0[3]); w_.z = cvt_pk_bf16(s1[0], s1[1]); w_.w = cvt_pk_bf16(s1[2], s1[3]);
            pf[k] = __builtin_bit_cast(bf16x8, w_); __builtin_amdgcn_sched_barrier(0);
        }
#pragma unroll
        for (int dt = 0; dt < 4; ++dt) { const bf16x8 vf = tr_frag_split(lds + OFF_V, KP_, 32 * j, 16 * dt, lane);
#pragma unroll
            for (int k = 0; k < 4; ++k) o[k][dt] = MFMA16(vf, pf[k], o[k][dt]); }
    }
#pragma unroll
    for (int k = 0; k < 4; ++k) {
        float l = ls[k]; l += __shfl_xor(l, 16); l += __shfl_xor(l, 32);
        if (valid[k]) { const int q = ent[k] & 8191, j = ent[k] >> 13; const size_t slot = ((size_t)bhl * SEQ + q) * 3 + j; bf16_t* po = PO + slot * 64 + 4 * g;
#pragma unroll
            for (int dt = 0; dt < 4; ++dt) { u32x2 w_; w_.x = cvt_pk_bf16(o[k][dt][0], o[k][dt][1]); w_.y = cvt_pk_bf16(o[k][dt][2], o[k][dt][3]); *(u32x2*)(po + 16 * dt) = w_; }
            if (g == 0) PL[slot] = l; }
    }
}
__device__ __forceinline__ void mb_grp_barrier(LAS unsigned* ctr, unsigned target, int lane) {
    asm volatile("s_waitcnt lgkmcnt(0)" ::: "memory");
    if (lane == 0) __hip_atomic_fetch_add(ctr, 1u, __ATOMIC_RELAXED, __HIP_MEMORY_SCOPE_WORKGROUP);
    while (__hip_atomic_load(ctr, __ATOMIC_RELAXED, __HIP_MEMORY_SCOPE_WORKGROUP) < target) __builtin_amdgcn_s_sleep(1);
    asm volatile("" ::: "memory");
}
__device__ __forceinline__ void moba_part_phase(LAS unsigned char* lds, const LAS int* pfx, LAS unsigned* gctr, int nitems, int mbi, int nmb, const bf16_t* Qg, const bf16_t* Kg, const bf16_t* Vg, const unsigned* kamaxg, const unsigned* gcnt, const unsigned short* glist, bf16_t* PO, float* PL) {
    using namespace mb;
    int tid_ = threadIdx.x; asm volatile("" : "+v"(tid_)); const int tid = tid_, lane = tid & 63, w = __builtin_amdgcn_readfirstlane(tid >> 6), grp = w >> 2, wg = w & 3, tg = tid & 255, c = lane & 15, g = lane >> 4;
    LAS unsigned char* const lb = lds + grp * (2 * 256 * KP_);
    LAS unsigned* const ctr = gctr + grp; unsigned bar = 0;
    const int nw = 2 * nmb, wi = 2 * mbi + grp;
    int nbhl = 0, nn = 0, ne0 = 0; unsigned nent[4] = {0u, 0u, 0u, 0u}, ncnt = 0, nkam = 0; bool have = false;
    auto fetch = [&](int r) {
        const int k = r * nw + ((r & 1) ? nw - 1 - wi : wi);
        have = (r * nw < nitems) && (k < nitems);
        if (!have) return;
        int lo_ = 0, hi_ = 2047;
        while (lo_ < hi_) { const int mid = (lo_ + hi_) >> 1; if (pfx[mid] > k) hi_ = mid; else lo_ = mid + 1; }
        nn = lo_ >> 6; nbhl = lo_ & 63; ne0 = 256 * (k - (lo_ ? pfx[lo_ - 1] : 0));
        ncnt = gcnt[nbhl * 32 + nn]; nkam = kamaxg[nbhl];
        const unsigned short* gl = glist + (size_t)nbhl * LIST_PER_BH + list_off(nn) + ne0;
#pragma unroll
        for (int k4 = 0; k4 < 4; ++k4) nent[k4] = gl[16 * (wg + 4 * k4) + c];
    };
    fetch(0);
    for (int r = 0; have; ++r) {
        const int cbhl = nbhl, cn = nn, ce0 = ne0, ccnt = (int)ncnt; const float kam = __uint_as_float(nkam);
        unsigned cent[4]; bool cval[4]; bf16x8 q0[4], q1[4];
        const size_t pbase = (size_t)cbhl * SEQ * 64;
        {
            u32x4 rk[8], rv[8];
            const bf16_t* gk = Kg + pbase + (size_t)256 * cn * 64; const bf16_t* gv = Vg + pbase + (size_t)256 * cn * 64;
#pragma unroll
            for (int k = 0; k < 8; ++k) { const int i = tg + 256 * k; const size_t o = (size_t)(i >> 3) * 64 + (i & 7) * 8; rk[k] = *(const u32x4*)(gk + o); rv[k] = *(const u32x4*)(gv + o); }
#pragma unroll
            for (int k = 0; k < 4; ++k) { cent[k] = nent[k]; cval[k] = ce0 + 16 * (wg + 4 * k) + c < ccnt; const bf16_t* qr = Qg + pbase + (size_t)(cent[k] & 8191) * 64; q0[k] = *(const bf16x8*)(qr + 8 * g); q1[k] = *(const bf16x8*)(qr + 32 + 8 * g); }
            bar += 4; mb_grp_barrier(ctr, bar, lane);
#pragma unroll
            for (int k = 0; k < 8; ++k) { const int i = tg + 256 * k; const int o = (i >> 3) * KP_ + (i & 7) * 16; *(LAS u32x4*)(lb + OFF_K + o) = rk[k]; *(LAS u32x4*)(lb + OFF_V + o) = rv[k]; }
            bar += 4; mb_grp_barrier(ctr, bar, lane);
        }
        fetch(r + 1);
        if (ce0 + 16 * wg < ccnt) {
            float nmr[4], ls[4]; f32x4 o[4][4];
#pragma unroll
            for (int k = 0; k < 4; ++k) { nmr[k] = cval[k] ? -mb_mref(q0[k], q1[k], kam) : -INFINITY; ls[k] = 0.f;
#pragma unroll
                for (int dt = 0; dt < 4; ++dt) o[k][dt] = (f32x4){0.f, 0.f, 0.f, 0.f}; }
#pragma unroll 1
            for (int j = 0; j < 8; ++j) {
                const bf16x8 ka0 = ld_frag(lb + OFF_K, KP_, 32 * j + c, 8 * g), ka1 = ld_frag(lb + OFF_K, KP_, 32 * j + c, 32 + 8 * g);
                const bf16x8 kb0 = ld_frag(lb + OFF_K, KP_, 32 * j + 16 + c, 8 * g), kb1 = ld_frag(lb + OFF_K, KP_, 32 * j + 16 + c, 32 + 8 * g);
                f32x4 s0[4], s1[4];
#pragma unroll
                for (int k = 0; k < 4; ++k) { s0[k] = (f32x4){nmr[k], nmr[k], nmr[k], nmr[k]}; s1[k] = s0[k];
                    s0[k] = MFMA16(ka0, q0[k], s0[k]); s0[k] = MFMA16(ka1, q1[k], s0[k]); s1[k] = MFMA16(kb0, q0[k], s1[k]); s1[k] = MFMA16(kb1, q1[k], s1[k]); }
                bf16x8 vf[4];
#pragma unroll
                for (int dt = 0; dt < 4; ++dt) vf[dt] = tr_frag_split(lb + OFF_V, KP_, 32 * j, 16 * dt, lane);
                __builtin_amdgcn_sched_barrier(0);
#pragma unroll
                for (int k = 0; k < 4; ++k) {
#pragma unroll
                    for (int rr = 0; rr < 4; ++rr) { s0[k][rr] = __builtin_amdgcn_exp2f(s0[k][rr]); s1[k][rr] = __builtin_amdgcn_exp2f(s1[k][rr]); ls[k] += s0[k][rr] + s1[k][rr]; }
                    u32x4 w_; w_.x = cvt_pk_bf16(s0[k][0], s0[k][1]); w_.y = cvt_pk_bf16(s0[k][2], s0[k][3]); w_.z = cvt_pk_bf16(s1[k][0], s1[k][1]); w_.w = cvt_pk_bf16(s1[k][2], s1[k][3]);
                    const bf16x8 pf = __builtin_bit_cast(bf16x8, w_);
#pragma unroll
                    for (int dt = 0; dt < 4; ++dt) o[k][dt] = MFMA16(vf[dt], pf, o[k][dt]);
                    __builtin_amdgcn_sched_barrier(0);
                }
            }
#pragma unroll
            for (int k = 0; k < 4; ++k) {
                float l = ls[k]; l += __shfl_xor(l, 16); l += __shfl_xor(l, 32);
                if (cval[k]) { const int q = cent[k] & 8191, j = cent[k] >> 13; const size_t slot = ((size_t)cbhl * SEQ + q) * 3 + j; bf16_t* po = PO + slot * 64 + 8 * g;
#pragma unroll
                    for (int h = 0; h < 2; ++h) { u32x4 w_; w_.x = cvt_pk_bf16(o[k][2 * h][0], o[k][2 * h][1]); w_.y = cvt_pk_bf16(o[k][2 * h][2], o[k][2 * h][3]);
                        w_.z = cvt_pk_bf16(o[k][2 * h + 1][0], o[k][2 * h + 1][1]); w_.w = cvt_pk_bf16(o[k][2 * h + 1][2], o[k][2 * h + 1][3]); *(u32x4*)(po + 32 * h) = w_; }
                    if (g == 0) PL[slot] = l; }
            }
        }
    }
}
__device__ __forceinline__ void moba_comb_item(LAS unsigned char* lds, int bh, int bhl, int qb, bf16_t* Qg, const bf16_t* Kg, const bf16_t* Vg, const unsigned* kamaxg, const bf16_t* PO, const float* PL) {
    using namespace mb;
    int tid_ = threadIdx.x; asm volatile("" : "+v"(tid_)); const int tid = tid_, lane = tid & 63, w = __builtin_amdgcn_readfirstlane(tid >> 6), c = lane & 15, g = lane >> 4;
    const size_t pbase = (size_t)bh * SEQ * 64;
    MbStage st; mb_stage_issue(st, Kg + pbase + (size_t)256 * qb * 64, Vg + pbase + (size_t)256 * qb * 64, tid);
    const float kam = __uint_as_float(kamaxg[bh]); const int nsel = qb < 3 ? qb : 3;
    bf16x8 q0[2], q1[2];
#pragma unroll
    for (int k = 0; k < 2; ++k) { const int gq = k ? 15 - w : w; const bf16_t* qr = Qg + pbase + (size_t)(256 * qb + 16 * gq + c) * 64; q0[k] = *(const bf16x8*)(qr + 8 * g); q1[k] = *(const bf16x8*)(qr + 32 + 8 * g); }
    __syncthreads();
    mb_stage_commit(st, lds, tid);
    __syncthreads();
#pragma unroll 1
    for (int k = 0; k < 2; ++k) {
        const int gq = k ? 15 - w : w, ql = 16 * gq + c, q = 256 * qb + ql;
        const bf16x8 qa = k ? q0[1] : q0[0], qb_ = k ? q1[1] : q1[0];
        const size_t slot = ((size_t)bhl * SEQ + q) * 3;
        u32x4 pp[3][2]; float pl[3];
#pragma unroll
        for (int j = 0; j < 3; ++j) { const bool on = j < nsel; pl[j] = on ? PL[slot + j] : 0.f; const bf16_t* po = PO + (slot + (on ? j : 0)) * 64 + 8 * g;
#pragma unroll
            for (int h = 0; h < 2; ++h) pp[j][h] = on ? *(const u32x4*)(po + 32 * h) : (u32x4){0u, 0u, 0u, 0u}; }
        const float mref = mb_mref(qa, qb_, kam);
        f32x4 o[4]; float l; mb_granule(lds, lane, qa, qb_, mref, ql, (gq >> 1) + 1, o, l);
#pragma unroll
        for (int j = 0; j < 3; ++j) { l += pl[j];
#pragma unroll
            for (int h = 0; h < 2; ++h) { o[2 * h][0] += bflo(pp[j][h].x); o[2 * h][1] += bfhi(pp[j][h].x); o[2 * h][2] += bflo(pp[j][h].y); o[2 * h][3] += bfhi(pp[j][h].y);
                o[2 * h + 1][0] += bflo(pp[j][h].z); o[2 * h + 1][1] += bfhi(pp[j][h].z); o[2 * h + 1][2] += bflo(pp[j][h].w); o[2 * h + 1][3] += bfhi(pp[j][h].w); } }
        const float rl = 1.0f / l; bf16_t* qr = Qg + pbase + (size_t)q * 64;
#pragma unroll
        for (int dt = 0; dt < 4; ++dt) { u32x2 w_; w_.x = cvt_pk_bf16(o[dt][0] * rl, o[dt][1] * rl); w_.y = cvt_pk_bf16(o[dt][2] * rl, o[dt][3] * rl); *(u32x2*)(qr + 16 * dt + 4 * g) = w_; }
    }
}

namespace xa {
constexpr int P = 528;
constexpr int END = 256 * P;
static_assert(END <= 160 * 1024, "xattn lds");
}
__device__ __forceinline__ void xattn_unit(LAS unsigned char* lds, int b, int hx, int tok0, const bf16_t* QXg, const bf16_t* KXg, const bf16_t* VXg, bf16_t* OXg) {
    using namespace xa;
    int tid_ = threadIdx.x; asm volatile("" : "+v"(tid_));
    const int tid = tid_, lane = tid & 63, w = __builtin_amdgcn_readfirstlane(tid >> 6), c = lane & 15, g = lane >> 4;
    const bf16_t* kb = KXg + (size_t)(b * 4 + hx) * 256 * 256; const bf16_t* vb = VXg + (size_t)(b * 4 + hx) * 256 * 256;
    auto stage = [&](const bf16_t* src) {
#pragma unroll
        for (int h2 = 0; h2 < 2; ++h2) { u32x4 rr[8]; int tid = tid_; asm volatile("" : "+v"(tid));
#pragma unroll
            for (int k = 0; k < 8; ++k) { const int i = tid + 512 * (8 * h2 + k); rr[k] = *(const u32x4*)(src + (size_t)(i >> 5) * 256 + (i & 31) * 8); }
#pragma unroll
            for (int k = 0; k < 8; ++k) { const int i = tid + 512 * (8 * h2 + k); *(LAS u32x4*)(lds + (i >> 5) * P + (i & 31) * 16) = rr[k]; } }
    };
    __syncthreads();
    stage(kb);
    __syncthreads();
    bf16x8 pf[2][8]; float rl[2], fa[2];
#pragma unroll
    for (int t2 = 0; t2 < 2; ++t2) {
        const size_t tok = (size_t)tok0 + 128 * t2 + 16 * w + c;
        bf16x8 qf[8];
#pragma unroll
        for (int ks = 0; ks < 8; ++ks) qf[ks] = *(const bf16x8*)(QXg + tok * D + hx * 256 + 32 * ks + 8 * g);
        float mh[2], lh[2];
#pragma unroll
        for (int hf = 0; hf < 2; ++hf) {
            f32x4 sc[8]; float mx = -INFINITY;
#pragma unroll
            for (int t = 0; t < 8; ++t) { f32x4 acc = {0.f, 0.f, 0.f, 0.f};
#pragma unroll
                for (int ks = 0; ks < 8; ++ks) acc = MFMA16(ld_frag(lds, P, 128 * hf + 16 * t + c, 32 * ks + 8 * g), qf[ks], acc);
                sc[t] = acc; mx = fmaxf(mx, fmaxf(fmaxf(acc[0], acc[1]), fmaxf(acc[2], acc[3]))); __builtin_amdgcn_sched_barrier(0); }
            mx = fmaxf(mx, __shfl_xor(mx, 16)); mx = fmaxf(mx, __shfl_xor(mx, 32));
            if (hf == 1) mx = fmaxf(mx, mh[0]);
            float ls = 0.f;
#pragma unroll
            for (int t = 0; t < 8; ++t)
#pragma unroll
                for (int r = 0; r < 4; ++r) { const float p = __builtin_amdgcn_exp2f(sc[t][r] - mx); sc[t][r] = p; ls += p; }
            ls += __shfl_xor(ls, 16); ls += __shfl_xor(ls, 32); mh[hf] = mx; lh[hf] = ls;
#pragma unroll
            for (int j = 0; j < 4; ++j) { u32x4 w_; w_.x = cvt_pk_bf16(sc[2 * j][0], sc[2 * j][1]); w_.y = cvt_pk_bf16(sc[2 * j][2], sc[2 * j][3]); w_.z = cvt_pk_bf16(sc[2 * j + 1][0], sc[2 * j + 1][1]); w_.w = cvt_pk_bf16(sc[2 * j + 1][2], sc[2 * j + 1][3]);
                pf[t2][4 * hf + j] = __builtin_bit_cast(bf16x8, w_); }
            __builtin_amdgcn_sched_barrier(0);
        }
        fa[t2] = __builtin_amdgcn_exp2f(mh[0] - mh[1]);
        rl[t2] = __builtin_amdgcn_rcpf(fa[t2] * lh[0] + lh[1]);
    }
    __syncthreads();
    stage(vb);
    __syncthreads();
#pragma unroll
    for (int t2 = 0; t2 < 2; ++t2) {
        const size_t tok = (size_t)tok0 + 128 * t2 + 16 * w + c;
        f32x4 o[16];
#pragma unroll
        for (int dt = 0; dt < 16; ++dt) o[dt] = (f32x4){0.f, 0.f, 0.f, 0.f};
#pragma unroll
        for (int j = 0; j < 8; ++j) {
            if (j == 4) {
#pragma unroll
                for (int dt = 0; dt < 16; ++dt) o[dt] = o[dt] * fa[t2]; }
#pragma unroll
            for (int dt = 0; dt < 16; ++dt) { o[dt] = MFMA16(tr_frag_split(lds, P, 32 * j, 16 * dt, lane), pf[t2][j], o[dt]); if ((dt & 3) == 3) __builtin_amdgcn_sched_barrier(0); }
        }
#pragma unroll
        for (int dt = 0; dt < 16; ++dt) { u32x2 w_; w_.x = cvt_pk_bf16(o[dt][0] * rl[t2], o[dt][1] * rl[t2]); w_.y = cvt_pk_bf16(o[dt][2] * rl[t2], o[dt][3] * rl[t2]); *(u32x2*)(OXg + tok * D + hx * 256 + 16 * dt + 4 * g) = w_; }
    }
}

#define XB_TMO      128
#define XB_XCNT(j)  (256  + 64 * (j))
#define XB_XSUB(j)  (1280 + 64 * (j))
#define XB_XGEN(j)  (2304 + 64 * (j))
#define XB_TOP      3328
#define XB_TOPGEN   3392
#define XCD_BAR_WORDS 3456
#define XB_SPIN_CAP (1u << 18)

__device__ __forceinline__ unsigned xb_ld(unsigned* p)              { return __hip_atomic_load(p, __ATOMIC_RELAXED, __HIP_MEMORY_SCOPE_AGENT); }
__device__ __forceinline__ unsigned xb_add(unsigned* p, unsigned v) { return __hip_atomic_fetch_add(p, v, __ATOMIC_RELAXED, __HIP_MEMORY_SCOPE_AGENT); }
__device__ __forceinline__ unsigned xb_xcc_id() { return (unsigned)__builtin_amdgcn_s_getreg((3 << 11) | 20) & 0xFu; }
#define XB_SPIN(cond, bar) do { unsigned _sp = 0; while (cond) { __builtin_amdgcn_s_sleep(1); \
    if ((++_sp & 255u) == 0u) { if (xb_ld(&(bar)[XB_TMO])) break; if (_sp > XB_SPIN_CAP) { atomicAdd(&(bar)[XB_TMO], 1u); break; } } } } while (0)

struct XcdBarrier {
    unsigned* bar; unsigned x;
    volatile LAS unsigned* st;
};

__device__ __forceinline__ XcdBarrier xcd_barrier_post(unsigned* bar, volatile LAS unsigned* st) {
    XcdBarrier b; b.bar = bar; b.x = xb_xcc_id(); b.st = st;
    if (threadIdx.x == 0) (void)xb_add(&bar[XB_XCNT(b.x)], 1u);
    return b;
}
__device__ __forceinline__ void xcd_barrier_complete(unsigned* bar, unsigned x, unsigned& nloc, unsigned& nx) {
    const unsigned G = gridDim.x * gridDim.y * gridDim.z;
    unsigned sum, cnt, mine, sp = 0u;
    for (;;) {
        sum = 0u; cnt = 0u; mine = 0u;
#pragma unroll
        for (unsigned j = 0; j < 16; ++j) { const unsigned c = xb_ld(&bar[XB_XCNT(j)]); sum += c; cnt += (c > 0u) ? 1u : 0u; mine = (j == x) ? c : mine; }
        if (sum == G) break;
        __builtin_amdgcn_s_sleep(1);
        if ((++sp & 255u) == 0u) { if (xb_ld(&bar[XB_TMO])) break; if (sp > XB_SPIN_CAP) { atomicAdd(&bar[XB_TMO], 1u); break; } }
    }
    nloc = mine > 0u ? mine : 1u; nx = cnt > 0u ? cnt : 1u;
}

__device__ __forceinline__ void xcd_barrier(unsigned* const b_bar, const unsigned b_x, volatile LAS unsigned* const b_st) {
    asm volatile("s_waitcnt vmcnt(0)" ::: "memory");
    __syncthreads();
    if (threadIdx.x == 0) {
        unsigned* bar = b_bar;
        __builtin_amdgcn_s_waitcnt(0);
        unsigned nloc = b_st[0], nx = b_st[1];
        if (nloc == 0u) { xcd_barrier_complete(bar, b_x, nloc, nx); b_st[0] = nloc; b_st[1] = nx; }
        const unsigned old = xb_add(&bar[XB_XSUB(b_x)], 1u);
        const unsigned gen = old / nloc;
        if (old + 1u == (gen + 1u) * nloc) {
            __builtin_amdgcn_fence(__ATOMIC_RELEASE, "agent");
            asm volatile("s_waitcnt vmcnt(0)" ::: "memory");
            const unsigned og = xb_add(&bar[XB_TOP], 1u);
            const unsigned tg = og / nx;
            if (og + 1u == (tg + 1u) * nx) xb_add(&bar[XB_TOPGEN], 1u);
            else XB_SPIN(xb_ld(&bar[XB_TOPGEN]) == tg, bar);
            __builtin_amdgcn_fence(__ATOMIC_ACQUIRE, "agent");
            xb_add(&bar[XB_XGEN(b_x)], 1u);
            asm volatile("s_waitcnt vmcnt(0)" ::: "memory");
        } else {
            XB_SPIN(xb_ld(&bar[XB_XGEN(b_x)]) == gen, bar);
            __builtin_amdgcn_fence(__ATOMIC_ACQUIRE, "agent");
            asm volatile("s_waitcnt vmcnt(0)" ::: "memory");
        }
    }
    __syncthreads();
}


struct Args {
    const float* x; const float* mem; const int* pos; const float* g_mix; const float* w_in; const float* lbl; const float* g_hgrn; const float* w_bra; const float* w_brh; const float* w_out;
    const float* g_x; const float* g_mem; const float* wq; const float* wkv; const float* wo; const float* g_ffn; const float* w_ffi; const float* w_ffo; const float* g_fin;
    float* out; unsigned char* ws; int ph_lo, ph_hi;
};

template <class MapFn>
__device__ __forceinline__ void wt_item(const float* W, int ldw, const float* gain, bf16_t* WT, int ldwt, int koff, int nblk, int item, LAS float* scr, int lane, MapFn colmap) {
    const int kb = item / nblk, nb = item % nblk, k0 = 64 * kb, n0 = 32 * nb;
    const int col = colmap(n0 + (lane & 31));
    float wv[32];
#pragma unroll
    for (int i = 0; i < 32; ++i) wv[i] = W[(size_t)(k0 + 2 * i + (lane >> 5)) * ldw + col];
    if (gain) {
#pragma unroll
        for (int i = 0; i < 32; ++i) wv[i] *= gain[k0 + 2 * i + (lane >> 5)]; }
#pragma unroll
    for (int i = 0; i < 32; ++i) scr[(2 * i + (lane >> 5)) * 33 + (lane & 31)] = wv[i];
    asm volatile("s_waitcnt lgkmcnt(0)" ::: "memory");
    const int c = lane & 7;
#pragma unroll
    for (int j = 0; j < 4; ++j) { const int n = (lane >> 3) + 8 * j; const LAS float* s = scr + (8 * c) * 33 + n;
        u32x4 o; o.x = cvt_pk_bf16(s[0 * 33], s[1 * 33]); o.y = cvt_pk_bf16(s[2 * 33], s[3 * 33]); o.z = cvt_pk_bf16(s[4 * 33], s[5 * 33]); o.w = cvt_pk_bf16(s[6 * 33], s[7 * 33]);
        *(u32x4*)(WT + (size_t)(n0 + n) * ldwt + koff + k0 + 8 * c) = o; }
    asm volatile("s_waitcnt lgkmcnt(0)" ::: "memory");
}
__device__ __forceinline__ int zmap(int n) {
    const int tile = n >> 8, p = n & 255, bj = p >> 7, wc = (p >> 5) & 3, nn = (p >> 4) & 1, fq = (p >> 2) & 3, j = p & 3;
    if (tile < 8) return 256 * tile + 64 * (2 * bj + (wc >> 1)) + 32 * nn + 16 * (wc & 1) + 4 * fq + j;
    if (tile < 12) return 2048 + 256 * (tile - 8) + perm8(p);
    if (tile < 20) return (bj ? 4096 : 3072) + 128 * (tile - 12) + (perm8(p) & 127);
    if (tile < 24) return 5120 + 256 * (tile - 20) + perm8(p);
    return 6144 + 256 * (tile - 24) + perm8(p);
}
__device__ __forceinline__ void norm_row_bf16(const float* xrow, const float* g, bf16_t* orow, int lane) {
    f32x4 v[4]; float s = 0.f;
#pragma unroll
    for (int j = 0; j < 4; ++j) { v[j] = ((const f32x4*)xrow)[lane + 64 * j]; s += (v[j][0] * v[j][0] + v[j][1] * v[j][1]) + (v[j][2] * v[j][2] + v[j][3] * v[j][3]); }
    const float rstd = rsqrtf(wave_sum(s) * (1.0f / D) + EPS);
#pragma unroll
    for (int j = 0; j < 4; ++j) { const f32x4 gg = ((const f32x4*)g)[lane + 64 * j]; u32x2 w; w.x = cvt_pk_bf16(v[j][0] * rstd * gg[0], v[j][1] * rstd * gg[1]); w.y = cvt_pk_bf16(v[j][2] * rstd * gg[2], v[j][3] * rstd * gg[3]);
        ((u32x2*)orow)[lane + 64 * j] = w; }
}
__device__ __forceinline__ void sincos_acc(float ang, float& sn, float& cs) {
    const double a = (double)ang; const double q = __builtin_rint(a * 0.6366197723675814);
    const double t = __builtin_fma(-q, 1.5707963267948966, a) - q * 6.123233995736766e-17;
    const double t2 = t * t;
    double sp = -2.5052108385441720e-08; sp = sp * t2 + 2.7557319223985893e-06; sp = sp * t2 - 1.9841269841269841e-04; sp = sp * t2 + 8.3333333333333332e-03; sp = sp * t2 - 1.6666666666666666e-01; sp = sp * t2 * t + t;
    double cp = 2.0876756987868099e-09; cp = cp * t2 - 2.7557319223985888e-07; cp = cp * t2 + 2.4801587301587302e-05; cp = cp * t2 - 1.3888888888888889e-03; cp = cp * t2 + 4.1666666666666664e-02; cp = cp * t2 - 0.5; cp = cp * t2 + 1.0;
    const int qi = ((int)q) & 3;
    const double s_ = (qi & 1) ? cp : sp, c_ = (qi & 1) ? sp : cp;
    sn = (float)((qi & 2) ? -s_ : s_); cs = (float)(((qi == 1) || (qi == 2)) ? -c_ : c_);
}

constexpr int LDS_BYTES = 160 * 1024;
__global__ void __launch_bounds__(512, 2) mega_fwd(Args a) {
    extern __shared__ __attribute__((aligned(16))) unsigned char lds_raw[];
    LAS unsigned char* lds = (LAS unsigned char*)lds_raw;
    const int tid = threadIdx.x, lane = tid & 63, wave = __builtin_amdgcn_readfirstlane(tid >> 6);
    const int G = gridDim.x, bx = blockIdx.x;
    const int vcu = (G % 8 == 0) ? (bx % 8) * (G / 8) + bx / 8 : bx;
    const int gw = vcu * 8 + wave, NGW = G * 8;
#define kmean ((float*)(a.ws + CTL_KMEAN))
#define kamax ((unsigned*)(a.ws + CTL_KAMAX))
#define ssq1 ((float*)(a.ws + CTL_SSQ1))
#define ssq2 ((float*)(a.ws + CTL_SSQ2))
#define ssq3 ((float*)(a.ws + CTL_SSQ3))
#define WZ ((bf16_t*)(a.ws + WS_WZ))
#define WG ((bf16_t*)(a.ws + WS_WG))
#define WBR ((bf16_t*)(a.ws + WS_WBR))
#define WOUT ((bf16_t*)(a.ws + WS_WOUT))
#define WQ ((bf16_t*)(a.ws + WS_WQ))
#define WKV ((bf16_t*)(a.ws + WS_WKV))
#define WO ((bf16_t*)(a.ws + WS_WO))
#define WFI ((bf16_t*)(a.ws + WS_WFI))
#define WFO ((bf16_t*)(a.ws + WS_WFO))
#define RC ((float*)(a.ws + WS_RC))
#define RS ((float*)(a.ws + WS_RS))
#define MEMN ((bf16_t*)(a.ws + WS_MEMN))
#define KX ((bf16_t*)(a.ws + WS_KX))
#define VX ((bf16_t*)(a.ws + WS_VX))
#define E1 ((float*)(a.ws + WS_E1))
#define E2 ((float*)(a.ws + WS_E2))
#define XN ((bf16_t*)(a.ws + WS_XN))
#define HB XN
#define QP ((bf16_t*)(a.ws + WS_Q))
#define QX QP
#define QI ((bf16_t*)(a.ws + WS_QI))
#define OX QI
#define KI ((bf16_t*)(a.ws + WS_KI))
#define RAT KI
#define VB ((bf16_t*)(a.ws + WS_VB))
#define SGB VB
#define OG ((bf16_t*)(a.ws + WS_OG))
#define MG OG
#define ACT ((bf16_t*)(a.ws + WS_ACT))
#define KP ((bf16_t*)a.out)
#define VP ((bf16_t*)((unsigned char*)a.out + 64 * MiB))
#define H (a.out)
    cg::grid_group grid = cg::this_grid();
    volatile LAS unsigned* xb_st = (volatile LAS unsigned*)(lds + LDS_BYTES - 32);
    if (tid == 0) { xb_st[0] = 0u; xb_st[1] = 0u; }
    __syncthreads();
    unsigned* const xb_bar = (unsigned*)(a.ws + WS_CTL + 40960); const unsigned xb_x = xb_xcc_id();
    if (tid == 0) (void)xb_add(&xb_bar[XB_XCNT(xb_x)], 1u);
    const int lo = a.ph_lo, hi = a.ph_hi;
#ifndef PH_MASK
#define PH_MASK 0xfff
#endif
#define IN(k) (((PH_MASK >> (k)) & 1) && lo <= (k) && (k) < hi)
#define XBAR(word, count) xcd_barrier(xb_bar, xb_x, xb_st)
#define SEAM(k) do { if (IN(k) && IN((k) + 1)) { if (a.ph_lo < 0) grid.sync(); else XBAR(100 + (k), G); } } while (0)
#ifndef DUP_MASK
#define DUP_MASK 0
#endif
#define REPS(k) for (int rep_ = 0; rep_ < (((DUP_MASK >> (k)) & 1) ? 2 : 1); ++rep_)

    if (IN(0)) {
        LAS float* scr = (LAS float*)(lds + wave * 16384);
        constexpr int I_Z = 16 * (ZN / 32), I_G = 16 * 64, I_BR = 16 * 32, I_SQ = 16 * 32, I_KV = 16 * 64, I_FI = 16 * 176, I_FO = 44 * 32;
        constexpr int NITEMS = I_Z + I_G + 2 * I_BR + 3 * I_SQ + I_KV + I_FI + I_FO;
        for (int it = gw; it < NITEMS; it += NGW) {
            int r = it;
            if (r < I_Z) { wt_item(a.w_in, 9216, nullptr, WZ, 1024, 0, ZN / 32, r, scr, lane, [](int n) { return zmap(n); }); continue; } r -= I_Z;
            if (r < I_G) { wt_item(a.w_in, 9216, nullptr, WG, 1024, 0, 64, r, scr, lane, [](int n) { const int p = n & 255; return ((p >> 7) ? 8192 : 7168) + 128 * (n >> 8) + (perm8(p) & 127); }); continue; } r -= I_G;
            if (r < I_BR) { wt_item(a.w_bra, 1024, nullptr, WBR, 2048, 0, 32, r, scr, lane, [](int n) { return (n & ~255) + perm8(n & 255); }); continue; } r -= I_BR;
            if (r < I_BR) { wt_item(a.w_brh, 1024, nullptr, WBR, 2048, 1024, 32, r, scr, lane, [](int n) { return (n & ~255) + perm8(n & 255); }); continue; } r -= I_BR;
            if (r < I_SQ) { wt_item(a.w_out, 1024, nullptr, WOUT, 1024, 0, 32, r, scr, lane, [](int n) { return n; }); continue; } r -= I_SQ;
            if (r < I_SQ) { wt_item(a.wq, 1024, a.g_x, WQ, 1024, 0, 32, r, scr, lane, [](int n) { return (n & ~255) + perm8(n & 255); }); continue; } r -= I_SQ;
            if (r < I_SQ) { wt_item(a.wo, 1024, nullptr, WO, 1024, 0, 32, r, scr, lane, [](int n) { return n; }); continue; } r -= I_SQ;
            if (r < I_KV) { wt_item(a.wkv, 2048, nullptr, WKV, 1024, 0, 64, r, scr, lane, [](int n) { return (n & ~255) + perm8(n & 255); }); continue; } r -= I_KV;
            if (r < I_FI) { wt_item(a.w_ffi, 2 * FFN, a.g_ffn, WFI, 1024, 0, 176, r, scr, lane, [](int n) { const int p = n & 255; return ((p >> 7) ? FFN : 0) + 128 * (n >> 8) + (perm8(p) & 127); }); continue; } r -= I_FI;
            wt_item(a.w_ffo, 1024, nullptr, WFO, FFN, 0, 32, r, scr, lane, [](int n) { return n; });
        }
        for (int m = gw; m < T; m += 2 * NGW) {
            const int m2 = m + NGW; f32x4 v0[4], v1[4]; float s0 = 0.f, s1 = 0.f;
#pragma unroll
            for (int j = 0; j < 4; ++j) { v0[j] = ((const f32x4*)(a.x + (size_t)m * D))[lane + 64 * j]; v1[j] = ((const f32x4*)(a.x + (size_t)m2 * D))[lane + 64 * j]; }
#pragma unroll
            for (int j = 0; j < 4; ++j) { s0 += (v0[j][0] * v0[j][0] + v0[j][1] * v0[j][1]) + (v0[j][2] * v0[j][2] + v0[j][3] * v0[j][3]); s1 += (v1[j][0] * v1[j][0] + v1[j][1] * v1[j][1]) + (v1[j][2] * v1[j][2] + v1[j][3] * v1[j][3]); }
            const float r0 = rsqrtf(wave_sum(s0) * (1.0f / D) + EPS), r1 = rsqrtf(wave_sum(s1) * (1.0f / D) + EPS);
#pragma unroll
            for (int j = 0; j < 4; ++j) { const f32x4 gg = ((const f32x4*)a.g_mix)[lane + 64 * j]; const f32x4 a0 = v0[j] * r0 * gg, a1 = v1[j] * r1 * gg; u32x2 w0, w1;
                w0.x = cvt_pk_bf16(a0[0], a0[1]); w0.y = cvt_pk_bf16(a0[2], a0[3]); w1.x = cvt_pk_bf16(a1[0], a1[1]); w1.y = cvt_pk_bf16(a1[2], a1[3]);
                ((u32x2*)(XN + (size_t)m * D))[lane + 64 * j] = w0; ((u32x2*)(XN + (size_t)m2 * D))[lane + 64 * j] = w1; }
        }
        for (int m = gw; m < NB * NMEM; m += NGW) norm_row_bf16(a.mem + (size_t)m * D, a.g_mem, MEMN + (size_t)m * D, lane);
        for (int i = bx * 512 + tid; i < T * 32; i += G * 512) {
            const int tok = i >> 5, f = i & 31;
            const float inv = powf(10000.0f, -(float)(2 * f) * (1.0f / 64.0f));
            const float ang = (float)a.pos[tok] * inv;
            float sn, cs; sincos_acc(ang, sn, cs); RC[i] = cs; RS[i] = sn;
        }
    }
    SEAM(0);
    if (IN(1)) {

        const EpiZ Z{QP, KP, VP, QI, KI, VB, OG, E1, E2, RC, RS, kmean, kamax, a.lbl};
#define ZSEC(EPI, einit, tile0, ntile) { pg8::Gemm g{pg8::a_rowmajor(XN, D), WZ + (size_t)(tile0) * 256 * D, T, (ntile) * 256, D}; pg8::StaticOrder S; S.init(T, (ntile) * 256, G, bx); \
            const EPI E einit; pg8::gemm_phase<EPI, true>(lds, g, S, E); }
        ZSEC(EpiRope<false>, {Z}, 0, 4)
        ZSEC(EpiRope<true>, {Z}, 4, 4)
        ZSEC(EpiPlane<false>, ({Z, VP}), 8, 4)
        ZSEC(EpiQF, {Z}, 12, 8)
        ZSEC(EpiPlane<false>, ({Z, VB}), 20, 4)
        ZSEC(EpiPlane<true>, ({Z, OG}), 24, 4)
    #if (DUP_MASK >> 1) & 1
        ZSEC(EpiRope<false>, {Z}, 0, 4)
        ZSEC(EpiRope<true>, {Z}, 4, 4)
        ZSEC(EpiPlane<false>, ({Z, VP}), 8, 4)
        ZSEC(EpiQF, {Z}, 12, 8)
        ZSEC(EpiPlane<false>, ({Z, VB}), 20, 4)
        ZSEC(EpiPlane<true>, ({Z, OG}), 24, 4)
    #endif
#undef ZSEC
    }
    SEAM(1);
    if (IN(2)) {
        for (int it = bx; it < NB * BH * hg::NSEG; it += G) hgrn_seg_a(lds, it / (BH * hg::NSEG), (it / hg::NSEG) % BH, it % hg::NSEG, QI, KI, VB, E1, E2);
        XBAR(120, G);
        for (int it = bx; it < NB * BH * hg::NSEG; it += G) hgrn_seg_b(lds, it / (BH * hg::NSEG), (it / hg::NSEG) % BH, it % hg::NSEG, QI, KI, VB, OG, E1, E2, a.g_hgrn);
        {
            unsigned* ctl = (unsigned*)(a.ws + WS_CTL);
            unsigned* gcnt = ctl + 4096;
            bf16_t* PO = (bf16_t*)(a.ws + mb::WS_PO); float* PL = (float*)(a.ws + mb::WS_PL); unsigned short* GL = (unsigned short*)(a.ws + mb::WS_LIST);
            const int nmb = G, mbi = bx;
#define MB_QUEUE(total, ...) do { for (int r_ = 0;; ++r_) { const int k = r_ * nmb + ((r_ & 1) ? nmb - 1 - mbi : mbi); if (r_ * nmb >= (total)) break; if (k < (total)) { __VA_ARGS__ } } } while (0)
            if (bx < 32) { __syncthreads(); pg8::Gemm g{pg8::a_rowmajor(MEMN, D), WKV, NB * NMEM, 2 * D, D}; pg8::StaticOrder S; S.init(NB * NMEM, 2 * D, 32, bx);
                EpiKV E{KX, VX};
                pg8::gemm_phase<EpiKV, true>(lds, g, S, E); }
            { const int n1 = G - 32, head = 3 * n1;
              if (bx >= 32) for (int r_ = 0; r_ < 3; ++r_) { const int k = r_ * n1 + ((r_ & 1) ? n1 - 1 - (bx - 32) : bx - 32);
                  moba_gate_item(lds, k & 63, k & 63, 31 - (k >> 6), QP, kmean, gcnt, GL); }
              for (int r_ = 0; head + r_ * G < 64 * 31; ++r_) { const int k = head + r_ * G + ((r_ & 1) ? G - 1 - bx : bx);
                  if (k < 64 * 31) moba_gate_item(lds, k & 63, k & 63, 31 - (k >> 6), QP, kmean, gcnt, GL); } }
            XBAR(121, G);
            LAS int* pfx = (LAS int*)(lds + LDS_BYTES - 12288);
            { __syncthreads();
              int v4[4], v = 0;
#pragma unroll
              for (int q4 = 0; q4 < 4; ++q4) { const int i = 4 * tid + q4; v4[q4] = (int)((gcnt[(i & 63) * 32 + (i >> 6)] + 255u) >> 8); v += v4[q4]; }
              const int mine = v;
#pragma unroll
              for (int o = 1; o < 64; o <<= 1) { const int t_ = __shfl_up(v, o); if (lane >= o) v += t_; }
              LAS int* wtot = pfx + 2048;
              if (lane == 63) wtot[wave] = v;
              if (tid < 2) wtot[16 + tid] = 0;
              __syncthreads();
              int add = v - mine;
#pragma unroll
              for (int w_ = 0; w_ < 8; ++w_) add += (w_ < wave) ? wtot[w_] : 0;
#pragma unroll
              for (int q4 = 0; q4 < 4; ++q4) { add += v4[q4]; pfx[4 * tid + q4] = add; }
              __syncthreads(); }
            const int nitems = pfx[2047];
            moba_part_phase(lds, pfx, (LAS unsigned*)(pfx + 2048 + 16), nitems, mbi, nmb, QP, KP, VP, kamax, gcnt, GL, PO, PL);
            XBAR(122, G);
            MB_QUEUE(64 * 32, {
                const int bh = k & 63, qb = 31 - (k >> 6);
                moba_comb_item(lds, bh, bh, qb, QP, KP, VP, kamax, PO, PL); });
#undef MB_QUEUE
        }
    }
    SEAM(2);
    if (IN(3)) {
        pg8::Gemm g{pg8::a_rowmajor(XN, D), WG, T, 2 * D, D}; pg8::PairOrder S; S.base.init(T, D, G, bx);
        EpiGate E{RAT, SGB};
        pg8::gemm_phase<EpiGate, true, pg8::PairOrder>(lds, g, S, E);
        asm volatile("s_waitcnt vmcnt(0)" ::: "memory"); __syncthreads();
    }
    if (IN(4)) {
        {
        pg8::AView av; av.b0 = (const char*)QP; av.b1 = (const char*)QI - 16 * MiB; av.tsplit = 16; av.bstride = 16 * MiB; av.tstride = 256 * 64 * 2; av.kstride = 1 * MiB; av.lda = 64;
        pg8::Gemm g{av, WBR, T, D, 2 * D}; pg8::StaticOrder S; S.init(T, D, G, bx);
        EpiMerged E{RAT, SGB, MG};
        pg8::gemm_phase<EpiMerged, true>(lds, g, S, E);
            }
#if (DUP_MASK >> 4) & 1
        {
        pg8::AView av; av.b0 = (const char*)QP; av.b1 = (const char*)QI - 16 * MiB; av.tsplit = 16; av.bstride = 16 * MiB; av.tstride = 256 * 64 * 2; av.kstride = 1 * MiB; av.lda = 64;
        pg8::Gemm g{av, WBR, T, D, 2 * D}; pg8::StaticOrder S; S.init(T, D, G, bx);
        EpiMerged E{RAT, SGB, MG};
        pg8::gemm_phase<EpiMerged, true>(lds, g, S, E);
            }
#endif
    }
    SEAM(4);
    if (IN(5)) {
        pg8::Gemm g{pg8::a_rowmajor(MG, D), WOUT, T, D, D}; pg8::StaticOrder S; S.init(T, D, G, bx);
        EpiRes<false> E{a.x, HB, ssq1};
        pg8::gemm_phase<EpiRes<false>, true>(lds, g, S, E);
    }
    SEAM(5);
    if (IN(6)) {
        {
        pg8::Gemm g{pg8::a_rowmajor(HB, D), WQ, T, D, D}; pg8::StaticOrder S; S.init(T, D, G, bx);
        EpiScaleRow E{ssq1, QX, XSCALE};
        pg8::gemm_phase<EpiScaleRow, true>(lds, g, S, E);
#if STAGE_XATTN
        asm volatile("s_waitcnt vmcnt(0)" ::: "memory"); __syncthreads();
        for (int i = 0;; ++i) { const int u = pg8::so_unit(T / 256, D / 256, G, bx, i); if (u < 0) break; xattn_unit(lds, (u >> 16) >> 5, u & 0xffff, 256 * (u >> 16), QX, KX, VX, OX); }
#endif
            }
#if (DUP_MASK >> 6) & 1
        {
        pg8::Gemm g{pg8::a_rowmajor(HB, D), WQ, T, D, D}; pg8::StaticOrder S; S.init(T, D, G, bx);
        EpiScaleRow E{ssq1, QX, XSCALE};
        pg8::gemm_phase<EpiScaleRow, true>(lds, g, S, E);
#if STAGE_XATTN
        asm volatile("s_waitcnt vmcnt(0)" ::: "memory"); __syncthreads();
        for (int i = 0;; ++i) { const int u = pg8::so_unit(T / 256, D / 256, G, bx, i); if (u < 0) break; xattn_unit(lds, (u >> 16) >> 5, u & 0xffff, 256 * (u >> 16), QX, KX, VX, OX); }
#endif
            }
#endif
    }
#if !STAGE_XATTN
    SEAM(6);
#endif
    if (IN(7)) {
#if STAGE_XATTN
#else
        LAS float* qsh = (LAS float*)(lds + wave * 2048); LAS float* psh = qsh + 256;
        for (int it = gw; it < T * XH; it += NGW) {
            const int tok = it >> 2, hx = it & 3, b = tok >> 13;
            { const u32x2 w = *(const u32x2*)(QX + (size_t)tok * D + hx * 256 + 4 * lane); qsh[4 * lane] = bflo(w.x); qsh[4 * lane + 1] = bfhi(w.x); qsh[4 * lane + 2] = bflo(w.y); qsh[4 * lane + 3] = bfhi(w.y); }
            asm volatile("s_waitcnt lgkmcnt(0)" ::: "memory");
            const bf16_t* kb = KX + (size_t)(b * 4 + hx) * 256 * 256; const bf16_t* vb = VX + (size_t)(b * 4 + hx) * 256 * 256;
            float sc[4]; float mx = -INFINITY;
#pragma unroll
            for (int i = 0; i < 4; ++i) { const u32x4* kr = (const u32x4*)(kb + (size_t)(lane + 64 * i) * 256); float s_ = 0.f;
#pragma unroll 2
                for (int c = 0; c < 32; ++c) { const u32x4 w = kr[c]; f32x4 x0, x1; unpack8(w, x0, x1);
#pragma unroll
                    for (int e = 0; e < 4; ++e) s_ += x0[e] * qsh[8 * c + e] + x1[e] * qsh[8 * c + 4 + e]; }
                sc[i] = s_; mx = fmaxf(mx, s_); }
            mx = wave_max(mx); float lsum = 0.f;
#pragma unroll
            for (int i = 0; i < 4; ++i) { const float p = exp2f(sc[i] - mx); psh[lane + 64 * i] = p; lsum += p; }
            lsum = wave_sum(lsum);
            asm volatile("s_waitcnt lgkmcnt(0)" ::: "memory");
            f32x4 ov = {0.f, 0.f, 0.f, 0.f};
#pragma unroll 4
            for (int m = 0; m < 256; ++m) { const u32x2 w = *(const u32x2*)(vb + (size_t)m * 256 + 4 * lane); const float p = psh[m]; ov[0] += p * bflo(w.x); ov[1] += p * bfhi(w.x); ov[2] += p * bflo(w.y); ov[3] += p * bfhi(w.y); }
            const float rl = 1.0f / lsum; u32x2 w; w.x = cvt_pk_bf16(ov[0] * rl, ov[1] * rl); w.y = cvt_pk_bf16(ov[2] * rl, ov[3] * rl);
            *(u32x2*)(OX + (size_t)tok * D + hx * 256 + 4 * lane) = w;
        }
#endif
    }
    SEAM(7);
    if (IN(8)) {
        pg8::Gemm g{pg8::a_rowmajor(OX, D), WO, T, D, D}; pg8::StaticOrder S; S.init(T, D, G, bx);
        EpiRes<true> E{HB, HB, ssq2};
        pg8::gemm_phase<EpiRes<true>, true>(lds, g, S, E);
    }
    SEAM(8);
    if (IN(9)) {
        pg8::Gemm g{pg8::a_rowmajor(HB, D), WFI, T, 2 * FFN, D}; pg8::StaticOrder S; S.init(T, 2 * FFN, G, bx);
        EpiSwiglu E{ssq2, ACT};
        pg8::gemm_phase<EpiSwiglu, true>(lds, g, S, E);
    }
    SEAM(9);
    if (IN(10)) {
        pg8::Gemm g{pg8::a_rowmajor(ACT, FFN), WFO, T, D, FFN}; pg8::StaticOrder S; S.init(T, D, G, bx);
        EpiRes<true> E{HB, HB, ssq3};
        pg8::gemm_phase<EpiRes<true>, true>(lds, g, S, E);
    }
    SEAM(10);
    if (IN(11)) {
        f32x4 gg[4];
#pragma unroll
        for (int j = 0; j < 4; ++j) gg[j] = ((const f32x4*)a.g_fin)[lane + 64 * j];
        for (int m0 = gw; m0 < T; m0 += 4 * NGW) {
            u32x2 hw[4][4]; float rs[4];
#pragma unroll
            for (int q = 0; q < 4; ++q) { const int m = m0 + q * NGW; const u32x2* hrow = (const u32x2*)(HB + (size_t)m * D);
#pragma unroll
                for (int j = 0; j < 4; ++j) hw[q][j] = hrow[lane + 64 * j];
                rs[q] = ssq3[m]; }
#pragma unroll
            for (int q = 0; q < 4; ++q) { const int m = m0 + q * NGW; const float rstd = rsqrtf(rs[q] * (1.0f / D) + EPS); f32x4* row = (f32x4*)(a.out + (size_t)m * D);
#pragma unroll
                for (int j = 0; j < 4; ++j) { const u32x2 w = hw[q][j]; row[lane + 64 * j] = (f32x4){bflo(w.x), bfhi(w.x), bflo(w.y), bfhi(w.y)} * rstd * gg[j]; } }
        }
    }
#undef IN
#undef SEAM
}
#undef kmean
#undef kamax
#undef ssq1
#undef ssq2
#undef ssq3
#undef WZ
#undef WG
#undef WBR
#undef WOUT
#undef WQ
#undef WKV
#undef WO
#undef WFI
#undef WFO
#undef RC
#undef RS
#undef MEMN
#undef KX
#undef VX
#undef E1
#undef E2
#undef XN
#undef HB
#undef QP
#undef QX
#undef QI
#undef OX
#undef KI
#undef RAT
#undef VB
#undef SGB
#undef OG
#undef MG
#undef ACT
#undef KP
#undef VP
#undef H

constexpr int N_PHASES = 12;
extern "C" void kernel_launch(void* const* d_in, const int* in_sizes, int n_in, void* d_out, int out_size, void* d_ws, size_t ws_size, hipStream_t stream) {
    static int grid = 0;
    if (grid == 0) {
        if (n_in != 19 || in_sizes[0] != T * D || out_size != T * D || ws_size < WS_END) { fprintf(stderr, "kernel_launch: unexpected shapes (n_in %d, in0 %d, out %d, ws %zu)\n", n_in, n_in > 0 ? in_sizes[0] : -1, out_size, ws_size); grid = -1; return; }
        int dev = 0, cus = 0, per_cu = 0;
        hipGetDevice(&dev); hipDeviceGetAttribute(&cus, hipDeviceAttributeMultiprocessorCount, dev);
        hipFuncSetAttribute((const void*)mega_fwd, hipFuncAttributeMaxDynamicSharedMemorySize, LDS_BYTES);
        if (hipOccupancyMaxActiveBlocksPerMultiprocessor(&per_cu, (const void*)mega_fwd, 512, LDS_BYTES) != hipSuccess || per_cu < 1) { fprintf(stderr, "kernel_launch: occupancy query says %d blocks/CU\n", per_cu); per_cu = 1; }
        (void)hipGetLastError();
        grid = cus;
    }
    if (grid < 0) return;
    hipMemsetAsync((char*)d_ws + WS_CTL, 0, CTL_ZERO_BYTES, stream);
    Args a{};
    a.x = (const float*)d_in[0]; a.mem = (const float*)d_in[1]; a.pos = (const int*)d_in[2]; a.g_mix = (const float*)d_in[3]; a.w_in = (const float*)d_in[4]; a.lbl = (const float*)d_in[5];
    a.g_hgrn = (const float*)d_in[6]; a.w_bra = (const float*)d_in[7]; a.w_brh = (const float*)d_in[8]; a.w_out = (const float*)d_in[9]; a.g_x = (const float*)d_in[10]; a.g_mem = (const float*)d_in[11];
    a.wq = (const float*)d_in[12]; a.wkv = (const float*)d_in[13]; a.wo = (const float*)d_in[14]; a.g_ffn = (const float*)d_in[15]; a.w_ffi = (const float*)d_in[16]; a.w_ffo = (const float*)d_in[17]; a.g_fin = (const float*)d_in[18];
    a.out = (float*)d_out; a.ws = (unsigned char*)d_ws;
#if MK_N_LAUNCHES == 1
    a.ph_lo = 0; a.ph_hi = N_PHASES;
    void* args[] = {&a};
    hipError_t e = hipLaunchCooperativeKernel((const void*)mega_fwd, dim3(grid), dim3(512), args, LDS_BYTES, stream);
    if (e != hipSuccess) fprintf(stderr, "cooperative launch failed: %s (grid %d)\n", hipGetErrorString(e), grid);
#else
    for (int p = 0; p < N_PHASES; ++p) { a.ph_lo = p; a.ph_hi = p + 1; hipLaunchKernelGGL(mega_fwd, dim3(grid), dim3(512), LDS_BYTES, stream, a); }
#endif
}
```
